# Optimizing an MI355X kernel written in HIP

```python
import math
import jax, jax.numpy as jnp
from jax import lax
import numpy as np

D_MODEL = 1024
BATCH = 4
SEQ = 4096
DEPTH = 4

MEM_LEN = 256
D_MIX = D_MODEL
NORM_EPS = 1e-6
DA_HEADS = 4
DA_HALF = D_MIX // (4 * DA_HEADS)
DA_VDIM = 2 * DA_HALF
DA_QK = DA_HEADS * 2 * DA_HALF
DA_V = DA_HEADS * DA_VDIM
Q_BLOCK = 128
SSD_HEADS = 4
SSD_INNER = D_MIX // 4
SSD_HEAD_DIM = SSD_INNER // SSD_HEADS
SSD_GROUPS = 2
SSD_STATE = 128
SSD_CONV = 4
SSD_CHUNK = 128
SSD_CONV_DIM = SSD_INNER + 2 * SSD_GROUPS * SSD_STATE
GDN_HEADS = 4
GDN_V = D_MIX // 4
GDN_DV = GDN_V // GDN_HEADS
GDN_DK = GDN_DV
GDN_QK = GDN_HEADS * GDN_DK
GDN_CONV = 4
GDN_CHUNK = 64
GDN_CONV_DIM = 2 * GDN_QK + GDN_V
IN_SIZES = (DA_QK, DA_QK, DA_V, SSD_INNER, SSD_CONV_DIM, SSD_HEADS, GDN_CONV_DIM, GDN_V, GDN_HEADS, GDN_HEADS)
P_IN = 2 * DA_QK + DA_V + SSD_INNER + SSD_CONV_DIM + SSD_HEADS + GDN_CONV_DIM + GDN_V + 2 * GDN_HEADS
X_HEADS = 4
X_HEAD_DIM = D_MODEL // X_HEADS
D_FF = -(-8 * D_MODEL // (3 * 256)) * 256

kernel_name = 'hymba_style_diffattn_ssd_gdn_hybrid'


def rms_norm(x, g, eps=NORM_EPS):
    xf = x.astype(jnp.float32)
    y = xf * lax.rsqrt(jnp.mean(xf * xf, axis=-1, keepdims=True) + eps)
    return (y * g.astype(jnp.float32)).astype(x.dtype)


def l2_norm(x, eps=1e-6):
    xf = x.astype(jnp.float32)
    return xf * lax.rsqrt(jnp.sum(xf * xf, axis=-1, keepdims=True) + eps)


def causal_depthwise_conv(x, w):
    k = w.shape[0]
    return lax.conv_general_dilated(
        x, w.astype(x.dtype)[:, None, :], window_strides=(1,), padding=[(k - 1, 0)],
        dimension_numbers=('NWC', 'WIO', 'NWC'), feature_group_count=x.shape[-1])


def diff_attention(q, k, v, lam, q_g, k_g, sub_g, lambda_init):
    bsz, seq, nh, _, dh = q.shape
    q = rms_norm(q, q_g)
    k = rms_norm(k, k_g)
    nb = seq // Q_BLOCK
    qb = jnp.moveaxis(q.reshape(bsz, nb, Q_BLOCK, nh, 2, dh), 1, 0)
    kpos = jnp.arange(seq)
    scale = dh ** -0.5

    def block(args):
        qblk, i = args
        qpos = i * Q_BLOCK + jnp.arange(Q_BLOCK)
        s = jnp.einsum('bqhcd,bkhcd->bhcqk', qblk, k).astype(jnp.float32) * scale
        s = jnp.where((kpos[None, :] <= qpos[:, None])[None, None, None], s, -jnp.inf)
        p = jax.nn.softmax(s, axis=-1)
        w = p[:, :, 0] - lam * p[:, :, 1]
        return jnp.einsum('bhqk,bkhe->bqhe', w.astype(v.dtype), v)

    o = lax.map(block, (qb, jnp.arange(nb)))
    o = jnp.moveaxis(o, 0, 1).reshape(bsz, seq, nh, 2 * dh)
    o = rms_norm(o, sub_g) * (1.0 - lambda_init)
    return o.reshape(bsz, seq, nh * 2 * dh)


def ssd_chunked(x, dt, a_neg, bm, cm):
    bsz, seq, nh, hp = x.shape
    n = bm.shape[-1]
    t = SSD_CHUNK
    nc = seq // t
    xd = (x * dt[..., None]).reshape(bsz, nc, t, nh, hp)
    bc = bm.reshape(bsz, nc, t, nh, n)
    cc = cm.reshape(bsz, nc, t, nh, n)
    a_cum = jnp.cumsum((dt * a_neg).reshape(bsz, nc, t, nh), axis=2)
    tril = jnp.arange(t)[:, None] >= jnp.arange(t)[None, :]
    seg = a_cum[:, :, :, None, :] - a_cum[:, :, None, :, :]
    lmat = jnp.exp(jnp.where(tril[None, None, :, :, None], seg, -jnp.inf))
    scores = jnp.einsum('bclhn,bcshn->bclsh', cc, bc) * lmat
    y_diag = jnp.einsum('bclsh,bcshp->bclhp', scores, xd)
    decay_states = jnp.exp(a_cum[:, :, -1:, :] - a_cum)
    states = jnp.einsum('bclhn,bclh,bclhp->bchpn', bc, decay_states, xd)
    chunk_decay = jnp.exp(a_cum[:, :, -1, :])

    def step(h, inp):
        st, dec = inp
        return h * dec[:, :, None, None] + st, h

    h0 = jnp.zeros((bsz, nh, hp, n), jnp.float32)
    _, h_prev = lax.scan(step, h0, (jnp.moveaxis(states, 1, 0), jnp.moveaxis(chunk_decay, 1, 0)))
    h_prev = jnp.moveaxis(h_prev, 0, 1)
    y_off = jnp.einsum('bclhn,bchpn,bclh->bclhp', cc, h_prev, jnp.exp(a_cum))
    return (y_diag + y_off).reshape(bsz, seq, nh, hp)


def ssd_mixer(z, xbc, dt_raw, conv_w, conv_b, dt_bias, a_log, d_skip, norm_g):
    bsz, seq, _ = z.shape
    xbc = jax.nn.silu(causal_depthwise_conv(xbc, conv_w) + conv_b.astype(xbc.dtype))
    xs, bm, cm = jnp.split(xbc, [SSD_INNER, SSD_INNER + SSD_GROUPS * SSD_STATE], axis=-1)
    xs = xs.astype(jnp.float32).reshape(bsz, seq, SSD_HEADS, SSD_HEAD_DIM)
    rep = SSD_HEADS // SSD_GROUPS
    bm = jnp.repeat(bm.astype(jnp.float32).reshape(bsz, seq, SSD_GROUPS, SSD_STATE), rep, axis=2)
    cm = jnp.repeat(cm.astype(jnp.float32).reshape(bsz, seq, SSD_GROUPS, SSD_STATE), rep, axis=2)
    dt = jax.nn.softplus(dt_raw.astype(jnp.float32) + dt_bias.astype(jnp.float32))
    a_neg = -jnp.exp(a_log.astype(jnp.float32))
    y = ssd_chunked(xs, dt, a_neg, bm, cm) + d_skip.astype(jnp.float32)[:, None] * xs
    y = y.reshape(bsz, seq, SSD_INNER) * jax.nn.silu(z.astype(jnp.float32))
    gsz = SSD_INNER // SSD_GROUPS
    y = rms_norm(y.reshape(bsz, seq, SSD_GROUPS, gsz), norm_g.reshape(SSD_GROUPS, gsz))
    return y.reshape(bsz, seq, SSD_INNER).astype(z.dtype)


def gated_delta_chunked(q, k, v, g, beta):
    bsz, seq, nh, dk = q.shape
    dv = v.shape[-1]
    t = GDN_CHUNK
    nc = seq // t
    to_c = lambda a: a.reshape(bsz, nc, t, nh, a.shape[-1]).transpose(0, 3, 1, 2, 4)
    q = to_c(q * dk ** -0.5)
    k = to_c(k)
    v = to_c(v)
    beta = beta.reshape(bsz, nc, t, nh).transpose(0, 3, 1, 2)
    g = jnp.cumsum(g.reshape(bsz, nc, t, nh).transpose(0, 3, 1, 2), axis=-1)
    tril = jnp.arange(t)[:, None] >= jnp.arange(t)[None, :]
    strict = jnp.arange(t)[:, None] > jnp.arange(t)[None, :]
    decay = jnp.exp(jnp.where(tril, g[..., :, None] - g[..., None, :], -jnp.inf))
    k_beta = k * beta[..., None]
    v_beta = v * beta[..., None]
    a_low = jnp.where(strict, jnp.einsum('bhcid,bhcjd->bhcij', k_beta, k) * decay, 0.0)
    eye = jnp.broadcast_to(jnp.eye(t, dtype=jnp.float32), a_low.shape)
    t_inv = lax.linalg.triangular_solve(eye + a_low, eye, left_side=True, lower=True)
    u = jnp.einsum('bhcij,bhcjd->bhcid', t_inv, v_beta)
    w = jnp.einsum('bhcij,bhcjd->bhcid', t_inv, k_beta * jnp.exp(g)[..., None])
    attn = jnp.where(tril, jnp.einsum('bhcid,bhcjd->bhcij', q, k) * decay, 0.0)
    qg = q * jnp.exp(g)[..., None]
    kg = k * jnp.exp(g[..., -1:] - g)[..., None]
    g_last = jnp.exp(g[..., -1])

    def step(state, inp):
        qg_i, kg_i, u_i, w_i, attn_i, gl_i = inp
        v_new = u_i - jnp.einsum('bhtk,bhkv->bhtv', w_i, state)
        o = jnp.einsum('bhtk,bhkv->bhtv', qg_i, state) + jnp.einsum('bhts,bhsv->bhtv', attn_i, v_new)
        state = state * gl_i[..., None, None] + jnp.einsum('bhtk,bhtv->bhkv', kg_i, v_new)
        return state, o

    s0 = jnp.zeros((bsz, nh, dk, dv), jnp.float32)
    mv = lambda a: jnp.moveaxis(a, 2, 0)
    _, o = lax.scan(step, s0, (mv(qg), mv(kg), mv(u), mv(w), mv(attn), mv(g_last)))
    return o.transpose(1, 0, 3, 2, 4).reshape(bsz, seq, nh, dv)


def gdn_mixer(qkv, z, b_raw, a_raw, conv_w, a_log, dt_bias, norm_g):
    bsz, seq, _ = z.shape
    qkv = jax.nn.silu(causal_depthwise_conv(qkv, conv_w))
    q, k, v = jnp.split(qkv, [GDN_QK, 2 * GDN_QK], axis=-1)
    q = l2_norm(q.reshape(bsz, seq, GDN_HEADS, GDN_DK))
    k = l2_norm(k.reshape(bsz, seq, GDN_HEADS, GDN_DK))
    v = v.astype(jnp.float32).reshape(bsz, seq, GDN_HEADS, GDN_DV)
    beta = jax.nn.sigmoid(b_raw.astype(jnp.float32))
    g = -jnp.exp(a_log.astype(jnp.float32)) * jax.nn.softplus(a_raw.astype(jnp.float32) + dt_bias.astype(jnp.float32))
    o = gated_delta_chunked(q, k, v, g, beta)
    o = rms_norm(o, norm_g) * jax.nn.silu(z.astype(jnp.float32).reshape(bsz, seq, GDN_HEADS, GDN_DV))
    return o.reshape(bsz, seq, GDN_V).astype(z.dtype)


def mem_cross_attention(h, mem_n, w_q, w_kv, q_g, k_g, w_o):
    bsz, seq, _ = h.shape
    q = rms_norm((h @ w_q).reshape(bsz, seq, X_HEADS, X_HEAD_DIM), q_g)
    k, v = jnp.split(mem_n @ w_kv, 2, axis=-1)
    k = rms_norm(k.reshape(bsz, -1, X_HEADS, X_HEAD_DIM), k_g)
    v = v.reshape(bsz, -1, X_HEADS, X_HEAD_DIM)
    s = jnp.einsum('bshd,bmhd->bhsm', q, k).astype(jnp.float32) * X_HEAD_DIM ** -0.5
    p = jax.nn.softmax(s, axis=-1)
    o = jnp.einsum('bhsm,bmhd->bshd', p.astype(v.dtype), v).reshape(bsz, seq, D_MODEL)
    return o @ w_o


def swiglu(h, w_gate_up, w_down):
    gate, up = jnp.split(h @ w_gate_up, 2, axis=-1)
    return (jax.nn.silu(gate) * up) @ w_down


def setup_inputs(seed: int = 0) -> dict:
    key = jax.random.key(seed)
    ks = jax.random.split(key, 40)
    L = DEPTH
    f32 = jnp.float32
    nrm = lambda k, shape, s: jax.random.normal(k, shape, f32) * s
    gain = lambda k, shape: 1.0 + 0.02 * jax.random.normal(k, shape, f32)

    def dt_bias_init(k, shape):
        dt = jnp.exp(jax.random.uniform(k, shape, f32) * (math.log(0.1) - math.log(1e-3)) + math.log(1e-3))
        return dt + jnp.log(-jnp.expm1(-dt))

    return {
        'x': jax.random.normal(ks[0], (BATCH, SEQ, D_MODEL), f32),
        'mem': jax.random.normal(ks[1], (BATCH, MEM_LEN, D_MODEL), f32),
        'norm_mix_g': gain(ks[2], (L, D_MODEL)),
        'w_in': nrm(ks[3], (L, D_MODEL, P_IN), D_MODEL ** -0.5),
        'w_out': nrm(ks[4], (L, D_MIX, D_MODEL), D_MIX ** -0.5),
        'da_q_norm_g': gain(ks[5], (L, DA_HALF)),
        'da_k_norm_g': gain(ks[6], (L, DA_HALF)),
        'da_lambda_q1': nrm(ks[7], (L, DA_HALF), 0.1),
        'da_lambda_k1': nrm(ks[8], (L, DA_HALF), 0.1),
        'da_lambda_q2': nrm(ks[9], (L, DA_HALF), 0.1),
        'da_lambda_k2': nrm(ks[10], (L, DA_HALF), 0.1),
        'da_sub_norm_g': gain(ks[11], (L, DA_VDIM)),
        'ssd_conv_w': nrm(ks[12], (L, SSD_CONV, SSD_CONV_DIM), SSD_CONV ** -0.5),
        'ssd_conv_b': nrm(ks[13], (L, SSD_CONV_DIM), 0.1),
        'ssd_dt_bias': dt_bias_init(ks[14], (L, SSD_HEADS)),
        'ssd_A_log': jnp.log(jax.random.uniform(ks[15], (L, SSD_HEADS), f32, 1.0, 16.0)),
        'ssd_D': 1.0 + 0.1 * jax.random.normal(ks[16], (L, SSD_HEADS), f32),
        'ssd_norm_g': gain(ks[17], (L, SSD_INNER)),
        'gdn_conv_w': nrm(ks[18], (L, GDN_CONV, GDN_CONV_DIM), GDN_CONV ** -0.5),
        'gdn_A_log': jnp.log(jax.random.uniform(ks[19], (L, GDN_HEADS), f32, 1.0, 16.0)),
        'gdn_dt_bias': dt_bias_init(ks[20], (L, GDN_HEADS)),
        'gdn_norm_g': gain(ks[21], (L, GDN_DV)),
        'norm_x_g': gain(ks[22], (L, D_MODEL)),
        'norm_mem_g': gain(ks[23], (L, D_MODEL)),
        'w_cq': nrm(ks[24], (L, D_MODEL, D_MODEL), D_MODEL ** -0.5),
        'w_ckv': nrm(ks[25], (L, D_MODEL, 2 * D_MODEL), D_MODEL ** -0.5),
        'xq_norm_g': gain(ks[26], (L, X_HEAD_DIM)),
        'xk_norm_g': gain(ks[27], (L, X_HEAD_DIM)),
        'w_co': nrm(ks[28], (L, D_MODEL, D_MODEL), D_MODEL ** -0.5),
        'norm_ffn_g': gain(ks[29], (L, D_MODEL)),
        'w_gate_up': nrm(ks[30], (L, D_MODEL, 2 * D_FF), D_MODEL ** -0.5),
        'w_down': nrm(ks[31], (L, D_FF, D_MODEL), D_FF ** -0.5),
    }


def reference(x, mem, norm_mix_g, w_in, w_out, da_q_norm_g, da_k_norm_g, da_lambda_q1, da_lambda_k1,
              da_lambda_q2, da_lambda_k2, da_sub_norm_g, ssd_conv_w, ssd_conv_b, ssd_dt_bias, ssd_A_log,
              ssd_D, ssd_norm_g, gdn_conv_w, gdn_A_log, gdn_dt_bias, gdn_norm_g, norm_x_g, norm_mem_g,
              w_cq, w_ckv, xq_norm_g, xk_norm_g, w_co, norm_ffn_g, w_gate_up, w_down):
    bsz, seq, _ = x.shape
    offsets = np.cumsum(IN_SIZES)[:-1].tolist()
    f32 = jnp.float32
    for l in range(DEPTH):
        lambda_init = 0.8 - 0.6 * math.exp(-0.3 * l)
        h = rms_norm(x, norm_mix_g[l])
        proj = h @ w_in[l]
        qa, ka, va, z_s, xbc_s, dt_s, qkv_g, z_g, b_g, a_g = jnp.split(proj, offsets, axis=-1)
        lam = (jnp.exp(jnp.sum(da_lambda_q1[l].astype(f32) * da_lambda_k1[l].astype(f32)))
               - jnp.exp(jnp.sum(da_lambda_q2[l].astype(f32) * da_lambda_k2[l].astype(f32))) + lambda_init)
        o_a = diff_attention(qa.reshape(bsz, seq, DA_HEADS, 2, DA_HALF),
                             ka.reshape(bsz, seq, DA_HEADS, 2, DA_HALF),
                             va.reshape(bsz, seq, DA_HEADS, DA_VDIM),
                             lam, da_q_norm_g[l], da_k_norm_g[l], da_sub_norm_g[l], lambda_init).astype(x.dtype)
        o_b = ssd_mixer(z_s, xbc_s, dt_s, ssd_conv_w[l], ssd_conv_b[l], ssd_dt_bias[l], ssd_A_log[l],
                        ssd_D[l], ssd_norm_g[l])
        o_c = gdn_mixer(qkv_g, z_g, b_g, a_g, gdn_conv_w[l], gdn_A_log[l], gdn_dt_bias[l], gdn_norm_g[l])
        x = x + jnp.concatenate([o_a, o_b, o_c], axis=-1) @ w_out[l]
        x = x + mem_cross_attention(rms_norm(x, norm_x_g[l]), rms_norm(mem, norm_mem_g[l]),
                                    w_cq[l], w_ckv[l], xq_norm_g[l], xk_norm_g[l], w_co[l])
        x = x + swiglu(rms_norm(x, norm_ffn_g[l]), w_gate_up[l], w_down[l])
    return x
```

```cpp
#include <hip/hip_runtime.h>
#include <hip/hip_cooperative_groups.h>
#include <hip/hip_bf16.h>
#include <cstdio>
#include <cstdint>
#include <cmath>
namespace cg = cooperative_groups;

#define LAS __attribute__((address_space(3)))
typedef unsigned short bf16_t;
typedef short bf16x8 __attribute__((ext_vector_type(8)));
typedef float f32x4 __attribute__((ext_vector_type(4)));
typedef float f32x2 __attribute__((ext_vector_type(2)));
typedef unsigned u32x4 __attribute__((ext_vector_type(4)));
typedef unsigned u32x2 __attribute__((ext_vector_type(2)));

constexpr int BATCH = 4, SEQ = 4096, DM = 1024, DEPTH = 4, MTOK = BATCH * SEQ;
constexpr int MEM_LEN = 256, NMEM = BATCH * MEM_LEN;
constexpr int P_IN = 3596, PN = 3584;
constexpr int D_FF = 2816;
constexpr float NORM_EPS = 1e-6f;
constexpr float LOG2E = 1.4426950408889634f;

__device__ __forceinline__ unsigned f2bf(float f) { unsigned u = __builtin_bit_cast(unsigned, f); return (u + 0x7fffu + ((u >> 16) & 1u)) >> 16; }
__device__ __forceinline__ unsigned pk2(float lo, float hi) { return f2bf(lo) | (f2bf(hi) << 16); }
__device__ __forceinline__ float bf2f(bf16_t b) { return __builtin_bit_cast(float, (unsigned)b << 16); }
__device__ __forceinline__ float lane_xor(float v, int o, int lane) { return __builtin_bit_cast(float, __builtin_amdgcn_ds_bpermute((lane ^ o) << 2, __builtin_bit_cast(int, v))); }
__device__ __forceinline__ float wave_sum(float v, int lane) {
#pragma unroll
    for (int o = 1; o < 64; o <<= 1) v += lane_xor(v, o, lane);
    return v;
}
__device__ __forceinline__ float wave_incl_scan(float v, int lane) {
#pragma unroll
    for (int o = 1; o < 64; o <<= 1) { const float n = __builtin_bit_cast(float, __builtin_amdgcn_ds_bpermute((lane - o) << 2, __builtin_bit_cast(int, v))); if (lane >= o) v += n; }
    return v;
}
__device__ __forceinline__ float dot4v(f32x4 a) { return (a[0] * a[0] + a[1] * a[1]) + (a[2] * a[2] + a[3] * a[3]); }
__device__ __forceinline__ float silu_f(float x) { return x / (1.f + __expf(-x)); }
__device__ __forceinline__ float sigmoid_f(float x) { return 1.f / (1.f + __expf(-x)); }
__device__ __forceinline__ float softplus_f(float x) { return fmaxf(x, 0.f) + __logf(1.f + __expf(-fabsf(x))); }

namespace pg8 {
#define PG8_LAS __attribute__((address_space(3)))
constexpr int BM = 256, BK = 64, HALF = 128, HTB = HALF * BK * 2  , STAGE_BYTES = 8 * HTB, NXCD = 8, WGM = 8;

__host__ __device__ __forceinline__ int lds_byte(int r, int c) { const int st = (r >> 4) * 2 + (c >> 5), rr = r & 15, cc = c & 31, ob = rr * 64 + cc * 2; return st * 1024 + (ob ^ (((ob >> 9) & 1) << 5)); }
__host__ __device__ __forceinline__ void stage_rc(int b, int& R, int& C) { const int st = b / 1024, sb = b % 1024, swz = sb ^ (((sb >> 9) & 1) << 5); R = (st >> 1) * 16 + swz / 64; C = (st & 1) * 32 + (swz % 64) / 2; }
__host__ __device__ __forceinline__ int perm32(int rho) { const int n = rho >> 4, i = rho & 15; return 8 * (i >> 2) + 4 * n + (i & 3); }

struct Unit { int pm, pn, kind, aux; const char* a; const char* b; };
struct Gemm { int lda, ldb, K; };

struct GridOrder {
    int nM, nN, nwg, G, c;
    __device__ void init(int nM_, int nN_, int G_, int c_) { nM = nM_; nN = nN_; nwg = nM * nN; G = G_; c = c_; }
    __device__ bool tile(int i, int& pm, int& pn) const {
        const long L = (long)i * G + c; if (L >= nwg) return false;
        int wgid = (int)L; { const int q = nwg / NXCD, r = nwg % NXCD, xcd = wgid % NXCD, off = wgid / NXCD; wgid = (xcd < r ? xcd * (q + 1) : r * (q + 1) + (xcd - r) * q) + off; }
        const int nig = WGM * nN, gid = wgid / nig, fm = gid * WGM, gsz = (nM - fm) < WGM ? (nM - fm) : WGM;
        pm = fm + ((wgid % nig) % gsz); pn = (wgid % nig) / gsz; return true;
    }
};
__device__ __forceinline__ unsigned cvt_pk_bf16(float lo, float hi) { unsigned r; asm volatile("v_cvt_pk_bf16_f32 %0, %1, %2" : "=v"(r) : "v"(lo), "v"(hi)); return r; }
template <class Epi, class Sched, bool ALIGN_EPI = false, bool SP2 = false>
__device__ __forceinline__ void gemm_phase(PG8_LAS unsigned char* lds, const Gemm g, const Sched& S, const Epi& E, int tid_in) {
    int tid_l = tid_in; asm volatile("" : "+v"(tid_l));
    const int tid = tid_l, wid = __builtin_amdgcn_readfirstlane(tid >> 6), lane = tid & 63, wr = wid >> 2, wc = wid & 3, fr = lane & 15, fq = lane >> 4;
    const int K = g.K, nt = K / BK;
    unsigned voffA[2], voffB[2];
#pragma unroll
    for (int i = 0; i < 2; ++i) { int R, C; stage_rc(tid * 16 + i * 8192, R, C); const int Rb = Epi::PERM ? ((R & ~31) + perm32(R & 31)) : R;
        voffA[i] = (unsigned)(R * g.lda + C) * 2u; voffB[i] = (unsigned)(Rb * g.ldb + C) * 2u; }
    const size_t kstep = (size_t)(BK * 2);
    const size_t hstepA = (size_t)HALF * g.lda * 2, hstepB = (size_t)HALF * g.ldb * 2;
    const unsigned ldsw = (unsigned)wid * 1024u;
    const int aoff = lds_byte(wr * 64 + fr, fq * 8), boff = lds_byte(wc * 32 + fr, fq * 8);
#define PG8_SA(b, h) (((b) * 2 + (h)) * HTB)
#define PG8_SB(b, h) ((4 + (b) * 2 + (h)) * HTB)
#define PG8_STAGE(bufoff, gbase, voff) do { _Pragma("unroll") for (int _i = 0; _i < 2; ++_i) \
        __builtin_amdgcn_global_load_lds((const unsigned*)((const char*)(gbase) + (voff)[_i]), (PG8_LAS unsigned*)(lds + (bufoff) + ldsw + _i * 8192), 16, 0, 0); } while (0)
#define PG8_LDA(dst, b, h) do { _Pragma("unroll") for (int m = 0; m < 4; ++m) _Pragma("unroll") for (int k = 0; k < 2; ++k) dst[m][k] = *(const PG8_LAS bf16x8*)(lds + PG8_SA(b, h) + aoff + m * 2048 + k * 1024); } while (0)
#define PG8_LDB(dst, b, h) do { _Pragma("unroll") for (int n = 0; n < 2; ++n) _Pragma("unroll") for (int k = 0; k < 2; ++k) dst[n][k] = *(const PG8_LAS bf16x8*)(lds + PG8_SB(b, h) + boff + n * 2048 + k * 1024); } while (0)
#define PG8_MMA(ai, bj, At, Bt) do { __builtin_amdgcn_s_setprio(1); _Pragma("unroll") for (int m = 0; m < 4; ++m) _Pragma("unroll") for (int n = 0; n < 2; ++n) _Pragma("unroll") for (int k = 0; k < 2; ++k) \
        acc[ai][bj][m][n] = __builtin_amdgcn_mfma_f32_16x16x32_bf16(Bt[n][k], At[m][k], acc[ai][bj][m][n], 0, 0, 0); __builtin_amdgcn_s_setprio(0); } while (0)
#define PG8_WAIT_V(n) asm volatile("s_waitcnt vmcnt(" #n ")" ::: "memory")
#define PG8_WAIT_L(n) asm volatile("s_waitcnt lgkmcnt(" #n ")" ::: "memory")
#define PG8_BAR __builtin_amdgcn_s_barrier()
#define PG8_SCHED __builtin_amdgcn_sched_barrier(0)
    Unit cur, nxt; int ui = 0;
    if (!S.next(0, cur)) return;
    f32x4 acc[2][2][4][2];
#pragma unroll
    for (int a = 0; a < 2; ++a)
#pragma unroll
        for (int b = 0; b < 2; ++b)
#pragma unroll
            for (int m = 0; m < 4; ++m)
#pragma unroll
                for (int n = 0; n < 2; ++n) acc[a][b][m][n] = (f32x4){0.f, 0.f, 0.f, 0.f};
    bf16x8 At[4][2], B0[2][2], B1[2][2];
    const char* cA = cur.a; const char* cB = cur.b;
    S.a_ready(cur);
    if constexpr (SP2) {
        PG8_STAGE(PG8_SB(0, 0), cB, voffB); PG8_STAGE(PG8_SB(0, 1), cB + hstepB, voffB); PG8_STAGE(PG8_SA(0, 0), cA, voffA); PG8_STAGE(PG8_SA(0, 1), cA + hstepA, voffA);
        if (wr == 1) PG8_BAR;
        PG8_WAIT_V(2); PG8_BAR;
        PG8_STAGE(PG8_SB(1, 0), cB + kstep, voffB); PG8_STAGE(PG8_SA(1, 0), cA + kstep, voffA); PG8_STAGE(PG8_SB(1, 1), cB + hstepB + kstep, voffB);
        PG8_WAIT_V(6); PG8_BAR;
    } else {
        PG8_STAGE(PG8_SB(0, 0), cB, voffB); PG8_STAGE(PG8_SA(0, 0), cA, voffA); PG8_STAGE(PG8_SB(0, 1), cB + hstepB, voffB); PG8_STAGE(PG8_SA(0, 1), cA + hstepA, voffA);
        if (wr == 1) PG8_BAR;
        PG8_WAIT_V(4); PG8_BAR;
        PG8_STAGE(PG8_SB(1, 0), cB + kstep, voffB); PG8_STAGE(PG8_SA(1, 0), cA + kstep, voffA); PG8_STAGE(PG8_SB(1, 1), cB + hstepB + kstep, voffB);
        PG8_WAIT_V(6); PG8_BAR;
    }
    for (;;) {
        const bool has_next = S.next(ui + 1, nxt);
        const char* nA = has_next ? nxt.a : cA; const char* nB = has_next ? nxt.b : cB;
        for (int t = 0; t < nt; t += 2) {
            const bool last = (t == nt - 2);
            const char* a1 = cA + (size_t)(t + 1) * kstep;
            const char* a2 = last ? nA : cA + (size_t)(t + 2) * kstep; const char* b2 = last ? nB : cB + (size_t)(t + 2) * kstep;
            const char* a3 = a2 + kstep; const char* b3 = b2 + kstep;
            if (last && has_next) S.a_ready(nxt);
            if constexpr (SP2) {
            PG8_LDB(B0, 0, 0); PG8_LDB(B1, 0, 1); PG8_SCHED; PG8_LDA(At, 0, 0); PG8_STAGE(PG8_SA(1, 1), a1 + hstepA, voffA);
            PG8_WAIT_V(8); PG8_WAIT_L(0); PG8_BAR; PG8_MMA(0, 0, At, B0); PG8_MMA(0, 1, At, B1); PG8_BAR; PG8_SCHED;
            PG8_LDA(At, 0, 1); PG8_STAGE(PG8_SB(0, 0), b2, voffB); PG8_STAGE(PG8_SB(0, 1), b2 + hstepB, voffB); PG8_STAGE(PG8_SA(0, 0), a2, voffA);
            PG8_WAIT_V(8); PG8_WAIT_L(0); PG8_BAR; PG8_MMA(1, 0, At, B0); PG8_MMA(1, 1, At, B1); PG8_BAR; PG8_SCHED;
            PG8_LDB(B0, 1, 0); PG8_LDB(B1, 1, 1); PG8_SCHED; PG8_LDA(At, 1, 0); PG8_STAGE(PG8_SA(0, 1), a2 + hstepA, voffA);
            PG8_WAIT_V(8); PG8_WAIT_L(0); PG8_BAR; PG8_MMA(0, 0, At, B0); PG8_MMA(0, 1, At, B1); PG8_BAR; PG8_SCHED;
            PG8_LDA(At, 1, 1); PG8_STAGE(PG8_SB(1, 0), b3, voffB); PG8_STAGE(PG8_SB(1, 1), b3 + hstepB, voffB); PG8_STAGE(PG8_SA(1, 0), a3, voffA);
            PG8_WAIT_V(8); PG8_WAIT_L(0); PG8_BAR; PG8_MMA(1, 0, At, B0); PG8_MMA(1, 1, At, B1); PG8_BAR; PG8_SCHED;
            } else {
            PG8_LDB(B0, 0, 0); PG8_SCHED; PG8_LDA(At, 0, 0); PG8_STAGE(PG8_SA(1, 1), a1 + hstepA, voffA);
            PG8_WAIT_L(8); PG8_BAR; PG8_WAIT_L(0); PG8_MMA(0, 0, At, B0); PG8_BAR; PG8_SCHED;
            PG8_LDB(B1, 0, 1); PG8_STAGE(PG8_SB(0, 0), b2, voffB);
            PG8_BAR; PG8_WAIT_L(0); PG8_MMA(0, 1, At, B1); PG8_BAR;
            PG8_LDA(At, 0, 1); PG8_STAGE(PG8_SA(0, 0), a2, voffA);
            PG8_BAR; PG8_WAIT_L(0); PG8_MMA(1, 0, At, B0); PG8_BAR; PG8_SCHED;
            PG8_STAGE(PG8_SB(0, 1), b2 + hstepB, voffB);
            PG8_WAIT_V(6); PG8_BAR; PG8_MMA(1, 1, At, B1); PG8_BAR;
            PG8_LDB(B0, 1, 0); PG8_SCHED; PG8_LDA(At, 1, 0); PG8_STAGE(PG8_SA(0, 1), a2 + hstepA, voffA);
            PG8_WAIT_L(8); PG8_BAR; PG8_WAIT_L(0); PG8_MMA(0, 0, At, B0); PG8_BAR; PG8_SCHED;
            PG8_LDB(B1, 1, 1); PG8_STAGE(PG8_SB(1, 0), b3, voffB);
            PG8_BAR; PG8_WAIT_L(0); PG8_MMA(0, 1, At, B1); PG8_BAR;
            PG8_LDA(At, 1, 1); PG8_STAGE(PG8_SA(1, 0), a3, voffA);
            PG8_BAR; PG8_WAIT_L(0); PG8_MMA(1, 0, At, B0); PG8_BAR; PG8_SCHED;
            PG8_STAGE(PG8_SB(1, 1), b3 + hstepB, voffB);
            PG8_WAIT_V(6); PG8_BAR; PG8_MMA(1, 1, At, B1); PG8_BAR;
            }
        }
        if constexpr (ALIGN_EPI) { if (wr == 0) PG8_BAR; }
        if constexpr (!Epi::AFTER_DRAIN) { E(acc, cur, wr, wc, fr, fq); S.done(cur); }
        if (!has_next) break;
#pragma unroll
        for (int a = 0; a < 2; ++a)
#pragma unroll
            for (int b = 0; b < 2; ++b)
#pragma unroll
                for (int m = 0; m < 4; ++m)
#pragma unroll
                    for (int n = 0; n < 2; ++n) acc[a][b][m][n] = (f32x4){0.f, 0.f, 0.f, 0.f};
        cur = nxt; cA = nA; cB = nB; ++ui;
        if constexpr (ALIGN_EPI) { if (wr == 1) PG8_BAR; }
    }
    PG8_WAIT_V(0);
    if constexpr (!ALIGN_EPI) { if (wr == 0) PG8_BAR; }
    PG8_BAR;
    if constexpr (Epi::AFTER_DRAIN) { E.fused(acc, cur, wr, wc, fr, fq, lds, wid, lane); S.done(cur); }
#undef PG8_SA
#undef PG8_SB
#undef PG8_STAGE
#undef PG8_LDA
#undef PG8_LDB
#undef PG8_MMA
#undef PG8_WAIT_V
#undef PG8_WAIT_L
#undef PG8_BAR
#undef PG8_SCHED
}
}

namespace pg8 {
typedef f32x4 Acc[2][2][4][2];
constexpr float ATT_C2 = 0.125f * 1.4426950408889634f;
__device__ __forceinline__ float dot4(f32x4 a) { return (a[0] * a[0] + a[1] * a[1]) + (a[2] * a[2] + a[3] * a[3]); }
__device__ __forceinline__ void st_bf16x4(bf16_t* p, f32x4 v) { u32x2 w; w.x = cvt_pk_bf16(v[0], v[1]); w.y = cvt_pk_bf16(v[2], v[3]); *(u32x2*)p = w; }

struct SchedDense {
    GridOrder go; const char* A; const char* Bt; size_t ta, tb;
    __device__ void init(const void* A_, const void* Bt_, int lda, int ldb, int nM, int nN) { go.init(nM, nN, gridDim.x, blockIdx.x); A = (const char*)A_; Bt = (const char*)Bt_; ta = (size_t)256 * lda * 2; tb = (size_t)256 * ldb * 2; }
    __device__ bool next(int i, Unit& u) const { int pm, pn; if (!go.tile(i, pm, pn)) return false; u.pm = pm; u.pn = pn; u.kind = 0; u.aux = 0; u.a = A + pm * ta; u.b = Bt + pn * tb; return true; }
    __device__ __forceinline__ void a_ready(const Unit&) const {}
    __device__ __forceinline__ void done(const Unit&) const {}
};
struct SchedOne {
    Unit u0; bool have;
    __device__ bool next(int i, Unit& u) const { if (i != 0 || !have) return false; u = u0; return true; }
    __device__ __forceinline__ void a_ready(const Unit&) const {}
    __device__ __forceinline__ void done(const Unit&) const {}
};

struct EpiInProj {
    static constexpr bool PERM = false, AFTER_DRAIN = false;
    bf16_t* O; const float* qg; const float* kg;
    __device__ __forceinline__ void operator()(const Acc& acc, const Unit& u, int wr, int wc, int fr, int fq) const {
        const int row0 = u.pm * 256 + wr * 64 + fr, colb = u.pn * 256 + 64 * wc + 4 * fq;
        if (u.pn < 4) {
            const float* g = u.pn < 2 ? qg : kg; const float sc = u.pn < 2 ? ATT_C2 : 1.f;
            f32x4 gv[2][2];
#pragma unroll
            for (int bj = 0; bj < 2; ++bj)
#pragma unroll
                for (int n = 0; n < 2; ++n) gv[bj][n] = *(const f32x4*)(g + 32 * bj + 16 * n + 4 * fq);
#pragma unroll
            for (int ai = 0; ai < 2; ++ai)
#pragma unroll
                for (int m = 0; m < 4; ++m) {
                    float ss = (dot4(acc[ai][0][m][0]) + dot4(acc[ai][0][m][1])) + (dot4(acc[ai][1][m][0]) + dot4(acc[ai][1][m][1]));
                    ss += lane_xor(ss, 16, fq * 16 + fr); ss += lane_xor(ss, 32, fq * 16 + fr);
                    const float r = rsqrtf(ss * (1.f / 64.f) + NORM_EPS) * sc;
                    bf16_t* rowp = O + (size_t)(row0 + ai * 128 + m * 16) * PN + colb;
#pragma unroll
                    for (int bj = 0; bj < 2; ++bj)
#pragma unroll
                        for (int n = 0; n < 2; ++n) st_bf16x4(rowp + 32 * bj + 16 * n, acc[ai][bj][m][n] * r * gv[bj][n]);
                }
        } else {
#pragma unroll
            for (int ai = 0; ai < 2; ++ai)
#pragma unroll
                for (int m = 0; m < 4; ++m) {
                    bf16_t* rowp = O + (size_t)(row0 + ai * 128 + m * 16) * PN + colb;
#pragma unroll
                    for (int bj = 0; bj < 2; ++bj)
#pragma unroll
                        for (int n = 0; n < 2; ++n) st_bf16x4(rowp + 32 * bj + 16 * n, acc[ai][bj][m][n]);
                }
        }
    }
};
struct EpiResid {
    static constexpr bool PERM = false, AFTER_DRAIN = false;
    const float* base; float* out;
    __device__ __forceinline__ void operator()(const Acc& acc, const Unit& u, int wr, int wc, int fr, int fq) const {
        const int row0 = u.pm * 256 + wr * 64 + fr, col0 = u.pn * 256 + wc * 32 + 4 * fq;
#pragma unroll
        for (int ai = 0; ai < 2; ++ai)
#pragma unroll
            for (int m = 0; m < 4; ++m) { const size_t off = (size_t)(row0 + ai * 128 + m * 16) * DM + col0;
#pragma unroll
                for (int bj = 0; bj < 2; ++bj)
#pragma unroll
                    for (int n = 0; n < 2; ++n) { const f32x4 b = *(const f32x4*)(base + off + bj * 128 + n * 16); *(f32x4*)(out + off + bj * 128 + n * 16) = b + acc[ai][bj][m][n]; } }
    }
};
struct EpiSwiGLU {
    static constexpr bool PERM = false, AFTER_DRAIN = false;
    bf16_t* O;
    __device__ __forceinline__ void operator()(const Acc& acc, const Unit& u, int wr, int wc, int fr, int fq) const {
        const int row0 = u.pm * 256 + wr * 64 + fr, col0 = u.pn * 128 + wc * 32 + 4 * fq;
#pragma unroll
        for (int ai = 0; ai < 2; ++ai)
#pragma unroll
            for (int m = 0; m < 4; ++m) { bf16_t* rowp = O + (size_t)(row0 + ai * 128 + m * 16) * D_FF + col0;
#pragma unroll
                for (int n = 0; n < 2; ++n) { const f32x4 g = acc[ai][0][m][n], up = acc[ai][1][m][n]; f32x4 v;
#pragma unroll
                    for (int i = 0; i < 4; ++i) v[i] = g[i] / (1.f + __expf(-g[i])) * up[i];
                    st_bf16x4(rowp + 16 * n, v); } }
    }
};
struct EpiBf16 {
    static constexpr bool PERM = false, AFTER_DRAIN = false;
    bf16_t* O;
    __device__ __forceinline__ void operator()(const Acc& acc, const Unit& u, int wr, int wc, int fr, int fq) const {
        const int row0 = u.pm * 256 + wr * 64 + fr, col0 = u.pn * 256 + wc * 32 + 4 * fq;
#pragma unroll
        for (int ai = 0; ai < 2; ++ai)
#pragma unroll
            for (int m = 0; m < 4; ++m) { bf16_t* rowp = O + (size_t)(row0 + ai * 128 + m * 16) * DM + col0;
#pragma unroll
                for (int bj = 0; bj < 2; ++bj)
#pragma unroll
                    for (int n = 0; n < 2; ++n) st_bf16x4(rowp + bj * 128 + n * 16, acc[ai][bj][m][n]); }
    }
};
#define PG8_BARRIER() do { asm volatile("s_waitcnt lgkmcnt(0)" ::: "memory"); __builtin_amdgcn_s_barrier(); asm volatile("" ::: "memory"); } while (0)
__device__ __forceinline__ void tile_row_rstd(const Acc& acc, float (&rs)[2][4], int wr, int wc, int fr, int fq, PG8_LAS unsigned char* lds) {
    PG8_LAS float* P = (PG8_LAS float*)lds;
#pragma unroll
    for (int ai = 0; ai < 2; ++ai)
#pragma unroll
        for (int m = 0; m < 4; ++m) {
            float ss = (dot4(acc[ai][0][m][0]) + dot4(acc[ai][0][m][1])) + (dot4(acc[ai][1][m][0]) + dot4(acc[ai][1][m][1]));
            ss += lane_xor(ss, 16, fq * 16 + fr); ss += lane_xor(ss, 32, fq * 16 + fr);
            if (fq == 0) P[(ai * 128 + wr * 64 + m * 16 + fr) * 4 + wc] = ss;
        }
    PG8_BARRIER();
#pragma unroll
    for (int ai = 0; ai < 2; ++ai)
#pragma unroll
        for (int m = 0; m < 4; ++m) { const f32x4 p = *(const PG8_LAS f32x4*)(P + (ai * 128 + wr * 64 + m * 16 + fr) * 4); rs[ai][m] = rsqrtf(((p[0] + p[1]) + (p[2] + p[3])) * (1.f / 256.f) + NORM_EPS); }
}
struct EpiQProj {
    static constexpr bool PERM = false, AFTER_DRAIN = true;
    bf16_t* O; const float* g;
    __device__ __forceinline__ void fused(Acc& acc, const Unit& u, int wr, int wc, int fr, int fq, PG8_LAS unsigned char* lds, int wid, int lane) const {
        float rs[2][4]; tile_row_rstd(acc, rs, wr, wc, fr, fq, lds);
        const int row0 = u.pm * 256 + wr * 64 + fr, cl = wc * 32 + 4 * fq;
#pragma unroll
        for (int bj = 0; bj < 2; ++bj)
#pragma unroll
            for (int n = 0; n < 2; ++n) { const f32x4 gv = *(const f32x4*)(g + cl + bj * 128 + n * 16);
#pragma unroll
                for (int ai = 0; ai < 2; ++ai)
#pragma unroll
                    for (int m = 0; m < 4; ++m) st_bf16x4(O + (size_t)(row0 + ai * 128 + m * 16) * DM + u.pn * 256 + cl + bj * 128 + n * 16, acc[ai][bj][m][n] * rs[ai][m] * gv); }
    }
};
struct EpiKV {
    static constexpr bool PERM = false, AFTER_DRAIN = true;
    bf16_t* KN; bf16_t* VT; const float* g;
    __device__ __forceinline__ void fused(Acc& acc, const Unit& u, int wr, int wc, int fr, int fq, PG8_LAS unsigned char* lds, int wid, int lane) const {
        const int l = u.aux;
        if (u.pn < 4) {
            float rs[2][4]; tile_row_rstd(acc, rs, wr, wc, fr, fq, lds);
            bf16_t* Ob = KN + (size_t)l * NMEM * DM; const float* gl = g + l * 256;
            const int row0 = u.pm * 256 + wr * 64 + fr, cl = wc * 32 + 4 * fq;
#pragma unroll
            for (int bj = 0; bj < 2; ++bj)
#pragma unroll
                for (int n = 0; n < 2; ++n) { const f32x4 gv = *(const f32x4*)(gl + cl + bj * 128 + n * 16);
#pragma unroll
                    for (int ai = 0; ai < 2; ++ai)
#pragma unroll
                        for (int m = 0; m < 4; ++m) st_bf16x4(Ob + (size_t)(row0 + ai * 128 + m * 16) * DM + u.pn * 256 + cl + bj * 128 + n * 16, acc[ai][bj][m][n] * rs[ai][m] * gv); }
        } else {
            bf16_t* Ob = VT + ((size_t)(l * 4 + u.pm) * 4 + (u.pn - 4)) * 65536;
            const int r0 = wr * 64 + fr, c0 = wc * 32 + 4 * fq;
#pragma unroll
            for (int ai = 0; ai < 2; ++ai)
#pragma unroll
                for (int m = 0; m < 4; ++m)
#pragma unroll
                    for (int bj = 0; bj < 2; ++bj)
#pragma unroll
                        for (int n = 0; n < 2; ++n)
#pragma unroll
                            for (int i = 0; i < 4; ++i) Ob[(size_t)(c0 + bj * 128 + n * 16 + i) * 256 + r0 + ai * 128 + m * 16] = (bf16_t)f2bf(acc[ai][bj][m][n][i]);
        }
    }
};
struct EpiSoftmax {
    static constexpr bool PERM = false, AFTER_DRAIN = true;
    bf16_t* O;
    __device__ __forceinline__ void fused(Acc& acc, const Unit& u, int wr, int wc, int fr, int fq, PG8_LAS unsigned char* lds, int wid, int lane) const {
        PG8_LAS float* P = (PG8_LAS float*)lds; PG8_LAS float* P2 = (PG8_LAS float*)(lds + 4096);
        const float sc = 0.0625f * LOG2E;
#pragma unroll
        for (int ai = 0; ai < 2; ++ai)
#pragma unroll
            for (int m = 0; m < 4; ++m) {
                float mx = -INFINITY;
#pragma unroll
                for (int bj = 0; bj < 2; ++bj)
#pragma unroll
                    for (int n = 0; n < 2; ++n) { const f32x4 a = acc[ai][bj][m][n]; mx = fmaxf(mx, fmaxf(fmaxf(a[0], a[1]), fmaxf(a[2], a[3]))); }
                mx = fmaxf(mx, lane_xor(mx, 16, fq * 16 + fr)); mx = fmaxf(mx, lane_xor(mx, 32, fq * 16 + fr));
                if (fq == 0) P[(ai * 128 + wr * 64 + m * 16 + fr) * 4 + wc] = mx;
            }
        PG8_BARRIER();
#pragma unroll
        for (int ai = 0; ai < 2; ++ai)
#pragma unroll
            for (int m = 0; m < 4; ++m) {
                const int row = ai * 128 + wr * 64 + m * 16 + fr;
                const f32x4 p = *(const PG8_LAS f32x4*)(P + row * 4); const float mx = fmaxf(fmaxf(p[0], p[1]), fmaxf(p[2], p[3])) * sc;
                float s = 0.f;
#pragma unroll
                for (int bj = 0; bj < 2; ++bj)
#pragma unroll
                    for (int n = 0; n < 2; ++n) { f32x4 a = acc[ai][bj][m][n];
#pragma unroll
                        for (int i = 0; i < 4; ++i) { a[i] = __builtin_amdgcn_exp2f(a[i] * sc - mx); s += a[i]; }
                        acc[ai][bj][m][n] = a; }
                s += lane_xor(s, 16, fq * 16 + fr); s += lane_xor(s, 32, fq * 16 + fr);
                if (fq == 0) P2[row * 4 + wc] = s;
            }
        PG8_BARRIER();
        const int row0 = u.pm * 256 + wr * 64 + fr, col0 = u.pn * 256 + wc * 32 + 4 * fq;
#pragma unroll
        for (int ai = 0; ai < 2; ++ai)
#pragma unroll
            for (int m = 0; m < 4; ++m) {
                const int row = ai * 128 + wr * 64 + m * 16 + fr;
                const f32x4 p = *(const PG8_LAS f32x4*)(P2 + row * 4); const float inv = 1.f / ((p[0] + p[1]) + (p[2] + p[3]));
                bf16_t* rowp = O + (size_t)(row0 + ai * 128 + m * 16) * DM + col0;
#pragma unroll
                for (int bj = 0; bj < 2; ++bj)
#pragma unroll
                    for (int n = 0; n < 2; ++n) st_bf16x4(rowp + bj * 128 + n * 16, acc[ai][bj][m][n] * inv);
            }
    }
};
}
namespace attn_body {
using bf16=__hip_bfloat16;
using bf16x8=__attribute__((ext_vector_type(8)))short;
using s16x4=__attribute__((ext_vector_type(4)))short;
using f32x16=__attribute__((ext_vector_type(16)))float;
using u32x4=__attribute__((ext_vector_type(4)))unsigned;
constexpr int BATCH=4,NHEAD=16,SEQ=4096,D=64,PQ=3584,PO=1024;
constexpr int NW=8,QBLK=32,QB=QBLK*NW,KVBLK=64,NQB=SEQ/QB;
constexpr int ATTN_UNIT_ROWS=QB;
__device__ __forceinline__ int crow(int r,int hi){return (r&3)+8*(r>>2)+4*hi;}
#define SBAR() __builtin_amdgcn_sched_barrier(0)
__device__ __forceinline__ void cmask(f32x16&p0,f32x16&p1,int jb,int qrel,int hi){
  const float NEG=-INFINITY; int kb=64*jb+4*hi;
  #pragma unroll
  for(int r=0;r<16;++r){int kv=kb+(r&3)+8*(r>>2); if(kv>qrel)p0[r]=NEG; if(kv+32>qrel)p1[r]=NEG;}
}

constexpr int NSLOT=3, SLOTB=8192;
constexpr int LDS_K=0, LDS_V=NSLOT*SLOTB, LDS_WS=2*NSLOT*SLOTB, LDS_OST=LDS_WS+NW*64*4, LDS_BYTES=LDS_OST+NW*4096;
constexpr float C2=0.125f*1.4426950408889634f;
__device__ __forceinline__ void glds16(const void*gsrc,unsigned lds_dst){unsigned keep;
  asm volatile("s_mov_b32 %0, m0\n\ts_mov_b32 m0, %2\n\ts_nop 0\n\tglobal_load_lds_dwordx4 %1, off\n\ts_mov_b32 m0, %0":"=&s"(keep):"v"(gsrc),"s"(lds_dst):"memory");}
__device__ __forceinline__ float max3f(float a,float b,float c){float r;asm("v_max3_f32 %0, %1, %2, %3":"=v"(r):"v"(a),"v"(b),"v"(c));return r;}
__device__ __forceinline__ float max2f(float a,float b){float r;asm("v_max_f32_e32 %0, %1, %2":"=v"(r):"v"(a),"v"(b));return r;}
__device__ __forceinline__ float fadd_s(float a,float b){float r;asm("v_add_f32_e32 %0, %1, %2":"=v"(r):"v"(a),"v"(b));return r;}
__device__ __forceinline__ float fsub_s(float a,float b){float r;asm("v_sub_f32_e32 %0, %1, %2":"=v"(r):"v"(a),"v"(b));return r;}
typedef float f32x2_t __attribute__((ext_vector_type(2))); typedef __bf16 bf16x2_t __attribute__((ext_vector_type(2)));
__device__ __forceinline__ unsigned cvtpk_s(float lo,float hi){f32x2_t v={lo,hi};bf16x2_t b=__builtin_convertvector(v,bf16x2_t);return __builtin_bit_cast(unsigned,b);}
#define WAIT_BAR(N) asm volatile("s_waitcnt vmcnt(" #N ") lgkmcnt(0)\n\ts_barrier":::"memory")

__device__ __forceinline__ void qkt(f32x16&p0,f32x16&p1,const char*Kslot,const bf16x8*qr,const f32x16&negm,int r32,int hi){
  const char*kb=Kslot+hi*1024+r32*16;
  #pragma unroll
  for(int d0=0;d0<4;++d0){
    const bf16x8 b0=*reinterpret_cast<const bf16x8*>(kb+d0*2048);
    const bf16x8 b1=*reinterpret_cast<const bf16x8*>(kb+d0*2048+512);
    if(d0==0){p0=__builtin_amdgcn_mfma_f32_32x32x16_bf16(b0,qr[0],negm,0,0,0);p1=__builtin_amdgcn_mfma_f32_32x32x16_bf16(b1,qr[0],negm,0,0,0);}
    else{p0=__builtin_amdgcn_mfma_f32_32x32x16_bf16(b0,qr[d0],p0,0,0,0);p1=__builtin_amdgcn_mfma_f32_32x32x16_bf16(b1,qr[d0],p1,0,0,0);}}
}
typedef __attribute__((address_space(3))) const char* lds_cptr;
typedef short v4i16_t __attribute__((ext_vector_type(4)));
__device__ __forceinline__ void kload8(bf16x8*kf,lds_cptr kp){
  kf[0]=*(const __attribute__((address_space(3))) bf16x8*)(kp);      kf[1]=*(const __attribute__((address_space(3))) bf16x8*)(kp+512);
  kf[2]=*(const __attribute__((address_space(3))) bf16x8*)(kp+2048); kf[3]=*(const __attribute__((address_space(3))) bf16x8*)(kp+2560);
  kf[4]=*(const __attribute__((address_space(3))) bf16x8*)(kp+4096); kf[5]=*(const __attribute__((address_space(3))) bf16x8*)(kp+4608);
  kf[6]=*(const __attribute__((address_space(3))) bf16x8*)(kp+6144); kf[7]=*(const __attribute__((address_space(3))) bf16x8*)(kp+6656);
}
__device__ __forceinline__ void kload2(bf16x8*kf,lds_cptr kp,int j){ kf[2*j]=*(const __attribute__((address_space(3))) bf16x8*)(kp+j*2048); kf[2*j+1]=*(const __attribute__((address_space(3))) bf16x8*)(kp+j*2048+512); }
__device__ __forceinline__ s16x4 vtr(lds_cptr p){ return __builtin_bit_cast(s16x4,__builtin_amdgcn_ds_read_tr16_b64_v4i16((__attribute__((address_space(3))) v4i16_t*)p)); }
__device__ __forceinline__ float rowmax(const f32x16&p0,const f32x16&p1){
  float a=max3f(p0[0],p0[1],p1[0]),b=max3f(p0[2],p0[3],p1[1]);a=max3f(a,p1[2],p1[3]);
  #pragma unroll
  for(int r=4;r<16;r+=4){a=max3f(a,p0[r],p0[r+1]);b=max3f(b,p0[r+2],p0[r+3]);a=max3f(a,p1[r],p1[r+1]);b=max3f(b,p1[r+2],p1[r+3]);}
  const float m=max2f(a,b);
  auto rr=__builtin_amdgcn_permlane32_swap(__float_as_uint(m),__float_as_uint(m),false,false);
  return max2f(__uint_as_float(rr[0]),__uint_as_float(rr[1]));
}
__device__ __forceinline__ void pv(f32x16*o,int vb,bf16x8 pa0,bf16x8 pa1,bf16x8 pa2,bf16x8 pa3){
  #pragma unroll
  for(int d0=0;d0<2;++d0){s16x4 lo[4],hi[4];
    #pragma unroll
    for(int ks=0;ks<4;++ks){
      asm volatile("ds_read_b64_tr_b16 %0,%1 offset:%c2":"=&v"(lo[ks]):"v"(vb),"i"(d0*4096+ks*1024):"memory");
      asm volatile("ds_read_b64_tr_b16 %0,%1 offset:%c2":"=&v"(hi[ks]):"v"(vb),"i"(d0*4096+ks*1024+512):"memory");}
    asm volatile("s_waitcnt lgkmcnt(0)":::"memory");SBAR();
    #define PK(k) (bf16x8){lo[k][0],lo[k][1],lo[k][2],lo[k][3],hi[k][0],hi[k][1],hi[k][2],hi[k][3]}
    o[d0]=__builtin_amdgcn_mfma_f32_32x32x16_bf16(pa0,PK(0),o[d0],0,0,0);
    o[d0]=__builtin_amdgcn_mfma_f32_32x32x16_bf16(pa1,PK(1),o[d0],0,0,0);
    o[d0]=__builtin_amdgcn_mfma_f32_32x32x16_bf16(pa2,PK(2),o[d0],0,0,0);
    o[d0]=__builtin_amdgcn_mfma_f32_32x32x16_bf16(pa3,PK(3),o[d0],0,0,0);
    #undef PK
  }
}

#ifndef ATTN_STORE16
#define ATTN_STORE16(p,v) (*(u32x4*)(p)=(v))
#endif
template<int THRL> __device__ __forceinline__ void attn_unit(int b,int h,int qb,const bf16*Q,const bf16*__restrict__ K,const bf16*__restrict__ V,bf16*O,char*shm,int tid_in){
  int tid_l=tid_in; asm volatile("":"+v"(tid_l)); const int tid=tid_l,lane=tid&63,r32=lane&31,hi=lane>>5; const int wid=__builtin_amdgcn_readfirstlane(tid>>6);
  const long rowbase=(long)b*SEQ; const int q0=qb*QB;
  const bf16*Qw=Q+(rowbase+q0+wid*QBLK)*PQ+(h>>1)*D;
  const bf16*Kh=K+rowbase*PQ+512+(h>>1)*D,*Vh=V+rowbase*PQ+1024+(h>>2)*128+(h&1)*D;
  const unsigned lds0=(unsigned)(uintptr_t)shm;
  float*wsf=(float*)(shm+LDS_WS)+wid*64;
  const bf16*ksrc=Kh+(long)lane*PQ+wid*8;
  const bf16*vsrc=Vh+(long)(16*(wid&3)+(lane>>2))*PQ+(wid>>2)*32+(lane&3)*8;
  const unsigned kdst=lds0+LDS_K+wid*1024, vdst=lds0+LDS_V+wid*1024;
  #define DMA_K(t,slot) glds16(ksrc+(long)(t)*KVBLK*PQ,(unsigned)__builtin_amdgcn_readfirstlane(kdst+(slot)))
  #define DMA_V(t,slot) glds16(vsrc+(long)(t)*KVBLK*PQ,(unsigned)__builtin_amdgcn_readfirstlane(vdst+(slot)))
  const int vb0=(int)(lds0+LDS_V)+((lane>>4)&1)*32+(lane&3)*8+(4*hi+((lane&15)>>2))*64;
  const char*Kbase=shm+LDS_K; bf16x8 kf[8];
  const lds_cptr shm3=(lds_cptr)shm; const lds_cptr kp0=shm3+LDS_K+hi*1024+r32*16; const lds_cptr vp0=shm3+LDS_V+((lane>>4)&1)*32+(lane&3)*8+(4*hi+((lane&15)>>2))*64;
  const int NT=(q0+QB)/KVBLK;
  DMA_K(0,0);DMA_V(0,0);DMA_K(1,SLOTB);
  bf16x8 qr[4];
  #pragma unroll
  for(int d0=0;d0<4;++d0)qr[d0]=*reinterpret_cast<const bf16x8*>(&Qw[(long)r32*PQ+d0*16+hi*8]);
  float mhat=0.f,l_reg=0.f;f32x16 o[2];o[0]=f32x16{};o[1]=f32x16{};f32x16 negm=f32x16{};asm volatile("":"+v"(negm));
  const int qrel=wid*QBLK+r32;
  #define CMASK(P0,P1,t) do{int jb_=(t)-(NT-4); if(jb_>=0)cmask(P0,P1,jb_,qrel,hi);}while(0)
  bool resc=false;
  #define START(P0,P1) do{ const float rm=rowmax(P0,P1); resc=false; \
    { const float dl=rm; mhat=fadd_s(mhat,dl); \
      _Pragma("unroll") for(int r=0;r<16;++r){P0[r]=fsub_s(P0[r],dl);P1[r]=fsub_s(P1[r],dl);} \
      _Pragma("unroll") for(int r=0;r<16;++r)negm[r]=-mhat; asm volatile("":"+v"(negm)); } \
    _Pragma("unroll") for(int r=0;r<16;++r)P0[r]=__builtin_amdgcn_exp2f(P0[r]); }while(0)
  #define RESC() do{ if(resc){ asm volatile("s_waitcnt lgkmcnt(0)":::"memory"); \
      _Pragma("unroll") for(int d_=0;d_<2;++d_) _Pragma("unroll") for(int r=0;r<16;++r)o[d_][r]*=wsf[crow(r,hi)]; } }while(0)
  f32x16 pA0,pA1,pB0,pB1;
  int sl_prev=0,sl_cur=0,sl_next=SLOTB;
  #define ROT() do{sl_prev=sl_cur;sl_cur=sl_next;sl_next=(sl_next==(NSLOT-1)*SLOTB)?0:sl_next+SLOTB;}while(0)
  DMA_K(2,2*SLOTB);
  WAIT_BAR(3);
  qkt(pA0,pA1,Kbase,qr,negm,r32,hi);asm volatile("s_nop 15\n\ts_nop 7":"+v"(pA0),"+v"(pA1));CMASK(pA0,pA1,0);
  START(pA0,pA1);
  _Pragma("unroll") for(int r=0;r<16;++r)pA1[r]=__builtin_amdgcn_exp2f(pA1[r]);
  WAIT_BAR(0);
  DMA_K(3,0);DMA_V(1,SLOTB);
  ROT();
  kload8(kf,kp0+sl_cur);
  WAIT_BAR(2);
  s16x4 vlo[8],vhi[8]; u32x4 pw0,pw1,pw2,pw3;
  #define PKW(P,B) cvtpk_s(P[B],P[B+1])
  #define PAF(k) __builtin_bit_cast(bf16x8,pw##k)
  #define VFR(i) (bf16x8){vlo[i][0],vlo[i][1],vlo[i][2],vlo[i][3],vhi[i][0],vhi[i][1],vhi[i][2],vhi[i][3]}
  #define PIN(x) asm volatile("":"+v"(x))
  #define MX3(a,b,c) __builtin_fmaxf(__builtin_fmaxf((a),(b)),(c))
  #define GAPA(MF,A0,A1,A2,A3,W0,W1,PW) do{ MF; sacc+=A0; sacc+=A1; sacc+=A2; sacc+=A3; PIN(sacc); W0; W1; PIN(PW); SBAR(); }while(0)
  #define EX(v) __builtin_amdgcn_exp2f(v)
  #define GAPB(MF,X,B) do{ MF; X[B]=EX(X[B]); X[B+1]=EX(X[B+1]); X[B+2]=EX(X[B+2]); X[B+3]=EX(X[B+3]); PIN(X); SBAR(); }while(0)
  #define VRD(i) do{ vlo[i]=vtr(vp_+(((i)>>2)*4096+((i)&3)*1024)); vhi[i]=vtr(vp_+(((i)>>2)*4096+((i)&3)*1024+512)); }while(0)
  #define KRD(G,j) do{ if(G){ kload2(kf,kp0+sl_next,j); SBAR(); } }while(0)
  #define STEP(C0,C1,P0,P1,t,GK,GV,GL) do{ SBAR(); \
    const lds_cptr vp_=vp0+sl_prev; \
    VRD(0); SBAR(); float sacc=(P0[0]+P0[1]); \
    GAPA(C0=__builtin_amdgcn_mfma_f32_32x32x16_bf16(kf[0],qr[0],negm,0,0,0), P0[2],P0[3],P0[4],P0[5],     pw0[0]=PKW(P0,0), pw0[1]=PKW(P0,2), pw0); \
    VRD(4); SBAR(); GAPA(C1=__builtin_amdgcn_mfma_f32_32x32x16_bf16(kf[1],qr[0],negm,0,0,0), P0[6],P0[7],P0[8],P0[9],     pw0[2]=PKW(P0,4), pw0[3]=PKW(P0,6), pw0); \
    VRD(1); SBAR(); GAPA(C0=__builtin_amdgcn_mfma_f32_32x32x16_bf16(kf[2],qr[1],C0,0,0,0),   P0[10],P0[11],P0[12],P0[13], pw1[0]=PKW(P0,8), pw1[1]=PKW(P0,10), pw1); \
    VRD(5); SBAR(); GAPA(C1=__builtin_amdgcn_mfma_f32_32x32x16_bf16(kf[3],qr[1],C1,0,0,0),   P0[14],P0[15],P1[0],P1[1],   pw1[2]=PKW(P0,12),pw1[3]=PKW(P0,14), pw1); \
    VRD(2); SBAR(); GAPA(C0=__builtin_amdgcn_mfma_f32_32x32x16_bf16(kf[4],qr[2],C0,0,0,0),   P1[2],P1[3],P1[4],P1[5],     pw2[0]=PKW(P1,0), pw2[1]=PKW(P1,2), pw2); \
    VRD(6); SBAR(); GAPA(C1=__builtin_amdgcn_mfma_f32_32x32x16_bf16(kf[5],qr[2],C1,0,0,0),   P1[6],P1[7],P1[8],P1[9],     pw2[2]=PKW(P1,4), pw2[3]=PKW(P1,6), pw2); \
    VRD(3); SBAR(); GAPA(C0=__builtin_amdgcn_mfma_f32_32x32x16_bf16(kf[6],qr[3],C0,0,0,0),   P1[10],P1[11],P1[12],P1[13], pw3[0]=PKW(P1,8), pw3[1]=PKW(P1,10), pw3); \
    VRD(7); SBAR(); GAPA(C1=__builtin_amdgcn_mfma_f32_32x32x16_bf16(kf[7],qr[3],C1,0,0,0),   P1[14],P1[15],0.f,0.f,       pw3[2]=PKW(P1,12),pw3[3]=PKW(P1,14), pw3); \
    l_reg+=sacc; \
    if(GK){DMA_K((t)+3,sl_cur);} if(GV){DMA_V((t)+1,sl_next);} \
    CMASK(C0,C1,t); \
    { float a=MX3(C0[0],C0[1],C1[0]),b=MX3(C0[2],C0[3],C1[1]); a=MX3(a,C1[2],C1[3]); \
      _Pragma("unroll") for(int r=4;r<16;r+=4){a=MX3(a,C0[r],C0[r+1]);b=MX3(b,C0[r+2],C0[r+3]);a=MX3(a,C1[r],C1[r+1]);b=MX3(b,C1[r+2],C1[r+3]);} \
      float rm=__builtin_fmaxf(a,b); { auto rr=__builtin_amdgcn_permlane32_swap(__float_as_uint(rm),__float_as_uint(rm),false,false); rm=__builtin_fmaxf(__uint_as_float(rr[0]),__uint_as_float(rr[1])); } \
      resc=false; \
      if(__builtin_expect(__any(rm>(float)THRL),0)){ const float dl=__builtin_fmaxf(rm,0.f); mhat+=dl; \
        _Pragma("unroll") for(int r=0;r<16;++r){C0[r]-=dl;C1[r]-=dl;} \
        _Pragma("unroll") for(int r=0;r<16;++r)negm[r]=-mhat; asm volatile("":"+v"(negm)); \
        const float f=__builtin_amdgcn_exp2f(-dl); l_reg*=f; if(hi==0)wsf[r32]=f; resc=true; } } \
    SBAR(); \
    GAPB(o[0]=__builtin_amdgcn_mfma_f32_32x32x16_bf16(PAF(0),VFR(0),o[0],0,0,0), C0,0); \
    GAPB(o[1]=__builtin_amdgcn_mfma_f32_32x32x16_bf16(PAF(0),VFR(4),o[1],0,0,0), C0,4); \
    KRD(GL,0); GAPB(o[0]=__builtin_amdgcn_mfma_f32_32x32x16_bf16(PAF(1),VFR(1),o[0],0,0,0), C0,8); \
    KRD(GL,1); GAPB(o[1]=__builtin_amdgcn_mfma_f32_32x32x16_bf16(PAF(1),VFR(5),o[1],0,0,0), C0,12); \
    KRD(GL,2); GAPB(o[0]=__builtin_amdgcn_mfma_f32_32x32x16_bf16(PAF(2),VFR(2),o[0],0,0,0), C1,0); \
    KRD(GL,3); GAPB(o[1]=__builtin_amdgcn_mfma_f32_32x32x16_bf16(PAF(2),VFR(6),o[1],0,0,0), C1,4); \
    GAPB(o[0]=__builtin_amdgcn_mfma_f32_32x32x16_bf16(PAF(3),VFR(3),o[0],0,0,0), C1,8); \
    GAPB(o[1]=__builtin_amdgcn_mfma_f32_32x32x16_bf16(PAF(3),VFR(7),o[1],0,0,0), C1,12); \
    }while(0)
  int t=1;
  #undef CMASK
  #define CMASK(P0,P1,t) do{}while(0)
  for(;t+5<NT;t+=2){
    STEP(pB0,pB1,pA0,pA1,t,true,true,true);     WAIT_BAR(2); RESC(); ROT();
    STEP(pA0,pA1,pB0,pB1,t+1,true,true,true);   WAIT_BAR(2); RESC(); ROT();
  }
  #undef CMASK
  #define CMASK(P0,P1,t) do{int jb_=(t)-(NT-4); if(jb_>=0)cmask(P0,P1,jb_,qrel,hi);}while(0)
  #define ENDW(tt) do{ if((tt)+3<NT){WAIT_BAR(2);} else if((tt)+2<NT){WAIT_BAR(1);} else {WAIT_BAR(0);} }while(0)
  for(;t+1<NT;t+=2){
    STEP(pB0,pB1,pA0,pA1,t,(t+3<NT),(t+1<NT),(t+1<NT));       ENDW(t);   RESC(); ROT();
    STEP(pA0,pA1,pB0,pB1,t+1,(t+4<NT),(t+2<NT),(t+2<NT));     ENDW(t+1); RESC(); ROT();
  }
  STEP(pB0,pB1,pA0,pA1,NT-1,false,false,false); RESC();
  { float sacc=pB0[0]+pB0[1]; _Pragma("unroll") for(int r=2;r<16;++r)sacc+=pB0[r]; _Pragma("unroll") for(int r=0;r<16;++r)sacc+=pB1[r]; l_reg+=sacc;
    pw0=(u32x4){PKW(pB0,0),PKW(pB0,2),PKW(pB0,4),PKW(pB0,6)};pw1=(u32x4){PKW(pB0,8),PKW(pB0,10),PKW(pB0,12),PKW(pB0,14)};pw2=(u32x4){PKW(pB1,0),PKW(pB1,2),PKW(pB1,4),PKW(pB1,6)};pw3=(u32x4){PKW(pB1,8),PKW(pB1,10),PKW(pB1,12),PKW(pB1,14)};
    SBAR(); pv(o,vb0+sl_cur,PAF(0),PAF(1),PAF(2),PAF(3)); }
  #undef PKW
  #undef PAF
  #undef VFR
  #undef PIN
  #undef MX3
  #undef GAPA
  #undef GAPB
  #undef EX
  #undef VRD
  #undef KRD
  #undef STEP
  #undef ENDW
  {auto rr=__builtin_amdgcn_permlane32_swap(__float_as_uint(l_reg),__float_as_uint(l_reg),false,false);l_reg=__uint_as_float(rr[0])+__uint_as_float(rr[1]);}
  if(hi==0)wsf[32+r32]=l_reg;asm volatile("s_waitcnt lgkmcnt(0)":::"memory");
  float rli[16];
  #pragma unroll
  for(int r=0;r<16;++r)rli[r]=__builtin_amdgcn_rcpf(wsf[32+crow(r,hi)]);
  bf16*Ow=O+(rowbase+q0+wid*QBLK)*PO+h*D;
  { bf16*stg=(bf16*)(shm+LDS_OST)+wid*2048;
    #pragma unroll
    for(int r=0;r<16;++r){const int orow=crow(r,hi);
      #pragma unroll
      for(int d0=0;d0<2;++d0)stg[orow*64+d0*32+r32]=__float2bfloat16(o[d0][r]*rli[r]);}
    asm volatile("s_waitcnt lgkmcnt(0)":::"memory");
    #pragma unroll
    for(int i=0;i<4;++i){const int row=i*8+(lane>>3),ch=lane&7; const u32x4 v=*(const u32x4*)(stg+row*64+ch*8); ATTN_STORE16(Ow+(long)row*PO+ch*8,v);} }
  asm volatile("s_waitcnt lgkmcnt(0)\n\ts_barrier":::"memory");
  #undef DMA_K
  #undef DMA_V
  #undef CMASK
  #undef START
  #undef RESC
  #undef ROT
}
constexpr int ATTN_LDS_BYTES=LDS_BYTES;
#undef SBAR
#undef WAIT_BAR
}

namespace mk {
struct Params { const float* in[32]; float* out; unsigned char* ws; };
enum { I_X = 0, I_MEM, I_NMIX, I_WIN, I_WOUT, I_QG, I_KG, I_LQ1, I_LK1, I_LQ2, I_LK2, I_SUBG, I_SCW, I_SCB, I_SDTB, I_SALOG, I_SD, I_SNG,
       I_GCW, I_GALOG, I_GDTB, I_GNG, I_NX, I_NMEM, I_WCQ, I_WCKV, I_XQG, I_XKG, I_WCO, I_NFFN, I_WGU, I_WDN };
__device__ __forceinline__ const float* pin(const Params& p, int i) { asm volatile("" : "+s"(i)); return p.in[i]; }
__device__ __forceinline__ unsigned char* wsp(const Params& p) { unsigned char* w = p.ws; asm volatile("" : "+s"(w)); return w; }
__device__ __forceinline__ float* outp(const Params& p) { float* w = p.out; asm volatile("" : "+s"(w)); return w; }
constexpr size_t MiB = 1u << 20;
constexpr size_t WS_CTL = 0, CTL_BYTES = 64 * 1024;
constexpr size_t WS_WIN = 2 * MiB, WS_WOUT = 9 * MiB, WS_WCQ = 11 * MiB, WS_WCO = 13 * MiB, WS_WGU = 15 * MiB, WS_WDN = 26 * MiB;
constexpr size_t WS_WCKV = 32 * MiB;
constexpr size_t WS_MEMN = 48 * MiB;
constexpr size_t WS_KN = 56 * MiB;
constexpr size_t WS_VT = 64 * MiB;
constexpr size_t WS_H = 72 * MiB;
constexpr size_t WS_SM = 104 * MiB;
constexpr size_t WS_PROJ = 106 * MiB;
constexpr size_t WS_AO = 218 * MiB;
constexpr size_t WS_CAT = 250 * MiB;
constexpr size_t WS_YS = 282 * MiB;
constexpr size_t WS_ST = 298 * MiB;
constexpr size_t WS_HP = 314 * MiB;
constexpr size_t WS_CM = 322 * MiB;
constexpr size_t WS_EA = 330 * MiB;
constexpr size_t WS_OG = 331 * MiB;
constexpr size_t WS_END = 347 * MiB;
constexpr size_t WS_GW = WS_H, WS_GQG = WS_H + 8 * MiB, WS_GATT = WS_H + 16 * MiB, WS_GKGT = WS_H + 24 * MiB, WS_GU = WS_CAT;
constexpr int LDS_BYTES = 160 * 1024;
constexpr int LDS_SLOT = LDS_BYTES - 256;

__device__ __forceinline__ void lds_wait() { asm volatile("s_waitcnt lgkmcnt(0)" ::: "memory"); }

template <int M, int N, int K, class Epi>
__device__ __forceinline__ void mm16(const LAS bf16_t* A, int lda, const LAS bf16_t* Bt, int ldb, int wid, int lane, Epi epi) {
    const int fr = lane & 15, fq = lane >> 4;
    constexpr int NB = N / 16, NBLK = (M / 16) * NB;
    for (int blk = wid; blk < NBLK; blk += 8) {
        const int mb = blk / NB, nb = blk % NB;
        f32x4 acc = {0.f, 0.f, 0.f, 0.f};
        const LAS bf16_t* ap = A + (mb * 16 + fr) * lda + fq * 8;
        const LAS bf16_t* bp = Bt + (nb * 16 + fr) * ldb + fq * 8;
#pragma unroll
        for (int k0 = 0; k0 < K; k0 += 32) acc = __builtin_amdgcn_mfma_f32_16x16x32_bf16(*(const LAS bf16x8*)(ap + k0), *(const LAS bf16x8*)(bp + k0), acc, 0, 0, 0);
#pragma unroll
        for (int i = 0; i < 4; ++i) epi(mb * 16 + fq * 4 + i, nb * 16 + fr, acc[i]);
    }
}

__device__ __forceinline__ int maprow(int mode, int n) {
    if (mode == 0) return n;
    if (mode == 1) { if ((n >= 2560 && n < 2564) || n >= 3588) return -1; const int c = n < 2560 ? n : n - 4; const int cl = c & 255; return (c & ~255) + 128 * ((cl >> 5) & 1) + 32 * (cl >> 6) + (cl & 31); }
    if (n < D_FF) return (n >> 7) * 256 + (n & 127);
    const int n2 = n - D_FF; return (n2 >> 7) * 256 + 128 + (n2 & 127);
}
__device__ __forceinline__ void transpose_item(const float* W, int K, int N, bf16_t* WT, int mode, LAS float* scr, int item, int lane) {
    const int nblk = (N + 31) / 32, kb = item / nblk, nb = item % nblk, k0 = 64 * kb, n0 = 32 * nb;
    const int nl = n0 + (lane & 31); const bool okn = nl < N;
#pragma unroll 8
    for (int i = 0; i < 32; ++i) { const int kk = 2 * i + (lane >> 5); scr[kk * 33 + (lane & 31)] = okn ? W[(size_t)(k0 + kk) * N + nl] : 0.f; }
    lds_wait(); asm volatile("" ::: "memory");
    const int c = lane & 7;
#pragma unroll
    for (int j = 0; j < 4; ++j) { const int nn = (lane >> 3) + 8 * j; const int n = n0 + nn; const int row = n < N ? maprow(mode, n) : -1; const LAS float* s = scr + (8 * c) * 33 + nn;
        u32x4 o; o.x = pk2(s[0 * 33], s[1 * 33]); o.y = pk2(s[2 * 33], s[3 * 33]); o.z = pk2(s[4 * 33], s[5 * 33]); o.w = pk2(s[6 * 33], s[7 * 33]);
        if (row >= 0) *(u32x4*)(WT + (size_t)row * K + k0 + 8 * c) = o; }
    lds_wait(); asm volatile("" ::: "memory");
}
__device__ __forceinline__ void norm_row(const float* xrow, const float* g, bf16_t* orow, int lane, f32x4 (&y)[4]) {
    const f32x4* xr = (const f32x4*)xrow + lane; const f32x4* gr = (const f32x4*)g + lane;
    float s = 0.f;
#pragma unroll
    for (int j = 0; j < 4; ++j) { y[j] = xr[64 * j]; s += dot4v(y[j]); }
    const float rstd = rsqrtf(wave_sum(s, lane) * (1.f / DM) + NORM_EPS);
    unsigned long long* o8 = (unsigned long long*)orow + lane;
#pragma unroll
    for (int j = 0; j < 4; ++j) { y[j] = y[j] * rstd * gr[64 * j]; o8[64 * j] = (unsigned long long)pk2(y[j][0], y[j][1]) | ((unsigned long long)pk2(y[j][2], y[j][3]) << 32); }
}

__device__ __forceinline__ void phase_a(const Params& p, int l, LAS unsigned char* lds, int tid, int lane, int wid) {
    asm volatile("" : "+v"(lds));
    unsigned char* ws = wsp(p);
    const int gw = blockIdx.x * 8 + wid, NGW = gridDim.x * 8;
    LAS float* scr = (LAS float*)(lds + wid * 16384);
    {
        constexpr int I_IN = 16 * 113, I_SQ = 16 * 32, I_GU = 16 * 176, I_DN = 44 * 32;
        constexpr int NIT = I_IN + 3 * I_SQ + I_GU + I_DN;
        for (int it = gw; it < NIT; it += NGW) {
            int r = it;
            if (r < I_IN) { transpose_item(pin(p, I_WIN) + (size_t)l * DM * P_IN, DM, P_IN, (bf16_t*)(ws + WS_WIN), 1, scr, r, lane); continue; } r -= I_IN;
            if (r < I_SQ) { transpose_item(pin(p, I_WOUT) + (size_t)l * DM * DM, DM, DM, (bf16_t*)(ws + WS_WOUT), 0, scr, r, lane); continue; } r -= I_SQ;
            if (r < I_SQ) { transpose_item(pin(p, I_WCQ) + (size_t)l * DM * DM, DM, DM, (bf16_t*)(ws + WS_WCQ), 0, scr, r, lane); continue; } r -= I_SQ;
            if (r < I_SQ) { transpose_item(pin(p, I_WCO) + (size_t)l * DM * DM, DM, DM, (bf16_t*)(ws + WS_WCO), 0, scr, r, lane); continue; } r -= I_SQ;
            if (r < I_GU) { transpose_item(pin(p, I_WGU) + (size_t)l * DM * 2 * D_FF, DM, 2 * D_FF, (bf16_t*)(ws + WS_WGU), 2, scr, r, lane); continue; } r -= I_GU;
            transpose_item(pin(p, I_WDN) + (size_t)l * D_FF * DM, D_FF, DM, (bf16_t*)(ws + WS_WDN), 0, scr, r, lane);
        }
        if (l == 0) {
            for (int it = gw; it < 4 * 1024; it += NGW) { const int ll = it >> 10;
                transpose_item(pin(p, I_WCKV) + (size_t)ll * DM * 2048, DM, 2048, (bf16_t*)(ws + WS_WCKV) + (size_t)ll * 2048 * DM, 0, scr, it & 1023, lane); }
            for (int m = gw; m < 4 * NMEM; m += NGW) { const int ll = m >> 10, r = m & 1023; f32x4 y[4];
                norm_row(pin(p, I_MEM) + (size_t)r * DM, pin(p, I_NMEM) + ll * DM, (bf16_t*)(ws + WS_MEMN) + (size_t)m * DM, lane, y); }
        }
    }
    __syncthreads();
    LAS float* Wsm = (LAS float*)lds;
    {
        const float* wl = pin(p, I_WIN) + (size_t)l * DM * P_IN;
        for (int idx = tid; idx < 3 * DM; idx += 512) { const int k = idx / 3, grp = idx % 3; const int c0 = grp == 0 ? 2560 : (grp == 1 ? 3588 : 3592);
            const f32x4 v = *(const f32x4*)(wl + (size_t)k * P_IN + c0);
#pragma unroll
            for (int i = 0; i < 4; ++i) Wsm[(grp * 4 + i) * DM + k] = v[i]; }
    }
    __syncthreads();
    const float* xin = (l == 0) ? pin(p, I_X) : outp(p);
    const float* g = pin(p, I_NMIX) + l * DM;
    bf16_t* H = (bf16_t*)(ws + WS_H); float* SM = (float*)(ws + WS_SM);
    for (int m = gw; m < MTOK; m += NGW) {
        f32x4 y[4]; norm_row(xin + (size_t)m * DM, g, H + (size_t)m * DM, lane, y);
        float keep = 0.f;
#pragma unroll
        for (int jj = 0; jj < 12; ++jj) { float s = 0.f;
#pragma unroll
            for (int j = 0; j < 4; ++j) { const f32x4 w = *(const LAS f32x4*)(Wsm + jj * DM + 4 * (lane + 64 * j)); s += (y[j][0] * w[0] + y[j][1] * w[1]) + (y[j][2] * w[2] + y[j][3] * w[3]); }
            s = wave_sum(s, lane); if (lane == jj) keep = s; }
        if (lane < 12) SM[(size_t)m * 12 + lane] = keep;
    }
}
__device__ __forceinline__ void phase_norm(const Params& p, const float* g, int lane, int wid) {
    const int gw = blockIdx.x * 8 + wid, NGW = gridDim.x * 8;
    bf16_t* H = (bf16_t*)(wsp(p) + WS_H);
    for (int m = gw; m < MTOK; m += NGW) { f32x4 y[4]; norm_row(outp(p) + (size_t)m * DM, g, H + (size_t)m * DM, lane, y); }
}

__device__ __forceinline__ void unpack8(u32x4 v, float (&f)[8]) {
#pragma unroll
    for (int i = 0; i < 4; ++i) { f[2 * i] = __builtin_bit_cast(float, v[i] << 16); f[2 * i + 1] = __builtin_bit_cast(float, v[i] & 0xffff0000u); }
}

__device__ __forceinline__ void ssd_prep_unit(const Params& p, int l, int unit, LAS unsigned char* lds, int tid, int lane, int wid) {
    asm volatile("" : "+v"(lds));
    unsigned char* ws = wsp(p);
    const int h = unit & 3, c = (unit >> 2) & 31, b = unit >> 7, g = h >> 1;
    const int tok0 = b * SEQ + c * 128;
    const bf16_t* PROJ = (const bf16_t*)(ws + WS_PROJ); const float* SM = (const float*)(ws + WS_SM);
    LAS bf16_t* Cm = (LAS bf16_t*)(lds); LAS bf16_t* Bm = (LAS bf16_t*)(lds + 34816); LAS bf16_t* BmT = (LAS bf16_t*)(lds + 69632);
    LAS bf16_t* XSt = (LAS bf16_t*)(lds + 104448); LAS bf16_t* XDt = (LAS bf16_t*)(lds + 121856);
    LAS float* dtv = (LAS float*)(lds + 139264); LAS float* acum = (LAS float*)(lds + 139264 + 512);
    const float a_neg = -__expf(pin(p, I_SALOG)[l * 4 + h]);
    if (tid < 128) dtv[tid] = softplus_f(SM[(size_t)(tok0 + tid) * 12 + h] + pin(p, I_SDTB)[l * 4 + h]);
    __syncthreads();
    if (wid == 0) { const float s0 = wave_incl_scan(dtv[lane] * a_neg, lane); const float tot = __builtin_bit_cast(float, __builtin_amdgcn_readlane(__builtin_bit_cast(int, s0), 63)); const float s1 = wave_incl_scan(dtv[lane + 64] * a_neg, lane) + tot; acum[lane] = s0; acum[lane + 64] = s1; }
    __syncthreads();
    if (tid < 320) {
        const int o = tid % 40, tg = tid / 40;
        int ch; if (o < 8) ch = h * 64 + o * 8; else if (o < 24) ch = 256 + g * 128 + (o - 8) * 8; else ch = 512 + g * 128 + (o - 24) * 8;
        const float* cw = pin(p, I_SCW) + (size_t)l * 4 * 768 + ch; const float* cb = pin(p, I_SCB) + (size_t)l * 768 + ch;
        float w0[8], w1[8], w2[8], w3[8], bs[8];
#pragma unroll
        for (int j = 0; j < 8; ++j) { w0[j] = cw[j]; w1[j] = cw[768 + j]; w2[j] = cw[2 * 768 + j]; w3[j] = cw[3 * 768 + j]; bs[j] = cb[j]; }
        const bf16_t* src = PROJ + (size_t)tok0 * PN + 1792 + ch;
        float x0[8], x1[8], x2[8], cur[8];
        const int t0 = tg * 16; const int sp = c * 128 + t0;
#pragma unroll
        for (int j = 0; j < 8; ++j) { x0[j] = 0.f; x1[j] = 0.f; x2[j] = 0.f; }
        if (sp >= 3) { unpack8(*(const u32x4*)(src + (ptrdiff_t)(t0 - 3) * PN), x0); unpack8(*(const u32x4*)(src + (ptrdiff_t)(t0 - 2) * PN), x1); unpack8(*(const u32x4*)(src + (ptrdiff_t)(t0 - 1) * PN), x2); }
        const float alast = acum[127];
        for (int tt = 0; tt < 16; ++tt) {
            const int t = t0 + tt;
            unpack8(*(const u32x4*)(src + (size_t)t * PN), cur);
            float v[8];
#pragma unroll
            for (int j = 0; j < 8; ++j) { const float a = bs[j] + ((w0[j] * x0[j] + w1[j] * x1[j]) + (w2[j] * x2[j] + w3[j] * cur[j])); v[j] = silu_f(a); x0[j] = x1[j]; x1[j] = x2[j]; x2[j] = cur[j]; }
            if (o < 8) {
                const float sc = dtv[t] * __expf(alast - acum[t]);
#pragma unroll
                for (int j = 0; j < 8; ++j) { XSt[(o * 8 + j) * 136 + t] = (bf16_t)f2bf(v[j]); XDt[(o * 8 + j) * 136 + t] = (bf16_t)f2bf(v[j] * sc); }
            } else {
                u32x4 pk; pk.x = pk2(v[0], v[1]); pk.y = pk2(v[2], v[3]); pk.z = pk2(v[4], v[5]); pk.w = pk2(v[6], v[7]);
                if (o < 24) { const int n0 = (o - 8) * 8; *(LAS u32x4*)(Bm + t * 136 + n0) = pk;
#pragma unroll
                    for (int j = 0; j < 8; ++j) BmT[(n0 + j) * 136 + t] = (bf16_t)f2bf(v[j]);
                } else { const int n0 = (o - 24) * 8; *(LAS u32x4*)(Cm + t * 136 + n0) = pk;
                    if ((h & 1) == 0) *(u32x4*)((bf16_t*)(ws + WS_CM) + (size_t)(tok0 + t) * 256 + g * 128 + n0) = pk; }
            }
        }
    }
    __syncthreads();
    {
        float* ST = (float*)(ws + WS_ST) + (size_t)unit * 8192;
        mm16<64, 128, 128>(XDt, 136, BmT, 136, wid, lane, [&](int pp, int n, float v) { ST[pp * 128 + n] = v; });
    }
    __syncthreads();
    {
        LAS bf16_t* Sc = BmT;
        mm16<128, 128, 128>(Cm, 136, Bm, 136, wid, lane, [&](int li, int s, float v) { Sc[li * 136 + s] = (li >= s) ? (bf16_t)f2bf(v * __expf(acum[li] - acum[s]) * dtv[s]) : (bf16_t)0; });
    }
    __syncthreads();
    {
        const float Dh = pin(p, I_SD)[l * 4 + h];
        float* Y = (float*)(ws + WS_YS);
        mm16<128, 64, 128>(BmT, 136, XSt, 136, wid, lane, [&](int li, int pp, float v) { Y[(size_t)(tok0 + li) * 256 + h * 64 + pp] = v + Dh * bf2f(XSt[pp * 136 + li]); });
        if (tid < 128) ((float*)(ws + WS_EA))[(size_t)(tok0 + tid) * 4 + h] = __expf(acum[tid]);
        if (tid == 0) ((float*)(ws + WS_EA + 512 * 1024))[unit] = __expf(acum[127]);
    }
    __syncthreads();
}
__device__ __forceinline__ void ssd_scan_unit(const Params& p, int su, int tid) {
    unsigned char* ws = wsp(p); const int b = su >> 2, h = su & 3;
    f32x4 hs[4];
#pragma unroll
    for (int j = 0; j < 4; ++j) hs[j] = (f32x4){0.f, 0.f, 0.f, 0.f};
    const float* DEC = (const float*)(ws + WS_EA + 512 * 1024);
    for (int c = 0; c < 32; ++c) {
        const int unit = (b * 32 + c) * 4 + h;
        const float* src = (const float*)(ws + WS_ST) + (size_t)unit * 8192; bf16_t* dst = (bf16_t*)(ws + WS_HP) + (size_t)unit * 8192;
        const float dec = DEC[unit];
#pragma unroll
        for (int j = 0; j < 4; ++j) { const int e = (tid + 512 * j) * 4; u32x2 w; w.x = pk2(hs[j][0], hs[j][1]); w.y = pk2(hs[j][2], hs[j][3]); *(u32x2*)(dst + e) = w; hs[j] = hs[j] * dec + *(const f32x4*)(src + e); }
    }
}

__device__ __forceinline__ void gdn_prep_unit(const Params& p, int l, int gu, LAS unsigned char* lds, int tid, int lane, int wid) {
    asm volatile("" : "+v"(lds));
    unsigned char* ws = wsp(p);
    const int c = gu & 63, h = (gu >> 6) & 3, b = gu >> 8;
    const int tok0 = b * SEQ + c * 64;
    const bf16_t* PROJ = (const bf16_t*)(ws + WS_PROJ); const float* SM = (const float*)(ws + WS_SM);
    LAS float* QKVf = (LAS float*)lds;
    LAS bf16_t* Qs = (LAS bf16_t*)(lds + 49408); LAS bf16_t* Ks = (LAS bf16_t*)(lds + 58624);
    LAS float* Tm = (LAS float*)(lds + 67840);
    LAS float* RHS = (LAS float*)(lds + 85248);
    LAS float* betas = (LAS float*)(lds + 119040); LAS float* gcs = (LAS float*)(lds + 119296);
    if (tid < 64) {
        const float braw = SM[(size_t)(tok0 + tid) * 12 + 4 + h], araw = SM[(size_t)(tok0 + tid) * 12 + 8 + h];
        betas[tid] = sigmoid_f(braw);
        const float gl = -__expf(pin(p, I_GALOG)[l * 4 + h]) * softplus_f(araw + pin(p, I_GDTB)[l * 4 + h]);
        gcs[tid] = wave_incl_scan(gl, lane);
    }
    if (tid < 384) {
        const int o = tid % 24, tg = tid / 24;
        const int ch = (o >> 3) * 256 + h * 64 + (o & 7) * 8;
        const float* cw = pin(p, I_GCW) + (size_t)l * 4 * 768 + ch;
        float w0[8], w1[8], w2[8], w3[8];
#pragma unroll
        for (int j = 0; j < 8; ++j) { w0[j] = cw[j]; w1[j] = cw[768 + j]; w2[j] = cw[2 * 768 + j]; w3[j] = cw[3 * 768 + j]; }
        const bf16_t* src = PROJ + (size_t)tok0 * PN + 2560 + ch;
        float x0[8], x1[8], x2[8], cur[8];
        const int t0 = tg * 4; const int sp = c * 64 + t0;
#pragma unroll
        for (int j = 0; j < 8; ++j) { x0[j] = 0.f; x1[j] = 0.f; x2[j] = 0.f; }
        if (sp >= 3) { unpack8(*(const u32x4*)(src + (ptrdiff_t)(t0 - 3) * PN), x0); unpack8(*(const u32x4*)(src + (ptrdiff_t)(t0 - 2) * PN), x1); unpack8(*(const u32x4*)(src + (ptrdiff_t)(t0 - 1) * PN), x2); }
#pragma unroll
        for (int tt = 0; tt < 4; ++tt) {
            const int t = t0 + tt;
            unpack8(*(const u32x4*)(src + (size_t)t * PN), cur);
#pragma unroll
            for (int j = 0; j < 8; ++j) { const float a = (w0[j] * x0[j] + w1[j] * x1[j]) + (w2[j] * x2[j] + w3[j] * cur[j]); QKVf[t * 193 + o * 8 + j] = silu_f(a); x0[j] = x1[j]; x1[j] = x2[j]; x2[j] = cur[j]; }
        }
    }
    __syncthreads();
    if (tid < 128) {
        const int t = tid & 63, which = tid >> 6;
        const LAS float* row = QKVf + t * 193 + which * 64;
        float ss = 0.f;
        for (int d = 0; d < 64; ++d) ss += row[d] * row[d];
        const float rinv = rsqrtf(ss + 1e-6f);
        const float gct = gcs[t];
        if (which == 0) {
            const float sc = rinv * 0.125f, eg = __expf(gct);
            bf16_t* QG = (bf16_t*)(ws + WS_GQG) + (size_t)gu * 4096 + t * 64;
            for (int d = 0; d < 64; d += 2) { const float v0 = row[d] * sc, v1 = row[d + 1] * sc; *(LAS unsigned*)(Qs + t * 72 + d) = pk2(v0, v1); *(unsigned*)(QG + d) = pk2(v0 * eg, v1 * eg); }
        } else {
            const float bt = betas[t] * __expf(gct), ek = __expf(gcs[63] - gct);
            bf16_t* KGT = (bf16_t*)(ws + WS_GKGT) + (size_t)gu * 4096;
            for (int d = 0; d < 64; d += 2) { const float v0 = row[d] * rinv, v1 = row[d + 1] * rinv; *(LAS unsigned*)(Ks + t * 72 + d) = pk2(v0, v1);
                RHS[t * 132 + 64 + d] = v0 * bt; RHS[t * 132 + 64 + d + 1] = v1 * bt; KGT[d * 64 + t] = (bf16_t)f2bf(v0 * ek); KGT[(d + 1) * 64 + t] = (bf16_t)f2bf(v1 * ek); }
        }
    }
    for (int idx = tid; idx < 4096; idx += 512) { const int t = idx >> 6, d = idx & 63; RHS[t * 132 + d] = QKVf[t * 193 + 128 + d] * betas[t]; }
    __syncthreads();
    mm16<64, 64, 64>(Ks, 72, Ks, 72, wid, lane, [&](int i, int j, float v) { Tm[i * 68 + j] = (i > j) ? v * betas[i] * __expf(gcs[i] - gcs[j]) : 0.f; });
    {
        bf16_t* ATT = (bf16_t*)(ws + WS_GATT) + (size_t)gu * 4096;
        mm16<64, 64, 64>(Qs, 72, Ks, 72, wid, lane, [&](int i, int j, float v) { ATT[i * 64 + j] = (i >= j) ? (bf16_t)f2bf(v * __expf(gcs[i] - gcs[j])) : (bf16_t)0; });
    }
    if (tid == 0) ((float*)(ws + WS_EA + 768 * 1024))[gu] = __expf(gcs[63]);
    __syncthreads();
    if (tid < 128) {
        float x[64];
#pragma unroll
        for (int i = 0; i < 64; ++i) {
            float a = RHS[i * 132 + tid];
#pragma unroll
            for (int j4 = 0; j4 < (i + 3) / 4; ++j4) { const f32x4 t4 = *(const LAS f32x4*)(Tm + i * 68 + 4 * j4);
#pragma unroll
                for (int q = 0; q < 4; ++q) if (4 * j4 + q < i) a -= t4[q] * x[4 * j4 + q]; }
            x[i] = a;
        }
        if (tid < 64) { float* U = (float*)(ws + WS_GU) + (size_t)gu * 4096 + tid;
#pragma unroll
            for (int i = 0; i < 64; ++i) U[i * 64] = x[i];
        } else { bf16_t* W = (bf16_t*)(ws + WS_GW) + (size_t)gu * 4096 + (tid - 64);
#pragma unroll
            for (int i = 0; i < 64; ++i) W[i * 64] = (bf16_t)f2bf(x[i]); }
    }
    __syncthreads();
}

__device__ __forceinline__ void gdn_chain_unit(const Params& p, int cu, LAS unsigned char* lds, int tid, int lane, int wid) {
    asm volatile("" : "+v"(lds));
    unsigned char* ws = wsp(p); const int b = cu >> 2, h = cu & 3;
    const int fr = lane & 15, fq = lane >> 4;
    constexpr int BUF = 54272;
    LAS bf16_t* St = (LAS bf16_t*)(lds + 2 * BUF); LAS bf16_t* VnT = (LAS bf16_t*)(lds + 2 * BUF + 9216);
    const bf16_t* gW = (const bf16_t*)(ws + WS_GW) + (size_t)cu * 64 * 4096; const bf16_t* gQG = (const bf16_t*)(ws + WS_GQG) + (size_t)cu * 64 * 4096;
    const bf16_t* gAT = (const bf16_t*)(ws + WS_GATT) + (size_t)cu * 64 * 4096; const bf16_t* gKT = (const bf16_t*)(ws + WS_GKGT) + (size_t)cu * 64 * 4096;
    const float* gU = (const float*)(ws + WS_GU) + (size_t)cu * 64 * 4096; const float* GL = (const float*)(ws + WS_EA + 768 * 1024) + cu * 64;
    float* OG = (float*)(ws + WS_OG);
    f32x4 sreg[2] = {(f32x4){0.f, 0.f, 0.f, 0.f}, (f32x4){0.f, 0.f, 0.f, 0.f}};
    for (int i = tid; i < 64 * 72 / 2; i += 512) ((LAS unsigned*)St)[i] = 0u;
    const int lrow = tid >> 3, lc8 = (tid & 7) * 8;
    u32x4 rw, rq, ra, rk; f32x4 ru[2];
    auto gload = [&](int c) { const size_t o = (size_t)c * 4096 + lrow * 64 + lc8; rw = *(const u32x4*)(gW + o); rq = *(const u32x4*)(gQG + o); ra = *(const u32x4*)(gAT + o); rk = *(const u32x4*)(gKT + o);
#pragma unroll
        for (int i = 0; i < 2; ++i) ru[i] = *(const f32x4*)(gU + (size_t)c * 4096 + (tid + 512 * i) * 4); };
    auto lstore = [&](int buf) { LAS unsigned char* B = lds + buf * BUF; const int o = (lrow * 72 + lc8) * 2;
        *(LAS u32x4*)(B + o) = rw; *(LAS u32x4*)(B + 9216 + o) = rq; *(LAS u32x4*)(B + 18432 + o) = ra; *(LAS u32x4*)(B + 27648 + o) = rk;
#pragma unroll
        for (int i = 0; i < 2; ++i) { const int idx = tid + 512 * i; *(LAS f32x4*)(B + 36864 + ((idx >> 4) * 68 + (idx & 15) * 4) * 4) = ru[i]; } };
    gload(0); lstore(0);
    __syncthreads();
    for (int c = 0; c < 64; ++c) {
        LAS unsigned char* B = lds + (c & 1) * BUF;
        const LAS bf16_t* Wt = (const LAS bf16_t*)B; const LAS bf16_t* QGt = (const LAS bf16_t*)(B + 9216); const LAS bf16_t* ATt = (const LAS bf16_t*)(B + 18432); const LAS bf16_t* KTt = (const LAS bf16_t*)(B + 27648);
        const LAS float* Ut = (const LAS float*)(B + 36864);
        if (c + 1 < 64) gload(c + 1);
        mm16<64, 64, 64>(Wt, 72, St, 72, wid, lane, [&](int t, int dv, float v) { VnT[dv * 72 + t] = (bf16_t)f2bf(Ut[t * 68 + dv] - v); });
        __syncthreads();
        const float gl = GL[c];
        const int tokc = b * SEQ + c * 64;
#pragma unroll
        for (int bi = 0; bi < 2; ++bi) {
            const int blk = wid + 8 * bi, mb = blk >> 2, nb = blk & 3;
            f32x4 acc = {0.f, 0.f, 0.f, 0.f}, acs = {0.f, 0.f, 0.f, 0.f};
            const LAS bf16_t* sp = St + (nb * 16 + fr) * 72 + fq * 8; const LAS bf16_t* vp = VnT + (nb * 16 + fr) * 72 + fq * 8;
            const int ao = (mb * 16 + fr) * 72 + fq * 8;
#pragma unroll
            for (int k0 = 0; k0 < 64; k0 += 32) {
                acc = __builtin_amdgcn_mfma_f32_16x16x32_bf16(*(const LAS bf16x8*)(QGt + ao + k0), *(const LAS bf16x8*)(sp + k0), acc, 0, 0, 0);
                acc = __builtin_amdgcn_mfma_f32_16x16x32_bf16(*(const LAS bf16x8*)(ATt + ao + k0), *(const LAS bf16x8*)(vp + k0), acc, 0, 0, 0);
                acs = __builtin_amdgcn_mfma_f32_16x16x32_bf16(*(const LAS bf16x8*)(KTt + ao + k0), *(const LAS bf16x8*)(vp + k0), acs, 0, 0, 0);
            }
#pragma unroll
            for (int i = 0; i < 4; ++i) OG[(size_t)(tokc + mb * 16 + fq * 4 + i) * 256 + h * 64 + nb * 16 + fr] = acc[i];
            sreg[bi] = sreg[bi] * gl + acs;
        }
        __syncthreads();
#pragma unroll
        for (int bi = 0; bi < 2; ++bi) { const int blk = wid + 8 * bi, mb = blk >> 2, nb = blk & 3;
            u32x2 w; w.x = pk2(sreg[bi][0], sreg[bi][1]); w.y = pk2(sreg[bi][2], sreg[bi][3]);
            *(LAS u32x2*)(St + (nb * 16 + fr) * 72 + mb * 16 + fq * 4) = w; }
        if (c + 1 < 64) lstore((c + 1) & 1);
        __syncthreads();
    }
}

__device__ __forceinline__ void phase_e_unit(const Params& p, int l, int tile, LAS unsigned char* lds, int tid, int lane, int wid) {
    asm volatile("" : "+v"(lds));
    unsigned char* ws = wsp(p);
    const int tok0 = tile * 64, b = tile >> 6, c = (tile & 63) >> 1;
    const bf16_t* PROJ = (const bf16_t*)(ws + WS_PROJ); bf16_t* CAT = (bf16_t*)(ws + WS_CAT);
    const float lambda_init = 0.8f - 0.6f * __expf(-0.3f * (float)l);
    float lam;
    { const float d1 = wave_sum(pin(p, I_LQ1)[l * 64 + lane] * pin(p, I_LK1)[l * 64 + lane], lane), d2 = wave_sum(pin(p, I_LQ2)[l * 64 + lane] * pin(p, I_LK2)[l * 64 + lane], lane); lam = __expf(d1) - __expf(d2) + lambda_init; }
    {
        const bf16_t* AO = (const bf16_t*)(ws + WS_AO); const float* sg = pin(p, I_SUBG) + l * 128;
        const float g0 = sg[lane], g1 = sg[64 + lane], post = 1.f - lambda_init;
        for (int task = wid; task < 256; task += 8) { const int tok = tok0 + (task >> 2), hh = task & 3;
            const bf16_t* r = AO + (size_t)tok * 1024 + hh * 256 + lane;
            const float v0 = bf2f(r[0]) - lam * bf2f(r[128]), v1 = bf2f(r[64]) - lam * bf2f(r[192]);
            const float rr = rsqrtf(wave_sum(v0 * v0 + v1 * v1, lane) * (1.f / 128.f) + NORM_EPS) * post;
            bf16_t* o = CAT + (size_t)tok * 1024 + hh * 128 + lane; o[0] = (bf16_t)f2bf(v0 * rr * g0); o[64] = (bf16_t)f2bf(v1 * rr * g1); }
    }
    {
        const float* OG = (const float*)(ws + WS_OG); const float gn = pin(p, I_GNG)[l * 64 + lane];
        for (int task = wid; task < 256; task += 8) { const int tok = tok0 + (task >> 2), hh = task & 3;
            const float v = OG[(size_t)tok * 256 + hh * 64 + lane];
            const float rr = rsqrtf(wave_sum(v * v, lane) * (1.f / 64.f) + NORM_EPS);
            const float z = bf2f(PROJ[(size_t)tok * PN + 3328 + hh * 64 + lane]);
            CAT[(size_t)tok * 1024 + 768 + hh * 64 + lane] = (bf16_t)f2bf(v * rr * gn * silu_f(z)); }
    }
    LAS bf16_t* CMg = (LAS bf16_t*)lds; LAS bf16_t* HPs = (LAS bf16_t*)(lds + 17408); LAS float* Yb = (LAS float*)(lds + 17408 + 34816);
    const float* Y = (const float*)(ws + WS_YS); const float* EA = (const float*)(ws + WS_EA);
    for (int g = 0; g < 2; ++g) {
        for (int idx = tid; idx < 1024; idx += 512) { const int r = idx >> 4, c8 = (idx & 15) * 8;
            *(LAS u32x4*)(CMg + r * 136 + c8) = *(const u32x4*)((const bf16_t*)(ws + WS_CM) + (size_t)(tok0 + r) * 256 + g * 128 + c8); }
        for (int idx = tid; idx < 2048; idx += 512) { const int hh = idx >> 10, r = (idx >> 4) & 63, c8 = (idx & 15) * 8;
            *(LAS u32x4*)(HPs + (hh * 64 + r) * 136 + c8) = *(const u32x4*)((const bf16_t*)(ws + WS_HP) + (size_t)((b * 32 + c) * 4 + 2 * g + hh) * 8192 + r * 128 + c8); }
        __syncthreads();
        for (int hh = 0; hh < 2; ++hh) { const int h = 2 * g + hh;
            mm16<64, 64, 128>(CMg, 136, HPs + hh * 64 * 136, 136, wid, lane, [&](int r, int pp, float v) { const size_t tok = tok0 + r;
                float y = Y[tok * 256 + h * 64 + pp] + v * EA[tok * 4 + h]; const float z = bf2f(PROJ[tok * PN + 1536 + h * 64 + pp]); Yb[r * 132 + hh * 64 + pp] = y * silu_f(z); }); }
        __syncthreads();
        { const float* gn = pin(p, I_SNG) + l * 256 + g * 128; const float g0 = gn[lane], g1 = gn[64 + lane];
            for (int r = wid; r < 64; r += 8) { const float v0 = Yb[r * 132 + lane], v1 = Yb[r * 132 + 64 + lane];
                const float rr = rsqrtf(wave_sum(v0 * v0 + v1 * v1, lane) * (1.f / 128.f) + NORM_EPS);
                bf16_t* o = CAT + (size_t)(tok0 + r) * 1024 + 512 + g * 128 + lane; o[0] = (bf16_t)f2bf(v0 * rr * g0); o[64] = (bf16_t)f2bf(v1 * rr * g1); } }
        __syncthreads();
    }
}
}

namespace mk {
__device__ __forceinline__ int q_next(unsigned* ctr, LAS unsigned char* lds, int tid) {
    LAS int* slot = (LAS int*)(lds + LDS_SLOT);
    __syncthreads();
    if (tid == 0) *slot = (int)atomicAdd(ctr, 1u);
    __syncthreads();
    return __builtin_amdgcn_readfirstlane(*slot);
}
}

#ifndef MK_LAYERS
#define MK_LAYERS DEPTH
#endif

#define IDS int tid; asm volatile("v_mbcnt_lo_u32_b32 %0, -1, 0\n\tv_mbcnt_hi_u32_b32 %0, -1, %0" : "=v"(tid)); tid += wid0 * 64; asm volatile("" : "+v"(tid)); const int lane = tid & 63, wid = __builtin_amdgcn_readfirstlane(tid >> 6); (void)lane; (void)wid
#define WSV unsigned char* ws = wsp(p); unsigned* ctl = (unsigned*)(ws + WS_CTL); bf16_t* H = (bf16_t*)(ws + WS_H); bf16_t* PROJ = (bf16_t*)(ws + WS_PROJ); bf16_t* AO = (bf16_t*)(ws + WS_AO); bf16_t* CAT = (bf16_t*)(ws + WS_CAT); \
    bf16_t* QX = AO; bf16_t* PB = PROJ; bf16_t* OX = CAT; bf16_t* HID = PROJ; (void)ctl; (void)H; (void)PROJ; (void)AO; (void)CAT; (void)QX; (void)PB; (void)OX; (void)HID
__global__ void __launch_bounds__(512, 2) mega_fwd(mk::Params p) {
    using namespace mk;
    extern __shared__ __attribute__((aligned(16))) unsigned char lds_raw[];
    cg::grid_group grid = cg::this_grid();
    LAS unsigned char* lds = (LAS unsigned char*)lds_raw;
    const int bid = blockIdx.x;
    const int wid0 = __builtin_amdgcn_readfirstlane((int)threadIdx.x >> 6);
    { IDS; phase_a(p, 0, lds, tid, lane, wid); }
    grid.sync();
    {
        WSV; pg8::SchedOne S; S.have = bid < 128; const int ll = bid >> 5, r = bid & 31;
        S.u0.pm = r >> 3; S.u0.pn = r & 7; S.u0.kind = 0; S.u0.aux = ll;
        S.u0.a = (const char*)(ws + WS_MEMN) + ((size_t)ll * NMEM + S.u0.pm * 256) * DM * 2;
        S.u0.b = (const char*)(ws + WS_WCKV) + ((size_t)ll * 2048 + S.u0.pn * 256) * DM * 2;
        pg8::EpiKV E{(bf16_t*)(ws + WS_KN), (bf16_t*)(ws + WS_VT), pin(p, I_XKG)};
        { IDS; pg8::gemm_phase<pg8::EpiKV, pg8::SchedOne, false, true>(lds, pg8::Gemm{DM, DM, DM}, S, E, tid); }
        __syncthreads();
    }
#pragma unroll 1
    for (int l = 0; l < MK_LAYERS; ++l) {
        {
            WSV; pg8::SchedDense S; S.init(H, ws + WS_WIN, DM, DM, MTOK / 256, PN / 256);
            pg8::EpiInProj E{PROJ, pin(p, I_QG) + l * 64, pin(p, I_KG) + l * 64};
            { IDS; pg8::gemm_phase<pg8::EpiInProj, pg8::SchedDense, true, true>(lds, pg8::Gemm{DM, DM, DM}, S, E, tid); }
        }
        grid.sync();
        {
            IDS; WSV; unsigned* ctr = ctl + (l * 2 + 0) * 64;
            for (;;) { const int idx = q_next(ctr, lds, tid); if (idx >= 1536) break;
#ifndef SKIP_GPREP
                if (idx < 1024) gdn_prep_unit(p, l, idx, lds, tid, lane, wid);
#endif
#ifndef SKIP_SPREP
                if (idx >= 1024) ssd_prep_unit(p, l, idx - 1024, lds, tid, lane, wid);
#endif
            }
        }
        grid.sync();
        {
            IDS; WSV; unsigned* ctr = ctl + (l * 2 + 1) * 64;
            for (;;) { const int idx = q_next(ctr, lds, tid); if (idx >= 32 + 1024) break;
#ifndef SKIP_GCHAIN
                if (idx < 16) gdn_chain_unit(p, idx, lds, tid, lane, wid);
#endif
                if (idx >= 16 && idx < 32) ssd_scan_unit(p, idx - 16, tid);
#ifndef SKIP_ATTN
                if (idx >= 32) { const int a = idx - 32, qb = 15 - (a >> 6), bh = a & 63;
                    attn_body::attn_unit<8>(bh >> 4, bh & 15, qb, (const attn_body::bf16*)PROJ, (const attn_body::bf16*)PROJ, (const attn_body::bf16*)PROJ, (attn_body::bf16*)AO, (char*)lds_raw, tid); }
#endif
            }
        }
        grid.sync();
#ifndef SKIP_E
        { IDS; for (int tile = bid; tile < MTOK / 64; tile += gridDim.x) phase_e_unit(p, l, tile, lds, tid, lane, wid); }
#endif
        grid.sync();
        {
            WSV; pg8::SchedDense S; S.init(CAT, ws + WS_WOUT, DM, DM, MTOK / 256, 4);
            pg8::EpiResid E{l == 0 ? pin(p, I_X) : outp(p), outp(p)};
            { IDS; pg8::gemm_phase<pg8::EpiResid, pg8::SchedDense, true, true>(lds, pg8::Gemm{DM, DM, DM}, S, E, tid); }
        }
        grid.sync();
        { IDS; phase_norm(p, pin(p, I_NX) + l * DM, lane, wid); }
        grid.sync();
        {
            WSV; pg8::SchedDense S; S.init(H, ws + WS_WCQ, DM, DM, MTOK / 256, 4);
            pg8::EpiQProj E{QX, pin(p, I_XQG) + l * 256};
            { IDS; pg8::gemm_phase<pg8::EpiQProj, pg8::SchedDense, false, true>(lds, pg8::Gemm{DM, DM, DM}, S, E, tid); }
        }
        grid.sync();
        {
            WSV; pg8::SchedOne S; S.have = true; S.u0.pm = bid >> 2; S.u0.pn = bid & 3; S.u0.kind = 0; S.u0.aux = 0;
            S.u0.a = (const char*)QX + ((size_t)S.u0.pm * 256 * DM + S.u0.pn * 256) * 2;
            S.u0.b = (const char*)(ws + WS_KN) + ((size_t)l * NMEM * DM + (size_t)(S.u0.pm >> 4) * 256 * DM + S.u0.pn * 256) * 2;
            pg8::EpiSoftmax E{PB};
            { IDS; pg8::gemm_phase<pg8::EpiSoftmax, pg8::SchedOne, false, true>(lds, pg8::Gemm{DM, DM, 256}, S, E, tid); }
        }
        grid.sync();
        {
            WSV; pg8::SchedOne S; S.have = true; S.u0.pm = bid >> 2; S.u0.pn = bid & 3; S.u0.kind = 0; S.u0.aux = 0;
            S.u0.a = (const char*)PB + ((size_t)S.u0.pm * 256 * DM + S.u0.pn * 256) * 2;
            S.u0.b = (const char*)(ws + WS_VT) + ((size_t)((l * 4 + (S.u0.pm >> 4)) * 4 + S.u0.pn) * 65536) * 2;
            pg8::EpiBf16 E{OX};
            { IDS; pg8::gemm_phase<pg8::EpiBf16, pg8::SchedOne, false, true>(lds, pg8::Gemm{DM, 256, 256}, S, E, tid); }
        }
        grid.sync();
        {
            WSV; pg8::SchedDense S; S.init(OX, ws + WS_WCO, DM, DM, MTOK / 256, 4);
            pg8::EpiResid E{outp(p), outp(p)};
            { IDS; pg8::gemm_phase<pg8::EpiResid, pg8::SchedDense, true, true>(lds, pg8::Gemm{DM, DM, DM}, S, E, tid); }
        }
        grid.sync();
        { IDS; phase_norm(p, pin(p, I_NFFN) + l * DM, lane, wid); }
        grid.sync();
        {
            WSV; pg8::SchedDense S; S.init(H, ws + WS_WGU, DM, DM, MTOK / 256, 2 * D_FF / 256);
            pg8::EpiSwiGLU E{HID};
            { IDS; pg8::gemm_phase<pg8::EpiSwiGLU, pg8::SchedDense, true, true>(lds, pg8::Gemm{DM, DM, DM}, S, E, tid); }
        }
        grid.sync();
        {
            WSV; pg8::SchedDense S; S.init(HID, ws + WS_WDN, D_FF, D_FF, MTOK / 256, 4);
            pg8::EpiResid E{outp(p), outp(p)};
            { IDS; pg8::gemm_phase<pg8::EpiResid, pg8::SchedDense, true, true>(lds, pg8::Gemm{D_FF, D_FF, D_FF}, S, E, tid); }
        }
        grid.sync();
        if (l + 1 < MK_LAYERS) { { IDS; phase_a(p, l + 1, lds, tid, lane, wid); } grid.sync(); }
    }
}

extern "C" void kernel_launch(void* const* d_in, const int* in_sizes, int n_in, void* d_out, int out_size, void* d_ws, size_t ws_size, hipStream_t stream) {
    static int grid = 0;
    if (grid == 0) {
        if (n_in != 32 || out_size != MTOK * DM || ws_size < mk::WS_END) { fprintf(stderr, "kernel_launch: unexpected shapes: n_in %d out %d ws %zu (need %zu)\n", n_in, out_size, ws_size, (size_t)mk::WS_END); grid = -1; return; }
        int dev = 0, cus = 0, per_cu = 0;
        hipGetDevice(&dev); hipDeviceGetAttribute(&cus, hipDeviceAttributeMultiprocessorCount, dev);
        if (hipFuncSetAttribute((const void*)mega_fwd, hipFuncAttributeMaxDynamicSharedMemorySize, mk::LDS_BYTES) != hipSuccess) { fprintf(stderr, "kernel_launch: hipFuncSetAttribute failed\n"); grid = -1; return; }
        hipOccupancyMaxActiveBlocksPerMultiprocessor(&per_cu, (const void*)mega_fwd, 512, mk::LDS_BYTES);
        (void)hipGetLastError();
        if (per_cu < 1) fprintf(stderr, "kernel_launch: occupancy query says %d blocks/CU\n", per_cu);
        grid = cus;
        if (grid != 256) fprintf(stderr, "kernel_launch: %d CUs; this kernel is built for 256\n", grid);
    }
    if (grid < 0) return;
    (void)hipMemsetAsync((char*)d_ws + mk::WS_CTL, 0, mk::CTL_BYTES, stream);
    mk::Params p{};
    for (int i = 0; i < 32; ++i) p.in[i] = (const float*)d_in[i];
    p.out = (float*)d_out; p.ws = (unsigned char*)d_ws;
    void* args[] = {&p};
    hipError_t e = hipLaunchCooperativeKernel((const void*)mega_fwd, dim3(grid), dim3(512), args, mk::LDS_BYTES, stream);
    if (e != hipSuccess) fprintf(stderr, "cooperative launch failed: %s (grid %d)\n", hipGetErrorString(e), grid);
}
```

```cpp
#include <hip/hip_runtime.h>
#include <hip/hip_cooperative_groups.h>
#include <hip/hip_bf16.h>
#include <cstdio>
#include <cstdint>
#include <cmath>
namespace cg = cooperative_groups;

#define LAS __attribute__((address_space(3)))
typedef unsigned short bf16_t;
typedef short bf16x8 __attribute__((ext_vector_type(8)));
typedef float f32x4 __attribute__((ext_vector_type(4)));
typedef float f32x2 __attribute__((ext_vector_type(2)));
typedef unsigned u32x4 __attribute__((ext_vector_type(4)));
typedef unsigned u32x2 __attribute__((ext_vector_type(2)));

constexpr int BATCH = 4, SEQ = 4096, DM = 1024, DEPTH = 4, MTOK = BATCH * SEQ;
constexpr int MEM_LEN = 256, NMEM = BATCH * MEM_LEN;
constexpr int P_IN = 3596, PN = 3584;
constexpr int D_FF = 2816;
constexpr float NORM_EPS = 1e-6f;
constexpr float LOG2E = 1.4426950408889634f;

typedef __bf16 hw_bf16x2 __attribute__((ext_vector_type(2)));
__device__ __forceinline__ unsigned pk2(float lo, float hi) { const f32x2 v = {lo, hi}; return __builtin_bit_cast(unsigned, __builtin_convertvector(v, hw_bf16x2)); }
__device__ __forceinline__ unsigned f2bf(float f) { return pk2(f, 0.f) & 0xffffu; }
__device__ __forceinline__ float bf2f(bf16_t b) { return __builtin_bit_cast(float, (unsigned)b << 16); }
__device__ __forceinline__ float lane_xor(float v, int o, int lane) { return __builtin_bit_cast(float, __builtin_amdgcn_ds_bpermute((lane ^ o) << 2, __builtin_bit_cast(int, v))); }
template <int CTRL> __device__ __forceinline__ float dpp_f(float v) { return __builtin_bit_cast(float, __builtin_amdgcn_update_dpp(0, __builtin_bit_cast(int, v), CTRL, 0xF, 0xF, true)); }
__device__ __forceinline__ float wave_sum(float v, int lane) {
    v += dpp_f<0xB1>(v);
    v += dpp_f<0x4E>(v);
    v += dpp_f<0x141>(v);
    v += dpp_f<0x140>(v);
    v += lane_xor(v, 16, lane);
    v += lane_xor(v, 32, lane);
    return v;
}
__device__ __forceinline__ float wave_incl_scan(float v, int lane) {
#pragma unroll
    for (int o = 1; o < 64; o <<= 1) { const float n = __builtin_bit_cast(float, __builtin_amdgcn_ds_bpermute((lane - o) << 2, __builtin_bit_cast(int, v))); if (lane >= o) v += n; }
    return v;
}
__device__ __forceinline__ float dot4v(f32x4 a) { return (a[0] * a[0] + a[1] * a[1]) + (a[2] * a[2] + a[3] * a[3]); }
__device__ __forceinline__ float silu_f(float x) { return x * __builtin_amdgcn_rcpf(1.f + __expf(-x)); }
__device__ __forceinline__ float sigmoid_f(float x) { return __builtin_amdgcn_rcpf(1.f + __expf(-x)); }
__device__ __forceinline__ float softplus_f(float x) { return fmaxf(x, 0.f) + __logf(1.f + __expf(-fabsf(x))); }

namespace pg8 {
#define PG8_LAS __attribute__((address_space(3)))
constexpr int BM = 256, BK = 64, HALF = 128, HTB = HALF * BK * 2  , STAGE_BYTES = 8 * HTB, NXCD = 8, WGM = 8;

__host__ __device__ __forceinline__ int lds_byte(int r, int c) { const int st = (r >> 4) * 2 + (c >> 5), rr = r & 15, cc = c & 31, ob = rr * 64 + cc * 2; return st * 1024 + (ob ^ (((ob >> 9) & 1) << 5)); }
__host__ __device__ __forceinline__ void stage_rc(int b, int& R, int& C) { const int st = b / 1024, sb = b % 1024, swz = sb ^ (((sb >> 9) & 1) << 5); R = (st >> 1) * 16 + swz / 64; C = (st & 1) * 32 + (swz % 64) / 2; }
__host__ __device__ __forceinline__ int perm32(int rho) { const int n = rho >> 4, i = rho & 15; return 8 * (i >> 2) + 4 * n + (i & 3); }

struct Unit { int pm, pn, kind, aux; const char* a; const char* b; };
struct Gemm { int lda, ldb, K; };

struct GridOrder {
    int nM, nN, nwg, G, c;
    __device__ void init(int nM_, int nN_, int G_, int c_) { nM = nM_; nN = nN_; nwg = nM * nN; G = G_; c = c_; }
    __device__ bool tile(int i, int& pm, int& pn) const {
        const long L = (long)i * G + c; if (L >= nwg) return false;
        int wgid = (int)L; { const int q = nwg / NXCD, r = nwg % NXCD, xcd = wgid % NXCD, off = wgid / NXCD; wgid = (xcd < r ? xcd * (q + 1) : r * (q + 1) + (xcd - r) * q) + off; }
        const int nig = WGM * nN, gid = wgid / nig, fm = gid * WGM, gsz = (nM - fm) < WGM ? (nM - fm) : WGM;
        pm = fm + ((wgid % nig) % gsz); pn = (wgid % nig) / gsz; return true;
    }
};
__device__ __forceinline__ unsigned cvt_pk_bf16(float lo, float hi) { unsigned r; asm volatile("v_cvt_pk_bf16_f32 %0, %1, %2" : "=v"(r) : "v"(lo), "v"(hi)); return r; }
template <class Epi, class Sched, bool ALIGN_EPI = false, bool SP2 = false>
__device__ __forceinline__ void gemm_phase(PG8_LAS unsigned char* lds, const Gemm g, const Sched& S, const Epi& E, int tid_in) {
    int tid_l = tid_in; asm volatile("" : "+v"(tid_l));
    const int tid = tid_l, wid = __builtin_amdgcn_readfirstlane(tid >> 6), lane = tid & 63, wr = wid >> 2, wc = wid & 3, fr = lane & 15, fq = lane >> 4;
    const int K = g.K, nt = K / BK;
    unsigned voffA[2], voffB[2];
#pragma unroll
    for (int i = 0; i < 2; ++i) { int R, C; stage_rc(tid * 16 + i * 8192, R, C); const int Rb = Epi::PERM ? ((R & ~31) + perm32(R & 31)) : R;
        voffA[i] = (unsigned)(R * g.lda + C) * 2u; voffB[i] = (unsigned)(Rb * g.ldb + C) * 2u; }
    const size_t kstep = (size_t)(BK * 2);
    const size_t hstepA = (size_t)HALF * g.lda * 2, hstepB = (size_t)HALF * g.ldb * 2;
    const unsigned ldsw = (unsigned)wid * 1024u;
    const int aoff = lds_byte(wr * 64 + fr, fq * 8), boff = lds_byte(wc * 32 + fr, fq * 8);
#define PG8_SA(b, h) (((b) * 2 + (h)) * HTB)
#define PG8_SB(b, h) ((4 + (b) * 2 + (h)) * HTB)
#define PG8_STAGE(bufoff, gbase, voff) do { _Pragma("unroll") for (int _i = 0; _i < 2; ++_i) \
        __builtin_amdgcn_global_load_lds((const unsigned*)((const char*)(gbase) + (voff)[_i]), (PG8_LAS unsigned*)(lds + (bufoff) + ldsw + _i * 8192), 16, 0, 0); } while (0)
#define PG8_LDA(dst, b, h) do { _Pragma("unroll") for (int m = 0; m < 4; ++m) _Pragma("unroll") for (int k = 0; k < 2; ++k) dst[m][k] = *(const PG8_LAS bf16x8*)(lds + PG8_SA(b, h) + aoff + m * 2048 + k * 1024); } while (0)
#define PG8_LDB(dst, b, h) do { _Pragma("unroll") for (int n = 0; n < 2; ++n) _Pragma("unroll") for (int k = 0; k < 2; ++k) dst[n][k] = *(const PG8_LAS bf16x8*)(lds + PG8_SB(b, h) + boff + n * 2048 + k * 1024); } while (0)
#define PG8_MMA(ai, bj, At, Bt) do { __builtin_amdgcn_s_setprio(1); _Pragma("unroll") for (int m = 0; m < 4; ++m) _Pragma("unroll") for (int n = 0; n < 2; ++n) _Pragma("unroll") for (int k = 0; k < 2; ++k) \
        acc[ai][bj][m][n] = __builtin_amdgcn_mfma_f32_16x16x32_bf16(Bt[n][k], At[m][k], acc[ai][bj][m][n], 0, 0, 0); __builtin_amdgcn_s_setprio(0); } while (0)
#define PG8_WAIT_V(n) asm volatile("s_waitcnt vmcnt(" #n ")" ::: "memory")
#define PG8_WAIT_L(n) asm volatile("s_waitcnt lgkmcnt(" #n ")" ::: "memory")
#define PG8_BAR __builtin_amdgcn_s_barrier()
#define PG8_SCHED __builtin_amdgcn_sched_barrier(0)
    Unit cur, nxt; int ui = 0;
    if (!S.next(0, cur)) return;
    f32x4 acc[2][2][4][2];
#pragma unroll
    for (int a = 0; a < 2; ++a)
#pragma unroll
        for (int b = 0; b < 2; ++b)
#pragma unroll
            for (int m = 0; m < 4; ++m)
#pragma unroll
                for (int n = 0; n < 2; ++n) acc[a][b][m][n] = (f32x4){0.f, 0.f, 0.f, 0.f};
    bf16x8 At[4][2], B0[2][2], B1[2][2];
    const char* cA = cur.a; const char* cB = cur.b;
    S.a_ready(cur);
    if constexpr (SP2) {
        PG8_STAGE(PG8_SB(0, 0), cB, voffB); PG8_STAGE(PG8_SB(0, 1), cB + hstepB, voffB); PG8_STAGE(PG8_SA(0, 0), cA, voffA); PG8_STAGE(PG8_SA(0, 1), cA + hstepA, voffA);
        if (wr == 1) PG8_BAR;
        PG8_WAIT_V(2); PG8_BAR;
        PG8_STAGE(PG8_SB(1, 0), cB + kstep, voffB); PG8_STAGE(PG8_SA(1, 0), cA + kstep, voffA); PG8_STAGE(PG8_SB(1, 1), cB + hstepB + kstep, voffB);
        PG8_WAIT_V(6); PG8_BAR;
    } else {
        PG8_STAGE(PG8_SB(0, 0), cB, voffB); PG8_STAGE(PG8_SA(0, 0), cA, voffA); PG8_STAGE(PG8_SB(0, 1), cB + hstepB, voffB); PG8_STAGE(PG8_SA(0, 1), cA + hstepA, voffA);
        if (wr == 1) PG8_BAR;
        PG8_WAIT_V(4); PG8_BAR;
        PG8_STAGE(PG8_SB(1, 0), cB + kstep, voffB); PG8_STAGE(PG8_SA(1, 0), cA + kstep, voffA); PG8_STAGE(PG8_SB(1, 1), cB + hstepB + kstep, voffB);
        PG8_WAIT_V(6); PG8_BAR;
    }
    for (;;) {
        const bool has_next = S.next(ui + 1, nxt);
        const char* nA = has_next ? nxt.a : cA; const char* nB = has_next ? nxt.b : cB;
        for (int t = 0; t < nt; t += 2) {
            const bool last = (t == nt - 2);
            const char* a1 = cA + (size_t)(t + 1) * kstep;
            const char* a2 = last ? nA : cA + (size_t)(t + 2) * kstep; const char* b2 = last ? nB : cB + (size_t)(t + 2) * kstep;
            const char* a3 = a2 + kstep; const char* b3 = b2 + kstep;
            if (last && has_next) S.a_ready(nxt);
            if constexpr (SP2) {
            PG8_LDB(B0, 0, 0); PG8_LDB(B1, 0, 1); PG8_SCHED; PG8_LDA(At, 0, 0); PG8_STAGE(PG8_SA(1, 1), a1 + hstepA, voffA);
            PG8_WAIT_V(8); PG8_WAIT_L(0); PG8_BAR; PG8_MMA(0, 0, At, B0); PG8_MMA(0, 1, At, B1); PG8_BAR; PG8_SCHED;
            PG8_LDA(At, 0, 1); PG8_STAGE(PG8_SB(0, 0), b2, voffB); PG8_STAGE(PG8_SB(0, 1), b2 + hstepB, voffB); PG8_STAGE(PG8_SA(0, 0), a2, voffA);
            PG8_WAIT_V(8); PG8_WAIT_L(0); PG8_BAR; PG8_MMA(1, 0, At, B0); PG8_MMA(1, 1, At, B1); PG8_BAR; PG8_SCHED;
            PG8_LDB(B0, 1, 0); PG8_LDB(B1, 1, 1); PG8_SCHED; PG8_LDA(At, 1, 0); PG8_STAGE(PG8_SA(0, 1), a2 + hstepA, voffA);
            PG8_WAIT_V(8); PG8_WAIT_L(0); PG8_BAR; PG8_MMA(0, 0, At, B0); PG8_MMA(0, 1, At, B1); PG8_BAR; PG8_SCHED;
            PG8_LDA(At, 1, 1); PG8_STAGE(PG8_SB(1, 0), b3, voffB); PG8_STAGE(PG8_SB(1, 1), b3 + hstepB, voffB); PG8_STAGE(PG8_SA(1, 0), a3, voffA);
            PG8_WAIT_V(8); PG8_WAIT_L(0); PG8_BAR; PG8_MMA(1, 0, At, B0); PG8_MMA(1, 1, At, B1); PG8_BAR; PG8_SCHED;
            } else {
            PG8_LDB(B0, 0, 0); PG8_SCHED; PG8_LDA(At, 0, 0); PG8_STAGE(PG8_SA(1, 1), a1 + hstepA, voffA);
            PG8_WAIT_L(8); PG8_BAR; PG8_WAIT_L(0); PG8_MMA(0, 0, At, B0); PG8_BAR; PG8_SCHED;
            PG8_LDB(B1, 0, 1); PG8_STAGE(PG8_SB(0, 0), b2, voffB);
            PG8_BAR; PG8_WAIT_L(0); PG8_MMA(0, 1, At, B1); PG8_BAR;
            PG8_LDA(At, 0, 1); PG8_STAGE(PG8_SA(0, 0), a2, voffA);
            PG8_BAR; PG8_WAIT_L(0); PG8_MMA(1, 0, At, B0); PG8_BAR; PG8_SCHED;
            PG8_STAGE(PG8_SB(0, 1), b2 + hstepB, voffB);
            PG8_WAIT_V(6); PG8_BAR; PG8_MMA(1, 1, At, B1); PG8_BAR;
            PG8_LDB(B0, 1, 0); PG8_SCHED; PG8_LDA(At, 1, 0); PG8_STAGE(PG8_SA(0, 1), a2 + hstepA, voffA);
            PG8_WAIT_L(8); PG8_BAR; PG8_WAIT_L(0); PG8_MMA(0, 0, At, B0); PG8_BAR; PG8_SCHED;
            PG8_LDB(B1, 1, 1); PG8_STAGE(PG8_SB(1, 0), b3, voffB);
            PG8_BAR; PG8_WAIT_L(0); PG8_MMA(0, 1, At, B1); PG8_BAR;
            PG8_LDA(At, 1, 1); PG8_STAGE(PG8_SA(1, 0), a3, voffA);
            PG8_BAR; PG8_WAIT_L(0); PG8_MMA(1, 0, At, B0); PG8_BAR; PG8_SCHED;
            PG8_STAGE(PG8_SB(1, 1), b3 + hstepB, voffB);
            PG8_WAIT_V(6); PG8_BAR; PG8_MMA(1, 1, At, B1); PG8_BAR;
            }
        }
        if constexpr (ALIGN_EPI) { if (wr == 0) PG8_BAR; }
        if constexpr (!Epi::AFTER_DRAIN) { E(acc, cur, wr, wc, fr, fq); S.done(cur); }
        if (!has_next) break;
#pragma unroll
        for (int a = 0; a < 2; ++a)
#pragma unroll
            for (int b = 0; b < 2; ++b)
#pragma unroll
                for (int m = 0; m < 4; ++m)
#pragma unroll
                    for (int n = 0; n < 2; ++n) acc[a][b][m][n] = (f32x4){0.f, 0.f, 0.f, 0.f};
        cur = nxt; cA = nA; cB = nB; ++ui;
        if constexpr (ALIGN_EPI) { if (wr == 1) PG8_BAR; }
    }
    PG8_WAIT_V(0);
    if constexpr (!ALIGN_EPI) { if (wr == 0) PG8_BAR; }
    PG8_BAR;
    if constexpr (Epi::AFTER_DRAIN) { E.fused(acc, cur, wr, wc, fr, fq, lds, wid, lane); S.done(cur); }
#undef PG8_SA
#undef PG8_SB
#undef PG8_STAGE
#undef PG8_LDA
#undef PG8_LDB
#undef PG8_MMA
#undef PG8_WAIT_V
#undef PG8_WAIT_L
#undef PG8_BAR
#undef PG8_SCHED
}
}

namespace pg8 {
typedef f32x4 Acc[2][2][4][2];
constexpr float ATT_C2 = 0.125f * 1.4426950408889634f;
__device__ __forceinline__ float dot4(f32x4 a) { return (a[0] * a[0] + a[1] * a[1]) + (a[2] * a[2] + a[3] * a[3]); }
__device__ __forceinline__ void st_bf16x4(bf16_t* p, f32x4 v) { u32x2 w; w.x = cvt_pk_bf16(v[0], v[1]); w.y = cvt_pk_bf16(v[2], v[3]); *(u32x2*)p = w; }

__device__ __forceinline__ float row_rstd(const float* ssp, int row, int fr, int fq) {
    const f32x4 v = *(const f32x4*)(ssp + (size_t)row * 16 + 4 * fq); float s = (v[0] + v[1]) + (v[2] + v[3]);
    s += lane_xor(s, 16, fq * 16 + fr); s += lane_xor(s, 32, fq * 16 + fr);
    return rsqrtf(s * (1.f / DM) + NORM_EPS);
}
__device__ __forceinline__ void st_bf16x8(bf16_t* p, f32x4 a, f32x4 b) { u32x4 w; w.x = cvt_pk_bf16(a[0], a[1]); w.y = cvt_pk_bf16(a[2], a[3]); w.z = cvt_pk_bf16(b[0], b[1]); w.w = cvt_pk_bf16(b[2], b[3]); *(u32x4*)p = w; }
__device__ __forceinline__ void rstd8(const float* ssp, int row0, int fr, int fq, float (&rs)[2][4]) {
    f32x4 v[2][4];
#pragma unroll
    for (int ai = 0; ai < 2; ++ai)
#pragma unroll
        for (int m = 0; m < 4; ++m) v[ai][m] = *(const f32x4*)(ssp + (size_t)(row0 + ai * 128 + m * 16) * 16 + 4 * fq);
#pragma unroll
    for (int ai = 0; ai < 2; ++ai)
#pragma unroll
        for (int m = 0; m < 4; ++m) { float s = (v[ai][m][0] + v[ai][m][1]) + (v[ai][m][2] + v[ai][m][3]);
            s += lane_xor(s, 16, fq * 16 + fr); s += lane_xor(s, 32, fq * 16 + fr); rs[ai][m] = rsqrtf(s * (1.f / DM) + NORM_EPS); }
}
struct SchedDense {
    GridOrder go; const char* A; const char* Bt; size_t ta, tb;
    __device__ void init(const void* A_, const void* Bt_, int lda, int ldb, int nM, int nN) { go.init(nM, nN, gridDim.x, blockIdx.x); A = (const char*)A_; Bt = (const char*)Bt_; ta = (size_t)256 * lda * 2; tb = (size_t)256 * ldb * 2; }
    __device__ bool next(int i, Unit& u) const { int pm, pn; if (!go.tile(i, pm, pn)) return false; u.pm = pm; u.pn = pn; u.kind = 0; u.aux = 0; u.a = A + pm * ta; u.b = Bt + pn * tb; return true; }
    __device__ __forceinline__ void a_ready(const Unit&) const {}
    __device__ __forceinline__ void done(const Unit&) const {}
};
template <int MODE> struct SchedX {
    GridOrder go; const char* A; const char* B;
    __device__ void init(const void* A_, const void* B_) { go.init(MTOK / 256, 4, gridDim.x, blockIdx.x); A = (const char*)A_; B = (const char*)B_; }
    __device__ bool next(int i, Unit& u) const { int pm, pn; if (!go.tile(i, pm, pn)) return false; u.pm = pm; u.pn = pn; u.kind = 0; u.aux = 0;
        u.a = A + ((size_t)pm * 256 * DM + pn * 256) * 2;
        u.b = MODE == 0 ? B + ((size_t)(pm >> 4) * 256 * DM + pn * 256) * 2 : B + ((size_t)((pm >> 4) * 4 + pn) * 65536) * 2; return true; }
    __device__ __forceinline__ void a_ready(const Unit&) const {}
    __device__ __forceinline__ void done(const Unit&) const {}
};
struct SchedOne {
    Unit u0; bool have;
    __device__ bool next(int i, Unit& u) const { if (i != 0 || !have) return false; u = u0; return true; }
    __device__ __forceinline__ void a_ready(const Unit&) const {}
    __device__ __forceinline__ void done(const Unit&) const {}
};

struct EpiInProj {
    static constexpr bool PERM = true, AFTER_DRAIN = false;
    bf16_t* O; const float* qg; const float* kg; const float* ss; float* SM;
    __device__ __forceinline__ void operator()(const Acc& acc, const Unit& u, int wr, int wc, int fr, int fq) const {
        const int row0 = u.pm * 256 + wr * 64 + fr, colb = u.pn * 256 + 64 * wc + 8 * fq;
        float rs8[2][4]; rstd8(ss, row0, fr, fq, rs8);
        if (u.pn < 4) {
            const float* g = u.pn < 2 ? qg : kg; const float sc = u.pn < 2 ? ATT_C2 : 1.f;
            f32x4 gv[2][2];
#pragma unroll
            for (int bj = 0; bj < 2; ++bj)
#pragma unroll
                for (int n = 0; n < 2; ++n) gv[bj][n] = *(const f32x4*)(g + 32 * bj + 8 * fq + 4 * n);
#pragma unroll
            for (int ai = 0; ai < 2; ++ai)
#pragma unroll
                for (int m = 0; m < 4; ++m) {
                    const int row = row0 + ai * 128 + m * 16;
                    const float rstd = rs8[ai][m];
                    float s2 = (dot4(acc[ai][0][m][0]) + dot4(acc[ai][0][m][1])) + (dot4(acc[ai][1][m][0]) + dot4(acc[ai][1][m][1]));
                    s2 += lane_xor(s2, 16, fq * 16 + fr); s2 += lane_xor(s2, 32, fq * 16 + fr);
                    const float r = rstd * rsqrtf(rstd * rstd * s2 * (1.f / 64.f) + NORM_EPS) * sc;
                    bf16_t* rowp = O + (size_t)row * PN + colb;
#pragma unroll
                    for (int bj = 0; bj < 2; ++bj) { const f32x4 v0 = acc[ai][bj][m][0] * r * gv[bj][0], v1 = acc[ai][bj][m][1] * r * gv[bj][1];
                        u32x4 w; w.x = cvt_pk_bf16(v0[0], v0[1]); w.y = cvt_pk_bf16(v0[2], v0[3]); w.z = cvt_pk_bf16(v1[0], v1[1]); w.w = cvt_pk_bf16(v1[2], v1[3]); *(u32x4*)(rowp + 32 * bj) = w; }
                }
        } else if (u.pn < 14) {
#pragma unroll
            for (int ai = 0; ai < 2; ++ai)
#pragma unroll
                for (int m = 0; m < 4; ++m) {
                    const int row = row0 + ai * 128 + m * 16;
                    const float rstd = rs8[ai][m];
                    bf16_t* rowp = O + (size_t)row * PN + colb;
#pragma unroll
                    for (int bj = 0; bj < 2; ++bj) { const f32x4 v0 = acc[ai][bj][m][0] * rstd, v1 = acc[ai][bj][m][1] * rstd;
                        u32x4 w; w.x = cvt_pk_bf16(v0[0], v0[1]); w.y = cvt_pk_bf16(v0[2], v0[3]); w.z = cvt_pk_bf16(v1[0], v1[1]); w.w = cvt_pk_bf16(v1[2], v1[3]); *(u32x4*)(rowp + 32 * bj) = w; }
                }
        } else {
#pragma unroll
            for (int ai = 0; ai < 2; ++ai)
#pragma unroll
                for (int m = 0; m < 4; ++m) {
                    const int row = row0 + ai * 128 + m * 16;
                    const float rstd = rs8[ai][m];
                    if (wc == 0 && fq < 2) { *(f32x4*)(SM + (size_t)row * 12 + 8 * fq) = acc[ai][0][m][0] * rstd; if (fq == 0) *(f32x4*)(SM + (size_t)row * 12 + 4) = acc[ai][0][m][1] * rstd; }
                }
        }
    }
};
struct EpiResid {
    static constexpr bool PERM = true, AFTER_DRAIN = false;
    bf16_t* xb; float* ss; float* outf;
    __device__ __forceinline__ void operator()(const Acc& acc, const Unit& u, int wr, int wc, int fr, int fq) const {
        const int row0 = u.pm * 256 + wr * 64 + fr, col0 = u.pn * 256 + wc * 32 + 8 * fq;
#pragma unroll
        for (int ai = 0; ai < 2; ++ai) {
            u32x4 b[4][2];
#pragma unroll
            for (int m = 0; m < 4; ++m)
#pragma unroll
                for (int bj = 0; bj < 2; ++bj) b[m][bj] = *(const u32x4*)(xb + (size_t)(row0 + ai * 128 + m * 16) * DM + col0 + bj * 128);
#pragma unroll
            for (int m = 0; m < 4; ++m) { const int row = row0 + ai * 128 + m * 16; const size_t off = (size_t)row * DM + col0; float sq = 0.f;
#pragma unroll
                for (int bj = 0; bj < 2; ++bj) { const u32x4 bb = b[m][bj];
                    f32x4 v0, v1; v0[0] = __builtin_bit_cast(float, bb.x << 16); v0[1] = __builtin_bit_cast(float, bb.x & 0xffff0000u); v0[2] = __builtin_bit_cast(float, bb.y << 16); v0[3] = __builtin_bit_cast(float, bb.y & 0xffff0000u);
                    v1[0] = __builtin_bit_cast(float, bb.z << 16); v1[1] = __builtin_bit_cast(float, bb.z & 0xffff0000u); v1[2] = __builtin_bit_cast(float, bb.w << 16); v1[3] = __builtin_bit_cast(float, bb.w & 0xffff0000u);
                    v0 = v0 + acc[ai][bj][m][0]; v1 = v1 + acc[ai][bj][m][1]; st_bf16x8(xb + off + bj * 128, v0, v1);
                    if (outf) { *(f32x4*)(outf + off + bj * 128) = v0; *(f32x4*)(outf + off + bj * 128 + 4) = v1; } sq += dot4(v0) + dot4(v1); }
                sq += lane_xor(sq, 16, fq * 16 + fr); sq += lane_xor(sq, 32, fq * 16 + fr);
                if (fq == 0) ss[(size_t)row * 16 + u.pn * 4 + wc] = sq;
            }
            asm volatile("" ::: "memory");
        }
    }
};
struct EpiNull { static constexpr bool PERM = false, AFTER_DRAIN = false; float* sink; __device__ __forceinline__ void operator()(const Acc& acc, const Unit& u, int wr, int wc, int fr, int fq) const { if (acc[0][0][0][0][0] == 123456.789f) sink[0] = 1.f; } };
struct EpiSwiGLU {
    static constexpr bool PERM = true, AFTER_DRAIN = false;
    bf16_t* O; const float* ss;
    __device__ __forceinline__ void operator()(const Acc& acc, const Unit& u, int wr, int wc, int fr, int fq) const {
        const int row0 = u.pm * 256 + wr * 64 + fr, col0 = u.pn * 128 + wc * 32 + 8 * fq;
        float rs8[2][4]; rstd8(ss, row0, fr, fq, rs8);
#pragma unroll
        for (int ai = 0; ai < 2; ++ai)
#pragma unroll
            for (int m = 0; m < 4; ++m) { const int row = row0 + ai * 128 + m * 16; bf16_t* rowp = O + (size_t)row * D_FF + col0; const float rstd = rs8[ai][m];
                u32x4 w;
#pragma unroll
                for (int n = 0; n < 2; ++n) { const f32x4 g = acc[ai][0][m][n] * rstd, up = acc[ai][1][m][n] * rstd; f32x4 v;
#pragma unroll
                    for (int i = 0; i < 4; ++i) v[i] = g[i] * __builtin_amdgcn_rcpf(1.f + __expf(-g[i])) * up[i];
                    w[2 * n] = cvt_pk_bf16(v[0], v[1]); w[2 * n + 1] = cvt_pk_bf16(v[2], v[3]); }
                *(u32x4*)rowp = w; }
    }
};
struct EpiBf16 {
    static constexpr bool PERM = true, AFTER_DRAIN = false;
    bf16_t* O;
    __device__ __forceinline__ void operator()(const Acc& acc, const Unit& u, int wr, int wc, int fr, int fq) const {
        const int row0 = u.pm * 256 + wr * 64 + fr, col0 = u.pn * 256 + wc * 32 + 8 * fq;
#pragma unroll
        for (int ai = 0; ai < 2; ++ai)
#pragma unroll
            for (int m = 0; m < 4; ++m) { bf16_t* rowp = O + (size_t)(row0 + ai * 128 + m * 16) * DM + col0;
#pragma unroll
                for (int bj = 0; bj < 2; ++bj) st_bf16x8(rowp + bj * 128, acc[ai][bj][m][0], acc[ai][bj][m][1]); }
    }
};
#define PG8_BARRIER() do { asm volatile("s_waitcnt lgkmcnt(0)" ::: "memory"); __builtin_amdgcn_s_barrier(); asm volatile("" ::: "memory"); } while (0)
__device__ __forceinline__ void tile_row_rstd(const Acc& acc, float (&rs)[2][4], int wr, int wc, int fr, int fq, PG8_LAS unsigned char* lds) {
    PG8_LAS float* P = (PG8_LAS float*)lds;
#pragma unroll
    for (int ai = 0; ai < 2; ++ai)
#pragma unroll
        for (int m = 0; m < 4; ++m) {
            float ss = (dot4(acc[ai][0][m][0]) + dot4(acc[ai][0][m][1])) + (dot4(acc[ai][1][m][0]) + dot4(acc[ai][1][m][1]));
            ss += lane_xor(ss, 16, fq * 16 + fr); ss += lane_xor(ss, 32, fq * 16 + fr);
            if (fq == 0) P[(ai * 128 + wr * 64 + m * 16 + fr) * 4 + wc] = ss;
        }
    PG8_BARRIER();
#pragma unroll
    for (int ai = 0; ai < 2; ++ai)
#pragma unroll
        for (int m = 0; m < 4; ++m) { const f32x4 p = *(const PG8_LAS f32x4*)(P + (ai * 128 + wr * 64 + m * 16 + fr) * 4); rs[ai][m] = rsqrtf(((p[0] + p[1]) + (p[2] + p[3])) * (1.f / 256.f) + NORM_EPS); }
}
struct EpiQProj {
    static constexpr bool PERM = true, AFTER_DRAIN = true;
    bf16_t* O; const float* g; const float* ss;
    __device__ __forceinline__ void fused(Acc& acc, const Unit& u, int wr, int wc, int fr, int fq, PG8_LAS unsigned char* lds, int wid, int lane) const {
        const int row0 = u.pm * 256 + wr * 64 + fr, cl = wc * 32 + 8 * fq;
        float rs8[2][4]; rstd8(ss, row0, fr, fq, rs8);
#pragma unroll
        for (int ai = 0; ai < 2; ++ai)
#pragma unroll
            for (int m = 0; m < 4; ++m) { const float rstd = rs8[ai][m];
#pragma unroll
                for (int bj = 0; bj < 2; ++bj)
#pragma unroll
                    for (int n = 0; n < 2; ++n) acc[ai][bj][m][n] = acc[ai][bj][m][n] * rstd; }
        float rs[2][4]; tile_row_rstd(acc, rs, wr, wc, fr, fq, lds);
#pragma unroll
        for (int bj = 0; bj < 2; ++bj) { const f32x4 g0 = *(const f32x4*)(g + cl + bj * 128), g1 = *(const f32x4*)(g + cl + bj * 128 + 4);
#pragma unroll
            for (int ai = 0; ai < 2; ++ai)
#pragma unroll
                for (int m = 0; m < 4; ++m) st_bf16x8(O + (size_t)(row0 + ai * 128 + m * 16) * DM + u.pn * 256 + cl + bj * 128, acc[ai][bj][m][0] * rs[ai][m] * g0, acc[ai][bj][m][1] * rs[ai][m] * g1); }
    }
};
struct EpiKV {
    static constexpr bool PERM = false, AFTER_DRAIN = true;
    bf16_t* KN; bf16_t* VT; const float* g;
    __device__ __forceinline__ void fused(Acc& acc, const Unit& u, int wr, int wc, int fr, int fq, PG8_LAS unsigned char* lds, int wid, int lane) const {
        const int l = u.aux;
        if (u.pn < 4) {
            float rs[2][4]; tile_row_rstd(acc, rs, wr, wc, fr, fq, lds);
            bf16_t* Ob = KN + (size_t)l * NMEM * DM; const float* gl = g + l * 256;
            const int row0 = u.pm * 256 + wr * 64 + fr, cl = wc * 32 + 4 * fq;
#pragma unroll
            for (int bj = 0; bj < 2; ++bj)
#pragma unroll
                for (int n = 0; n < 2; ++n) { const f32x4 gv = *(const f32x4*)(gl + cl + bj * 128 + n * 16);
#pragma unroll
                    for (int ai = 0; ai < 2; ++ai)
#pragma unroll
                        for (int m = 0; m < 4; ++m) st_bf16x4(Ob + (size_t)(row0 + ai * 128 + m * 16) * DM + u.pn * 256 + cl + bj * 128 + n * 16, acc[ai][bj][m][n] * rs[ai][m] * gv); }
        } else {
            bf16_t* Ob = VT + ((size_t)(l * 4 + u.pm) * 4 + (u.pn - 4)) * 65536;
            const int r0 = wr * 64 + fr, c0 = wc * 32 + 4 * fq;
#pragma unroll
            for (int ai = 0; ai < 2; ++ai)
#pragma unroll
                for (int m = 0; m < 4; ++m)
#pragma unroll
                    for (int bj = 0; bj < 2; ++bj)
#pragma unroll
                        for (int n = 0; n < 2; ++n)
#pragma unroll
                            for (int i = 0; i < 4; ++i) Ob[(size_t)(c0 + bj * 128 + n * 16 + i) * 256 + r0 + ai * 128 + m * 16] = (bf16_t)f2bf(acc[ai][bj][m][n][i]);
        }
    }
};
struct EpiSoftmax {
    static constexpr bool PERM = true, AFTER_DRAIN = true;
    bf16_t* O;
    __device__ __forceinline__ void fused(Acc& acc, const Unit& u, int wr, int wc, int fr, int fq, PG8_LAS unsigned char* lds, int wid, int lane) const {
        PG8_LAS float* P = (PG8_LAS float*)lds; PG8_LAS float* P2 = (PG8_LAS float*)(lds + 4096);
        const float sc = 0.0625f * LOG2E;
#pragma unroll
        for (int ai = 0; ai < 2; ++ai)
#pragma unroll
            for (int m = 0; m < 4; ++m) {
                float mx = -INFINITY;
#pragma unroll
                for (int bj = 0; bj < 2; ++bj)
#pragma unroll
                    for (int n = 0; n < 2; ++n) { const f32x4 a = acc[ai][bj][m][n]; mx = fmaxf(mx, fmaxf(fmaxf(a[0], a[1]), fmaxf(a[2], a[3]))); }
                mx = fmaxf(mx, lane_xor(mx, 16, fq * 16 + fr)); mx = fmaxf(mx, lane_xor(mx, 32, fq * 16 + fr));
                if (fq == 0) P[(ai * 128 + wr * 64 + m * 16 + fr) * 4 + wc] = mx;
            }
        PG8_BARRIER();
#pragma unroll
        for (int ai = 0; ai < 2; ++ai)
#pragma unroll
            for (int m = 0; m < 4; ++m) {
                const int row = ai * 128 + wr * 64 + m * 16 + fr;
                const f32x4 p = *(const PG8_LAS f32x4*)(P + row * 4); const float mx = fmaxf(fmaxf(p[0], p[1]), fmaxf(p[2], p[3])) * sc;
                float s = 0.f;
#pragma unroll
                for (int bj = 0; bj < 2; ++bj)
#pragma unroll
                    for (int n = 0; n < 2; ++n) { f32x4 a = acc[ai][bj][m][n];
#pragma unroll
                        for (int i = 0; i < 4; ++i) { a[i] = __builtin_amdgcn_exp2f(a[i] * sc - mx); s += a[i]; }
                        acc[ai][bj][m][n] = a; }
                s += lane_xor(s, 16, fq * 16 + fr); s += lane_xor(s, 32, fq * 16 + fr);
                if (fq == 0) P2[row * 4 + wc] = s;
            }
        PG8_BARRIER();
        const int row0 = u.pm * 256 + wr * 64 + fr, col0 = u.pn * 256 + wc * 32 + 8 * fq;
#pragma unroll
        for (int ai = 0; ai < 2; ++ai)
#pragma unroll
            for (int m = 0; m < 4; ++m) {
                const int row = ai * 128 + wr * 64 + m * 16 + fr;
                const f32x4 p = *(const PG8_LAS f32x4*)(P2 + row * 4); const float inv = __builtin_amdgcn_rcpf((p[0] + p[1]) + (p[2] + p[3]));
                bf16_t* rowp = O + (size_t)(row0 + ai * 128 + m * 16) * DM + col0;
#pragma unroll
                for (int bj = 0; bj < 2; ++bj) st_bf16x8(rowp + bj * 128, acc[ai][bj][m][0] * inv, acc[ai][bj][m][1] * inv);
            }
    }
};
}
namespace attn_body {
using bf16=__hip_bfloat16;
using bf16x8=__attribute__((ext_vector_type(8)))short;
using s16x4=__attribute__((ext_vector_type(4)))short;
using f32x16=__attribute__((ext_vector_type(16)))float;
using u32x4=__attribute__((ext_vector_type(4)))unsigned;
constexpr int BATCH=4,NHEAD=16,SEQ=4096,D=64,PQ=3584,PO=1024;
constexpr int NW=8,QBLK=32,QB=QBLK*NW,KVBLK=64,NQB=SEQ/QB;
constexpr int ATTN_UNIT_ROWS=QB;
__device__ __forceinline__ int crow(int r,int hi){return (r&3)+8*(r>>2)+4*hi;}
#define SBAR() __builtin_amdgcn_sched_barrier(0)
__device__ __forceinline__ void cmask(f32x16&p0,f32x16&p1,int jb,int qrel,int hi){
  const float NEG=-INFINITY; int kb=64*jb+4*hi;
  #pragma unroll
  for(int r=0;r<16;++r){int kv=kb+(r&3)+8*(r>>2); if(kv>qrel)p0[r]=NEG; if(kv+32>qrel)p1[r]=NEG;}
}

constexpr int NSLOT=3, SLOTB=8192;
constexpr int LDS_K=0, LDS_V=NSLOT*SLOTB, LDS_WS=2*NSLOT*SLOTB, LDS_OST=LDS_WS+NW*64*4, LDS_BYTES=LDS_OST+NW*4096;
constexpr float C2=0.125f*1.4426950408889634f;
__device__ __forceinline__ void glds16(const void*gsrc,unsigned lds_dst){unsigned keep;
  asm volatile("s_mov_b32 %0, m0\n\ts_mov_b32 m0, %2\n\ts_nop 0\n\tglobal_load_lds_dwordx4 %1, off\n\ts_mov_b32 m0, %0":"=&s"(keep):"v"(gsrc),"s"(lds_dst):"memory");}
__device__ __forceinline__ float max3f(float a,float b,float c){float r;asm("v_max3_f32 %0, %1, %2, %3":"=v"(r):"v"(a),"v"(b),"v"(c));return r;}
__device__ __forceinline__ float max2f(float a,float b){float r;asm("v_max_f32_e32 %0, %1, %2":"=v"(r):"v"(a),"v"(b));return r;}
__device__ __forceinline__ float fadd_s(float a,float b){float r;asm("v_add_f32_e32 %0, %1, %2":"=v"(r):"v"(a),"v"(b));return r;}
__device__ __forceinline__ float fsub_s(float a,float b){float r;asm("v_sub_f32_e32 %0, %1, %2":"=v"(r):"v"(a),"v"(b));return r;}
typedef float f32x2_t __attribute__((ext_vector_type(2))); typedef __bf16 bf16x2_t __attribute__((ext_vector_type(2)));
__device__ __forceinline__ unsigned cvtpk_s(float lo,float hi){f32x2_t v={lo,hi};bf16x2_t b=__builtin_convertvector(v,bf16x2_t);return __builtin_bit_cast(unsigned,b);}
#define WAIT_BAR(N) asm volatile("s_waitcnt vmcnt(" #N ") lgkmcnt(0)\n\ts_barrier":::"memory")

__device__ __forceinline__ void qkt(f32x16&p0,f32x16&p1,const char*Kslot,const bf16x8*qr,const f32x16&negm,int r32,int hi){
  const char*kb=Kslot+hi*1024+r32*16;
  #pragma unroll
  for(int d0=0;d0<4;++d0){
    const bf16x8 b0=*reinterpret_cast<const bf16x8*>(kb+d0*2048);
    const bf16x8 b1=*reinterpret_cast<const bf16x8*>(kb+d0*2048+512);
    if(d0==0){p0=__builtin_amdgcn_mfma_f32_32x32x16_bf16(b0,qr[0],negm,0,0,0);p1=__builtin_amdgcn_mfma_f32_32x32x16_bf16(b1,qr[0],negm,0,0,0);}
    else{p0=__builtin_amdgcn_mfma_f32_32x32x16_bf16(b0,qr[d0],p0,0,0,0);p1=__builtin_amdgcn_mfma_f32_32x32x16_bf16(b1,qr[d0],p1,0,0,0);}}
}
typedef __attribute__((address_space(3))) const char* lds_cptr;
typedef short v4i16_t __attribute__((ext_vector_type(4)));
__device__ __forceinline__ void kload8(bf16x8*kf,lds_cptr kp){
  kf[0]=*(const __attribute__((address_space(3))) bf16x8*)(kp);      kf[1]=*(const __attribute__((address_space(3))) bf16x8*)(kp+512);
  kf[2]=*(const __attribute__((address_space(3))) bf16x8*)(kp+2048); kf[3]=*(const __attribute__((address_space(3))) bf16x8*)(kp+2560);
  kf[4]=*(const __attribute__((address_space(3))) bf16x8*)(kp+4096); kf[5]=*(const __attribute__((address_space(3))) bf16x8*)(kp+4608);
  kf[6]=*(const __attribute__((address_space(3))) bf16x8*)(kp+6144); kf[7]=*(const __attribute__((address_space(3))) bf16x8*)(kp+6656);
}
__device__ __forceinline__ void kload2(bf16x8*kf,lds_cptr kp,int j){ kf[2*j]=*(const __attribute__((address_space(3))) bf16x8*)(kp+j*2048); kf[2*j+1]=*(const __attribute__((address_space(3))) bf16x8*)(kp+j*2048+512); }
__device__ __forceinline__ s16x4 vtr(lds_cptr p){ return __builtin_bit_cast(s16x4,__builtin_amdgcn_ds_read_tr16_b64_v4i16((__attribute__((address_space(3))) v4i16_t*)p)); }
__device__ __forceinline__ float rowmax(const f32x16&p0,const f32x16&p1){
  float a=max3f(p0[0],p0[1],p1[0]),b=max3f(p0[2],p0[3],p1[1]);a=max3f(a,p1[2],p1[3]);
  #pragma unroll
  for(int r=4;r<16;r+=4){a=max3f(a,p0[r],p0[r+1]);b=max3f(b,p0[r+2],p0[r+3]);a=max3f(a,p1[r],p1[r+1]);b=max3f(b,p1[r+2],p1[r+3]);}
  const float m=max2f(a,b);
  auto rr=__builtin_amdgcn_permlane32_swap(__float_as_uint(m),__float_as_uint(m),false,false);
  return max2f(__uint_as_float(rr[0]),__uint_as_float(rr[1]));
}
__device__ __forceinline__ void pv(f32x16*o,int vb,bf16x8 pa0,bf16x8 pa1,bf16x8 pa2,bf16x8 pa3){
  #pragma unroll
  for(int d0=0;d0<2;++d0){s16x4 lo[4],hi[4];
    #pragma unroll
    for(int ks=0;ks<4;++ks){
      asm volatile("ds_read_b64_tr_b16 %0,%1 offset:%c2":"=&v"(lo[ks]):"v"(vb),"i"(d0*4096+ks*1024):"memory");
      asm volatile("ds_read_b64_tr_b16 %0,%1 offset:%c2":"=&v"(hi[ks]):"v"(vb),"i"(d0*4096+ks*1024+512):"memory");}
    asm volatile("s_waitcnt lgkmcnt(0)":::"memory");SBAR();
    #define PK(k) (bf16x8){lo[k][0],lo[k][1],lo[k][2],lo[k][3],hi[k][0],hi[k][1],hi[k][2],hi[k][3]}
    o[d0]=__builtin_amdgcn_mfma_f32_32x32x16_bf16(pa0,PK(0),o[d0],0,0,0);
    o[d0]=__builtin_amdgcn_mfma_f32_32x32x16_bf16(pa1,PK(1),o[d0],0,0,0);
    o[d0]=__builtin_amdgcn_mfma_f32_32x32x16_bf16(pa2,PK(2),o[d0],0,0,0);
    o[d0]=__builtin_amdgcn_mfma_f32_32x32x16_bf16(pa3,PK(3),o[d0],0,0,0);
    #undef PK
  }
}

#ifndef ATTN_STORE16
#define ATTN_STORE16(p,v) (*(u32x4*)(p)=(v))
#endif
template<int THRL> __device__ __forceinline__ void attn_unit(int b,int h,int qb,const bf16*Q,const bf16*__restrict__ K,const bf16*__restrict__ V,bf16*O,char*shm,int tid_in){
  int tid_l=tid_in; asm volatile("":"+v"(tid_l)); const int tid=tid_l,lane=tid&63,r32=lane&31,hi=lane>>5; const int wid=__builtin_amdgcn_readfirstlane(tid>>6);
  const long rowbase=(long)b*SEQ; const int q0=qb*QB;
  const bf16*Qw=Q+(rowbase+q0+wid*QBLK)*PQ+(h>>1)*D;
  const bf16*Kh=K+rowbase*PQ+512+(h>>1)*D,*Vh=V+rowbase*PQ+1024+(h>>2)*128+(h&1)*D;
  const unsigned lds0=(unsigned)(uintptr_t)shm;
  float*wsf=(float*)(shm+LDS_WS)+wid*64;
  const bf16*ksrc=Kh+(long)lane*PQ+wid*8;
  const bf16*vsrc=Vh+(long)(16*(wid&3)+(lane>>2))*PQ+(wid>>2)*32+(lane&3)*8;
  const unsigned kdst=lds0+LDS_K+wid*1024, vdst=lds0+LDS_V+wid*1024;
  #define DMA_K(t,slot) glds16(ksrc+(long)(t)*KVBLK*PQ,(unsigned)__builtin_amdgcn_readfirstlane(kdst+(slot)))
  #define DMA_V(t,slot) glds16(vsrc+(long)(t)*KVBLK*PQ,(unsigned)__builtin_amdgcn_readfirstlane(vdst+(slot)))
  const int vb0=(int)(lds0+LDS_V)+((lane>>4)&1)*32+(lane&3)*8+(4*hi+((lane&15)>>2))*64;
  const char*Kbase=shm+LDS_K; bf16x8 kf[8];
  const lds_cptr shm3=(lds_cptr)shm; const lds_cptr kp0=shm3+LDS_K+hi*1024+r32*16; const lds_cptr vp0=shm3+LDS_V+((lane>>4)&1)*32+(lane&3)*8+(4*hi+((lane&15)>>2))*64;
  const int NT=(q0+QB)/KVBLK;
  DMA_K(0,0);DMA_V(0,0);DMA_K(1,SLOTB);
  bf16x8 qr[4];
  #pragma unroll
  for(int d0=0;d0<4;++d0)qr[d0]=*reinterpret_cast<const bf16x8*>(&Qw[(long)r32*PQ+d0*16+hi*8]);
  float mhat=0.f,l_reg=0.f;f32x16 o[2];o[0]=f32x16{};o[1]=f32x16{};f32x16 negm=f32x16{};asm volatile("":"+v"(negm));
  const int qrel=wid*QBLK+r32;
  #define CMASK(P0,P1,t) do{int jb_=(t)-(NT-4); if(jb_>=0)cmask(P0,P1,jb_,qrel,hi);}while(0)
  bool resc=false;
  #define START(P0,P1) do{ const float rm=rowmax(P0,P1); resc=false; \
    { const float dl=rm; mhat=fadd_s(mhat,dl); \
      _Pragma("unroll") for(int r=0;r<16;++r){P0[r]=fsub_s(P0[r],dl);P1[r]=fsub_s(P1[r],dl);} \
      _Pragma("unroll") for(int r=0;r<16;++r)negm[r]=-mhat; asm volatile("":"+v"(negm)); } \
    _Pragma("unroll") for(int r=0;r<16;++r)P0[r]=__builtin_amdgcn_exp2f(P0[r]); }while(0)
  #define RESC() do{ if(resc){ asm volatile("s_waitcnt lgkmcnt(0)":::"memory"); \
      _Pragma("unroll") for(int d_=0;d_<2;++d_) _Pragma("unroll") for(int r=0;r<16;++r)o[d_][r]*=wsf[crow(r,hi)]; } }while(0)
  f32x16 pA0,pA1,pB0,pB1;
  int sl_prev=0,sl_cur=0,sl_next=SLOTB;
  #define ROT() do{sl_prev=sl_cur;sl_cur=sl_next;sl_next=(sl_next==(NSLOT-1)*SLOTB)?0:sl_next+SLOTB;}while(0)
  DMA_K(2,2*SLOTB);
  WAIT_BAR(3);
  qkt(pA0,pA1,Kbase,qr,negm,r32,hi);asm volatile("s_nop 15\n\ts_nop 7":"+v"(pA0),"+v"(pA1));CMASK(pA0,pA1,0);
  START(pA0,pA1);
  _Pragma("unroll") for(int r=0;r<16;++r)pA1[r]=__builtin_amdgcn_exp2f(pA1[r]);
  WAIT_BAR(0);
  DMA_K(3,0);DMA_V(1,SLOTB);
  ROT();
  kload8(kf,kp0+sl_cur);
  WAIT_BAR(2);
  s16x4 vlo[8],vhi[8]; u32x4 pw0,pw1,pw2,pw3;
  #define PKW(P,B) cvtpk_s(P[B],P[B+1])
  #define PAF(k) __builtin_bit_cast(bf16x8,pw##k)
  #define VFR(i) (bf16x8){vlo[i][0],vlo[i][1],vlo[i][2],vlo[i][3],vhi[i][0],vhi[i][1],vhi[i][2],vhi[i][3]}
  #define PIN(x) asm volatile("":"+v"(x))
  #define MX3(a,b,c) __builtin_fmaxf(__builtin_fmaxf((a),(b)),(c))
  #define GAPA(MF,A0,A1,A2,A3,W0,W1,PW) do{ MF; sacc+=A0; sacc+=A1; sacc+=A2; sacc+=A3; PIN(sacc); W0; W1; PIN(PW); SBAR(); }while(0)
  #define EX(v) __builtin_amdgcn_exp2f(v)
  #define GAPB(MF,X,B) do{ MF; X[B]=EX(X[B]); X[B+1]=EX(X[B+1]); X[B+2]=EX(X[B+2]); X[B+3]=EX(X[B+3]); PIN(X); SBAR(); }while(0)
  #define VRD(i) do{ vlo[i]=vtr(vp_+(((i)>>2)*4096+((i)&3)*1024)); vhi[i]=vtr(vp_+(((i)>>2)*4096+((i)&3)*1024+512)); }while(0)
  #define KRD(G,j) do{ if(G){ kload2(kf,kp0+sl_next,j); SBAR(); } }while(0)
  #define STEP(C0,C1,P0,P1,t,GK,GV,GL) do{ SBAR(); \
    const lds_cptr vp_=vp0+sl_prev; \
    VRD(0); SBAR(); float sacc=(P0[0]+P0[1]); \
    GAPA(C0=__builtin_amdgcn_mfma_f32_32x32x16_bf16(kf[0],qr[0],negm,0,0,0), P0[2],P0[3],P0[4],P0[5],     pw0[0]=PKW(P0,0), pw0[1]=PKW(P0,2), pw0); \
    VRD(4); SBAR(); GAPA(C1=__builtin_amdgcn_mfma_f32_32x32x16_bf16(kf[1],qr[0],negm,0,0,0), P0[6],P0[7],P0[8],P0[9],     pw0[2]=PKW(P0,4), pw0[3]=PKW(P0,6), pw0); \
    VRD(1); SBAR(); GAPA(C0=__builtin_amdgcn_mfma_f32_32x32x16_bf16(kf[2],qr[1],C0,0,0,0),   P0[10],P0[11],P0[12],P0[13], pw1[0]=PKW(P0,8), pw1[1]=PKW(P0,10), pw1); \
    VRD(5); SBAR(); GAPA(C1=__builtin_amdgcn_mfma_f32_32x32x16_bf16(kf[3],qr[1],C1,0,0,0),   P0[14],P0[15],P1[0],P1[1],   pw1[2]=PKW(P0,12),pw1[3]=PKW(P0,14), pw1); \
    VRD(2); SBAR(); GAPA(C0=__builtin_amdgcn_mfma_f32_32x32x16_bf16(kf[4],qr[2],C0,0,0,0),   P1[2],P1[3],P1[4],P1[5],     pw2[0]=PKW(P1,0), pw2[1]=PKW(P1,2), pw2); \
    VRD(6); SBAR(); GAPA(C1=__builtin_amdgcn_mfma_f32_32x32x16_bf16(kf[5],qr[2],C1,0,0,0),   P1[6],P1[7],P1[8],P1[9],     pw2[2]=PKW(P1,4), pw2[3]=PKW(P1,6), pw2); \
    VRD(3); SBAR(); GAPA(C0=__builtin_amdgcn_mfma_f32_32x32x16_bf16(kf[6],qr[3],C0,0,0,0),   P1[10],P1[11],P1[12],P1[13], pw3[0]=PKW(P1,8), pw3[1]=PKW(P1,10), pw3); \
    VRD(7); SBAR(); GAPA(C1=__builtin_amdgcn_mfma_f32_32x32x16_bf16(kf[7],qr[3],C1,0,0,0),   P1[14],P1[15],0.f,0.f,       pw3[2]=PKW(P1,12),pw3[3]=PKW(P1,14), pw3); \
    l_reg+=sacc; \
    if(GK){DMA_K((t)+3,sl_cur);} if(GV){DMA_V((t)+1,sl_next);} \
    CMASK(C0,C1,t); \
    { float a=MX3(C0[0],C0[1],C1[0]),b=MX3(C0[2],C0[3],C1[1]); a=MX3(a,C1[2],C1[3]); \
      _Pragma("unroll") for(int r=4;r<16;r+=4){a=MX3(a,C0[r],C0[r+1]);b=MX3(b,C0[r+2],C0[r+3]);a=MX3(a,C1[r],C1[r+1]);b=MX3(b,C1[r+2],C1[r+3]);} \
      float rm=__builtin_fmaxf(a,b); { auto rr=__builtin_amdgcn_permlane32_swap(__float_as_uint(rm),__float_as_uint(rm),false,false); rm=__builtin_fmaxf(__uint_as_float(rr[0]),__uint_as_float(rr[1])); } \
      resc=false; \
      if(__builtin_expect(__any(rm>(float)THRL),0)){ const float dl=__builtin_fmaxf(rm,0.f); mhat+=dl; \
        _Pragma("unroll") for(int r=0;r<16;++r){C0[r]-=dl;C1[r]-=dl;} \
        _Pragma("unroll") for(int r=0;r<16;++r)negm[r]=-mhat; asm volatile("":"+v"(negm)); \
        const float f=__builtin_amdgcn_exp2f(-dl); l_reg*=f; if(hi==0)wsf[r32]=f; resc=true; } } \
    SBAR(); \
    GAPB(o[0]=__builtin_amdgcn_mfma_f32_32x32x16_bf16(PAF(0),VFR(0),o[0],0,0,0), C0,0); \
    GAPB(o[1]=__builtin_amdgcn_mfma_f32_32x32x16_bf16(PAF(0),VFR(4),o[1],0,0,0), C0,4); \
    KRD(GL,0); GAPB(o[0]=__builtin_amdgcn_mfma_f32_32x32x16_bf16(PAF(1),VFR(1),o[0],0,0,0), C0,8); \
    KRD(GL,1); GAPB(o[1]=__builtin_amdgcn_mfma_f32_32x32x16_bf16(PAF(1),VFR(5),o[1],0,0,0), C0,12); \
    KRD(GL,2); GAPB(o[0]=__builtin_amdgcn_mfma_f32_32x32x16_bf16(PAF(2),VFR(2),o[0],0,0,0), C1,0); \
    KRD(GL,3); GAPB(o[1]=__builtin_amdgcn_mfma_f32_32x32x16_bf16(PAF(2),VFR(6),o[1],0,0,0), C1,4); \
    GAPB(o[0]=__builtin_amdgcn_mfma_f32_32x32x16_bf16(PAF(3),VFR(3),o[0],0,0,0), C1,8); \
    GAPB(o[1]=__builtin_amdgcn_mfma_f32_32x32x16_bf16(PAF(3),VFR(7),o[1],0,0,0), C1,12); \
    }while(0)
  int t=1;
  #undef CMASK
  #define CMASK(P0,P1,t) do{}while(0)
  for(;t+5<NT;t+=2){
    STEP(pB0,pB1,pA0,pA1,t,true,true,true);     WAIT_BAR(2); RESC(); ROT();
    STEP(pA0,pA1,pB0,pB1,t+1,true,true,true);   WAIT_BAR(2); RESC(); ROT();
  }
  #undef CMASK
  #define CMASK(P0,P1,t) do{int jb_=(t)-(NT-4); if(jb_>=0)cmask(P0,P1,jb_,qrel,hi);}while(0)
  #define ENDW(tt) do{ if((tt)+3<NT){WAIT_BAR(2);} else if((tt)+2<NT){WAIT_BAR(1);} else {WAIT_BAR(0);} }while(0)
  for(;t+1<NT;t+=2){
    STEP(pB0,pB1,pA0,pA1,t,(t+3<NT),(t+1<NT),(t+1<NT));       ENDW(t);   RESC(); ROT();
    STEP(pA0,pA1,pB0,pB1,t+1,(t+4<NT),(t+2<NT),(t+2<NT));     ENDW(t+1); RESC(); ROT();
  }
  STEP(pB0,pB1,pA0,pA1,NT-1,false,false,false); RESC();
  { float sacc=pB0[0]+pB0[1]; _Pragma("unroll") for(int r=2;r<16;++r)sacc+=pB0[r]; _Pragma("unroll") for(int r=0;r<16;++r)sacc+=pB1[r]; l_reg+=sacc;
    pw0=(u32x4){PKW(pB0,0),PKW(pB0,2),PKW(pB0,4),PKW(pB0,6)};pw1=(u32x4){PKW(pB0,8),PKW(pB0,10),PKW(pB0,12),PKW(pB0,14)};pw2=(u32x4){PKW(pB1,0),PKW(pB1,2),PKW(pB1,4),PKW(pB1,6)};pw3=(u32x4){PKW(pB1,8),PKW(pB1,10),PKW(pB1,12),PKW(pB1,14)};
    SBAR(); pv(o,vb0+sl_cur,PAF(0),PAF(1),PAF(2),PAF(3)); }
  #undef PKW
  #undef PAF
  #undef VFR
  #undef PIN
  #undef MX3
  #undef GAPA
  #undef GAPB
  #undef EX
  #undef VRD
  #undef KRD
  #undef STEP
  #undef ENDW
  {auto rr=__builtin_amdgcn_permlane32_swap(__float_as_uint(l_reg),__float_as_uint(l_reg),false,false);l_reg=__uint_as_float(rr[0])+__uint_as_float(rr[1]);}
  if(hi==0)wsf[32+r32]=l_reg;asm volatile("s_waitcnt lgkmcnt(0)":::"memory");
  float rli[16];
  #pragma unroll
  for(int r=0;r<16;++r)rli[r]=__builtin_amdgcn_rcpf(wsf[32+crow(r,hi)]);
  bf16*Ow=O+(rowbase+q0+wid*QBLK)*PO+h*D;
  { bf16*stg=(bf16*)(shm+LDS_OST)+wid*2048;
    #pragma unroll
    for(int r=0;r<16;++r){const int orow=crow(r,hi);
      #pragma unroll
      for(int d0=0;d0<2;++d0)stg[orow*64+d0*32+r32]=__float2bfloat16(o[d0][r]*rli[r]);}
    asm volatile("s_waitcnt lgkmcnt(0)":::"memory");
    #pragma unroll
    for(int i=0;i<4;++i){const int row=i*8+(lane>>3),ch=lane&7; const u32x4 v=*(const u32x4*)(stg+row*64+ch*8); ATTN_STORE16(Ow+(long)row*PO+ch*8,v);} }
  asm volatile("s_waitcnt lgkmcnt(0)\n\ts_barrier":::"memory");
  #undef DMA_K
  #undef DMA_V
  #undef CMASK
  #undef START
  #undef RESC
  #undef ROT
}
constexpr int ATTN_LDS_BYTES=LDS_BYTES;
#undef SBAR
#undef WAIT_BAR
}

#define XB_TMO      128
#define XB_XCNT(j)  (256  + 64 * (j))
#define XB_XSUB(j)  (1280 + 64 * (j))
#define XB_XGEN(j)  (2304 + 64 * (j))
#define XB_TOP      3328
#define XB_TOPGEN   3392
#define XCD_BAR_WORDS 3456
#define XB_SPIN_CAP (1u << 18)

__device__ __forceinline__ unsigned xb_ld(unsigned* p)              { return __hip_atomic_load(p, __ATOMIC_RELAXED, __HIP_MEMORY_SCOPE_AGENT); }
__device__ __forceinline__ unsigned xb_add(unsigned* p, unsigned v) { return __hip_atomic_fetch_add(p, v, __ATOMIC_RELAXED, __HIP_MEMORY_SCOPE_AGENT); }
__device__ __forceinline__ unsigned xb_xcc_id() { unsigned r; asm volatile("s_getreg_b32 %0, hwreg(20, 0, 4)" : "=s"(r)); r &= 0xFu; asm volatile("" : "+v"(r)); return r; }
#define XB_SPIN(cond, bar) do { unsigned _sp = 0; while (cond) { __builtin_amdgcn_s_sleep(1); \
    if ((++_sp & 255u) == 0u) { if (xb_ld(&(bar)[XB_TMO])) break; if (_sp > XB_SPIN_CAP) { atomicAdd(&(bar)[XB_TMO], 1u); break; } } } } while (0)

struct XcdBarrier {
    unsigned* bar; unsigned x;
    volatile LAS unsigned* st;
};

__device__ __forceinline__ XcdBarrier xcd_barrier_post(unsigned* bar, volatile LAS unsigned* st, int tid) {
    XcdBarrier b; b.bar = bar; b.x = xb_xcc_id(); b.st = st;
    if (tid == 0) (void)xb_add(&bar[XB_XCNT(b.x)], 1u);
    return b;
}
__device__ __forceinline__ void xcd_barrier_complete(unsigned* bar, unsigned x, unsigned& nloc, unsigned& nx) {
    const unsigned G = gridDim.x * gridDim.y * gridDim.z;
    unsigned sum, cnt, mine, sp = 0u;
    for (;;) {
        sum = 0u; cnt = 0u; mine = 0u;
#pragma unroll
        for (unsigned j = 0; j < 16; ++j) { const unsigned c = xb_ld(&bar[XB_XCNT(j)]); sum += c; cnt += (c > 0u) ? 1u : 0u; mine = (j == x) ? c : mine; }
        if (sum == G) break;
        __builtin_amdgcn_s_sleep(1);
        if ((++sp & 255u) == 0u) { if (xb_ld(&bar[XB_TMO])) break; if (sp > XB_SPIN_CAP) { atomicAdd(&bar[XB_TMO], 1u); break; } }
    }
    nloc = mine > 0u ? mine : 1u; nx = cnt > 0u ? cnt : 1u;
}

__device__ __forceinline__ void xcd_barrier(const XcdBarrier& b, int tid) {
    asm volatile("s_waitcnt vmcnt(0)" ::: "memory");
    __syncthreads();
    if (tid == 0) {
        unsigned* bar = b.bar;
        __builtin_amdgcn_s_waitcnt(0);
        unsigned nloc = b.st[0], nx = b.st[1];
        if (nloc == 0u) { xcd_barrier_complete(bar, b.x, nloc, nx); b.st[0] = nloc; b.st[1] = nx; }
        const unsigned old = xb_add(&bar[XB_XSUB(b.x)], 1u);
        const unsigned gen = old / nloc;
        if (old + 1u == (gen + 1u) * nloc) {
            __builtin_amdgcn_fence(__ATOMIC_RELEASE, "agent");
            asm volatile("s_waitcnt vmcnt(0)" ::: "memory");
            const unsigned og = xb_add(&bar[XB_TOP], 1u);
            const unsigned tg = og / nx;
            if (og + 1u == (tg + 1u) * nx) xb_add(&bar[XB_TOPGEN], 1u);
            else XB_SPIN(xb_ld(&bar[XB_TOPGEN]) == tg, bar);
            __builtin_amdgcn_fence(__ATOMIC_ACQUIRE, "agent");
            xb_add(&bar[XB_XGEN(b.x)], 1u);
            asm volatile("s_waitcnt vmcnt(0)" ::: "memory");
        } else {
            XB_SPIN(xb_ld(&bar[XB_XGEN(b.x)]) == gen, bar);
            __builtin_amdgcn_fence(__ATOMIC_ACQUIRE, "agent");
            asm volatile("s_waitcnt vmcnt(0)" ::: "memory");
        }
    }
    __syncthreads();
}


namespace mk {
struct Params { const float* in[32]; float* out; unsigned char* ws; };
enum { I_X = 0, I_MEM, I_NMIX, I_WIN, I_WOUT, I_QG, I_KG, I_LQ1, I_LK1, I_LQ2, I_LK2, I_SUBG, I_SCW, I_SCB, I_SDTB, I_SALOG, I_SD, I_SNG,
       I_GCW, I_GALOG, I_GDTB, I_GNG, I_NX, I_NMEM, I_WCQ, I_WCKV, I_XQG, I_XKG, I_WCO, I_NFFN, I_WGU, I_WDN };
#define GAS __attribute__((address_space(1)))
__device__ __forceinline__ const float* pin(const Params& p, int i) { asm volatile("" : "+s"(i)); const GAS float* w = (const GAS float*)p.in[i]; asm volatile("" : "+s"(w)); return (const float*)w; }
__device__ __forceinline__ unsigned char* wsp(const Params& p) { GAS unsigned char* w = (GAS unsigned char*)p.ws; asm volatile("" : "+s"(w)); return (unsigned char*)w; }
__device__ __forceinline__ float* outp(const Params& p) { GAS float* w = (GAS float*)p.out; asm volatile("" : "+s"(w)); return (float*)w; }
constexpr size_t MiB = 1u << 20;
constexpr size_t WS_CTL = 0, CTL_BYTES = 1 * MiB;
constexpr size_t WS_SS = 128 * 1024;
constexpr size_t WS_WIN = 1 * MiB, WS_WOUT = 9 * MiB, WS_WCQ = 11 * MiB, WS_WCO = 13 * MiB, WS_WGU = 15 * MiB, WS_WDN = 26 * MiB;
constexpr size_t WS_WCKV = 32 * MiB;
constexpr size_t WS_MEMN = 48 * MiB;
constexpr size_t WS_KN = 56 * MiB;
constexpr size_t WS_VT = 64 * MiB;
constexpr size_t WS_H = 72 * MiB;
constexpr size_t WS_SM = 104 * MiB;
constexpr size_t WS_PROJ = 106 * MiB;
constexpr size_t WS_AO = 218 * MiB;
constexpr size_t WS_CAT = 250 * MiB;
constexpr size_t WS_YS = 282 * MiB;
constexpr size_t WS_ST = 298 * MiB;
constexpr size_t WS_HP = 314 * MiB;
constexpr size_t WS_CM = 322 * MiB;
constexpr size_t WS_EA = 330 * MiB;
constexpr size_t WS_OG = 331 * MiB;
constexpr size_t WS_SSP = 347 * MiB;
constexpr size_t WS_END = 352 * MiB;
__device__ __forceinline__ size_t woff(int which, int par) {
    if (par == 0) return which == 0 ? WS_WIN : which == 1 ? WS_WOUT : which == 2 ? WS_WCQ : which == 3 ? WS_WCO : WS_WGU;
    return which == 0 ? 32 * MiB : which == 1 ? 39 * MiB + MiB / 2 : which == 2 ? 41 * MiB + MiB / 2 : which == 3 ? 350 * MiB : 43 * MiB + MiB / 2;
}
constexpr size_t GO_W = 0, GO_QG = 8 * MiB, GO_ATT = 16 * MiB, GO_KGT = 24 * MiB;
constexpr size_t WS_GU = WS_CAT;
constexpr int LDS_BYTES = 160 * 1024;
constexpr int LDS_SLOT = LDS_BYTES - 256;

__device__ __forceinline__ void lds_wait() { asm volatile("s_waitcnt lgkmcnt(0)" ::: "memory"); }

#define TSW(n, t) ((n) * 136 + (((((t) >> 3) ^ (((n) >> 3) & 7))) << 3) + ((t) & 7))
template <int M, int N, int K, bool SWA = false, bool SWB = false, class Epi>
__device__ __forceinline__ void mm16(const LAS bf16_t* A, int lda, const LAS bf16_t* Bt, int ldb, int wid, int lane, Epi epi) {
    const int fr = lane & 15, fq = lane >> 4;
    constexpr int NB = N / 16, NBLK = (M / 16) * NB;
    for (int blk = wid; blk < NBLK; blk += 8) {
        const int mb = blk / NB, nb = blk % NB;
        f32x4 acc = {0.f, 0.f, 0.f, 0.f};
        const int ra = mb * 16 + fr, rb = nb * 16 + fr;
        const LAS bf16_t* ap = A + ra * lda; const LAS bf16_t* bp = Bt + rb * ldb;
        const int sa = SWA ? ((ra >> 3) & 7) : 0, sb = SWB ? ((rb >> 3) & 7) : 0;
#pragma unroll
        for (int k0 = 0; k0 < K; k0 += 32) acc = __builtin_amdgcn_mfma_f32_16x16x32_bf16(*(const LAS bf16x8*)(ap + ((((k0 >> 3) + fq) ^ sa) << 3)), *(const LAS bf16x8*)(bp + ((((k0 >> 3) + fq) ^ sb) << 3)), acc, 0, 0, 0);
#pragma unroll
        for (int i = 0; i < 4; ++i) epi(mb * 16 + fq * 4 + i, nb * 16 + fr, acc[i]);
    }
}

template <int M, int N, int K, bool SWA = false, bool SWB = false, class Epi>
__device__ __forceinline__ void mm16v(const LAS bf16_t* A, int lda, const LAS bf16_t* Bt, int ldb, int wid, int lane, Epi epi) {
    const int fr = lane & 15, fq = lane >> 4;
    constexpr int NB = N / 16, NBLK = (M / 16) * NB;
    for (int blk = wid; blk < NBLK; blk += 8) {
        const int mb = blk / NB, nb = blk % NB;
        f32x4 acc = {0.f, 0.f, 0.f, 0.f};
        const int ra = mb * 16 + fr, rb = nb * 16 + fr;
        const LAS bf16_t* ap = A + ra * lda; const LAS bf16_t* bp = Bt + rb * ldb;
        const int sa = SWA ? ((ra >> 3) & 7) : 0, sb = SWB ? ((rb >> 3) & 7) : 0;
#pragma unroll
        for (int k0 = 0; k0 < K; k0 += 32) acc = __builtin_amdgcn_mfma_f32_16x16x32_bf16(*(const LAS bf16x8*)(ap + ((((k0 >> 3) + fq) ^ sa) << 3)), *(const LAS bf16x8*)(bp + ((((k0 >> 3) + fq) ^ sb) << 3)), acc, 0, 0, 0);
        epi(mb * 16 + fq * 4, nb * 16 + fr, acc);
    }
}

__device__ __forceinline__ int maprow(int mode, int n) {
    if (mode == 0) return n;
    if (mode == 1) { if (n >= 2560 && n < 2564) return 3584 + (n - 2560); if (n >= 3588) return 3588 + (n - 3588); const int c = n < 2560 ? n : n - 4; const int cl = c & 255; return (c & ~255) + 128 * ((cl >> 5) & 1) + 32 * (cl >> 6) + (cl & 31); }
    if (n < D_FF) return (n >> 7) * 256 + (n & 127);
    const int n2 = n - D_FF; return (n2 >> 7) * 256 + 128 + (n2 & 127);
}
__device__ __forceinline__ void transpose_item(const float* W, int K, int N, bf16_t* WT, int mode, LAS float* scr, int item, int lane, const float* gk = nullptr) {
    const int nblk = (N + 63) / 64, kb = item / nblk, nb = item % nblk, k0 = 64 * kb, n0 = 64 * nb;
    const int nq = (lane & 15) * 4; const bool okn = n0 + nq < N;
    f32x4 v[16];
#pragma unroll
    for (int i = 0; i < 16; ++i) { const int kk = 4 * i + (lane >> 4); v[i] = okn ? *(const f32x4*)(W + (size_t)(k0 + kk) * N + n0 + nq) : (f32x4){0.f, 0.f, 0.f, 0.f}; if (gk) v[i] = v[i] * gk[k0 + kk]; }
#pragma unroll
    for (int i = 0; i < 16; ++i) { const int kk = 4 * i + (lane >> 4);
#pragma unroll
        for (int q = 0; q < 4; ++q) scr[kk * 65 + nq + q] = v[i][q]; }
    lds_wait(); asm volatile("" ::: "memory");
    const int c = lane & 7;
#pragma unroll
    for (int j = 0; j < 8; ++j) { const int nn = (lane >> 3) + 8 * j; const int n = n0 + nn; const int row = n < N ? maprow(mode, n) : -1; const LAS float* s = scr + (8 * c) * 65 + nn;
        u32x4 o; o.x = pk2(s[0 * 65], s[1 * 65]); o.y = pk2(s[2 * 65], s[3 * 65]); o.z = pk2(s[4 * 65], s[5 * 65]); o.w = pk2(s[6 * 65], s[7 * 65]);
        if (row >= 0) *(u32x4*)(WT + (size_t)row * K + k0 + 8 * c) = o; }
    lds_wait(); asm volatile("" ::: "memory");
}
__device__ __forceinline__ void norm_row(const float* xrow, const float* g, bf16_t* orow, int lane, f32x4 (&y)[4]) {
    const f32x4* xr = (const f32x4*)xrow + lane; const f32x4* gr = (const f32x4*)g + lane;
    float s = 0.f;
#pragma unroll
    for (int j = 0; j < 4; ++j) { y[j] = xr[64 * j]; s += dot4v(y[j]); }
    const float rstd = rsqrtf(wave_sum(s, lane) * (1.f / DM) + NORM_EPS);
    unsigned long long* o8 = (unsigned long long*)orow + lane;
#pragma unroll
    for (int j = 0; j < 4; ++j) { y[j] = y[j] * rstd * gr[64 * j]; o8[64 * j] = (unsigned long long)pk2(y[j][0], y[j][1]) | ((unsigned long long)pk2(y[j][2], y[j][3]) << 32); }
}

constexpr int CI_IN = 16 * 57, CI_SQ = 16 * 16, CI_GU = 16 * 88, CI_DN = 44 * 16, CI_MAIN = CI_IN + 3 * CI_SQ + CI_GU;
__device__ __forceinline__ void conv_item_main(const Params& p, unsigned char* ws, int l, int r, LAS float* scr, int lane) {
    const int par = l & 1;
    if (r < CI_IN) { transpose_item(pin(p, I_WIN) + (size_t)l * DM * P_IN, DM, P_IN, (bf16_t*)(ws + woff(0, par)), 1, scr, r, lane, pin(p, I_NMIX) + l * DM); return; } r -= CI_IN;
    if (r < CI_SQ) { transpose_item(pin(p, I_WOUT) + (size_t)l * DM * DM, DM, DM, (bf16_t*)(ws + woff(1, par)), 0, scr, r, lane); return; } r -= CI_SQ;
    if (r < CI_SQ) { transpose_item(pin(p, I_WCQ) + (size_t)l * DM * DM, DM, DM, (bf16_t*)(ws + woff(2, par)), 0, scr, r, lane, pin(p, I_NX) + l * DM); return; } r -= CI_SQ;
    if (r < CI_SQ) { transpose_item(pin(p, I_WCO) + (size_t)l * DM * DM, DM, DM, (bf16_t*)(ws + woff(3, par)), 0, scr, r, lane); return; } r -= CI_SQ;
    transpose_item(pin(p, I_WGU) + (size_t)l * DM * 2 * D_FF, DM, 2 * D_FF, (bf16_t*)(ws + woff(4, par)), 2, scr, r, lane, pin(p, I_NFFN) + l * DM);
}
__device__ __forceinline__ void conv_item_dn(const Params& p, unsigned char* ws, int l, int r, LAS float* scr, int lane) {
    transpose_item(pin(p, I_WDN) + (size_t)l * D_FF * DM, D_FF, DM, (bf16_t*)(ws + WS_WDN), 0, scr, r, lane);
}
__device__ __forceinline__ void conv_unit(const Params& p, int l, int cu, bool dn, LAS unsigned char* lds, int lane, int wid) {
    asm volatile("" : "+v"(lds)); asm volatile("" : "+v"(lane));
    unsigned char* ws = wsp(p); LAS float* scr = (LAS float*)(lds + wid * 16896); const int item = cu * 8 + wid;
    if (dn) { if (item < CI_DN) conv_item_dn(p, ws, l, item, scr, lane); } else { if (item < CI_MAIN) conv_item_main(p, ws, l, item, scr, lane); }
}
__device__ __forceinline__ void phase_a(const Params& p, int l, LAS unsigned char* lds, int tid, int lane, int wid) {
    asm volatile("" : "+v"(lds));
    unsigned char* ws = p.ws;
    const int gw = blockIdx.x * 8 + wid, NGW = gridDim.x * 8;
    LAS float* scr = (LAS float*)(lds + wid * 16896);
    {
        for (int it = gw; it < CI_MAIN + CI_DN; it += NGW) { if (it < CI_MAIN) conv_item_main(p, ws, l, it, scr, lane); else conv_item_dn(p, ws, l, it - CI_MAIN, scr, lane); }
        if (l == 0) {
            for (int it = gw; it < 4 * 512; it += NGW) { const int ll = it >> 9;
                transpose_item(pin(p, I_WCKV) + (size_t)ll * DM * 2048, DM, 2048, (bf16_t*)(ws + WS_WCKV) + (size_t)ll * 2048 * DM, 0, scr, it & 511, lane); }
            for (int m = gw; m < 4 * NMEM; m += NGW) { const int ll = m >> 10, r = m & 1023; f32x4 y[4];
                norm_row(pin(p, I_MEM) + (size_t)r * DM, pin(p, I_NMEM) + ll * DM, (bf16_t*)(ws + WS_MEMN) + (size_t)m * DM, lane, y); }
        }
    }
    if (l == 0) {
        const float* xin = pin(p, I_X); bf16_t* H = (bf16_t*)(ws + WS_H); float* SS = (float*)(ws + WS_SSP);
        for (int m = gw; m < MTOK; m += NGW) {
            const f32x4* xr = (const f32x4*)(xin + (size_t)m * DM) + lane; unsigned long long* o8 = (unsigned long long*)(H + (size_t)m * DM) + lane;
            float sq = 0.f;
#pragma unroll
            for (int j = 0; j < 4; ++j) { const f32x4 v = xr[64 * j]; sq += dot4v(v); o8[64 * j] = (unsigned long long)pk2(v[0], v[1]) | ((unsigned long long)pk2(v[2], v[3]) << 32); }
            sq = wave_sum(sq, lane);
            if (lane < 16) SS[(size_t)m * 16 + lane] = lane == 0 ? sq : 0.f;
        }
    }
}
__device__ __forceinline__ void phase_norm(const Params& p, const float* g, int lane, int wid) {
    const int gw = blockIdx.x * 8 + wid, NGW = gridDim.x * 8;
    bf16_t* H = (bf16_t*)(wsp(p) + WS_H);
    for (int m = gw; m < MTOK; m += NGW) { f32x4 y[4]; norm_row(outp(p) + (size_t)m * DM, g, H + (size_t)m * DM, lane, y); }
}

__device__ __forceinline__ void unpack8(u32x4 v, float (&f)[8]) {
#pragma unroll
    for (int i = 0; i < 4; ++i) { f[2 * i] = __builtin_bit_cast(float, v[i] << 16); f[2 * i + 1] = __builtin_bit_cast(float, v[i] & 0xffff0000u); }
}

__device__ __forceinline__ void ssd_prep_unit(const Params& p, int l, int unit, LAS unsigned char* lds, int tid, int lane, int wid) {
    asm volatile("" : "+v"(lds));
    unsigned char* ws = wsp(p);
    const int h = unit & 3, c = (unit >> 2) & 31, b = unit >> 7, g = h >> 1;
    const int tok0 = b * SEQ + c * 128;
    const bf16_t* PROJ = (const bf16_t*)(ws + WS_PROJ); const float* SM = (const float*)(ws + WS_SM);
    LAS bf16_t* Cm = (LAS bf16_t*)(lds); LAS bf16_t* Bm = (LAS bf16_t*)(lds + 34816); LAS bf16_t* BmT = (LAS bf16_t*)(lds + 69632);
    LAS bf16_t* XSt = (LAS bf16_t*)(lds + 104448); LAS bf16_t* XDt = (LAS bf16_t*)(lds + 121856);
    LAS float* dtv = (LAS float*)(lds + 139264); LAS float* acum = (LAS float*)(lds + 139264 + 512);
    const float a_neg = -__expf(pin(p, I_SALOG)[l * 4 + h]);
    if (tid < 128) dtv[tid] = softplus_f(SM[(size_t)(tok0 + tid) * 12 + h] + pin(p, I_SDTB)[l * 4 + h]);
    __syncthreads();
    if (wid == 0) { const float s0 = wave_incl_scan(dtv[lane] * a_neg, lane); const float tot = __builtin_bit_cast(float, __builtin_amdgcn_readlane(__builtin_bit_cast(int, s0), 63)); const float s1 = wave_incl_scan(dtv[lane + 64] * a_neg, lane) + tot; acum[lane] = s0; acum[lane + 64] = s1; }
    __syncthreads();
    if (tid < 320) {
        const int o = tid % 40, tg = tid / 40;
        int ch; if (o < 8) ch = h * 64 + o * 8; else if (o < 24) ch = 256 + g * 128 + (o - 8) * 8; else ch = 512 + g * 128 + (o - 24) * 8;
        const float* cw = pin(p, I_SCW) + (size_t)l * 4 * 768 + ch; const float* cb = pin(p, I_SCB) + (size_t)l * 768 + ch;
        float w0[8], w1[8], w2[8], w3[8], bs[8];
#pragma unroll
        for (int j = 0; j < 8; ++j) { w0[j] = cw[j]; w1[j] = cw[768 + j]; w2[j] = cw[2 * 768 + j]; w3[j] = cw[3 * 768 + j]; bs[j] = cb[j]; }
        const bf16_t* src = PROJ + (size_t)tok0 * PN + 1792 + ch;
        int t0 = tg * 16; asm volatile("" : "+v"(t0));
        const int sp = c * 128 + t0;
        const bf16_t* rp = src + (ptrdiff_t)(t0 - 3) * PN;
        u32x4 raw[19];
#pragma unroll
        for (int r = 0; r < 19; ++r) { const bool ok = (r >= 3) || (sp + r - 3 >= 0); raw[r] = *(const u32x4*)(ok ? rp + (size_t)r * PN : src); if (!ok) raw[r] = (u32x4){0u, 0u, 0u, 0u}; }
        float x0[8], x1[8], x2[8], cur[8];
        unpack8(raw[0], x0); unpack8(raw[1], x1); unpack8(raw[2], x2);
        const float alast = acum[127];
#pragma unroll
        for (int tt = 0; tt < 16; ++tt) {
            const int t = t0 + tt;
            unpack8(raw[tt + 3], cur);
            float v[8];
#pragma unroll
            for (int j = 0; j < 8; ++j) { const float a = bs[j] + ((w0[j] * x0[j] + w1[j] * x1[j]) + (w2[j] * x2[j] + w3[j] * cur[j])); v[j] = silu_f(a); x0[j] = x1[j]; x1[j] = x2[j]; x2[j] = cur[j]; }
            if (o < 8) {
                const float sc = dtv[t] * __expf(alast - acum[t]);
#pragma unroll
                for (int j = 0; j < 8; ++j) { XSt[TSW(o * 8 + j, t)] = (bf16_t)f2bf(v[j]); XDt[TSW(o * 8 + j, t)] = (bf16_t)f2bf(v[j] * sc); }
            } else {
                u32x4 pk; pk.x = pk2(v[0], v[1]); pk.y = pk2(v[2], v[3]); pk.z = pk2(v[4], v[5]); pk.w = pk2(v[6], v[7]);
                if (o < 24) { const int n0 = (o - 8) * 8; *(LAS u32x4*)(Bm + t * 136 + n0) = pk;
#pragma unroll
                    for (int j = 0; j < 8; ++j) BmT[TSW(n0 + j, t)] = (bf16_t)f2bf(v[j]);
                } else { const int n0 = (o - 24) * 8; *(LAS u32x4*)(Cm + t * 136 + n0) = pk;
                    if ((h & 1) == 0) *(u32x4*)((bf16_t*)(ws + WS_CM) + (size_t)(tok0 + t) * 256 + g * 128 + n0) = pk; }
            }
        }
    }
    __syncthreads();
    {
        float* ST = (float*)(ws + WS_ST) + (size_t)unit * 8192;
        mm16v<128, 64, 128, true, true>(BmT, 136, XDt, 136, wid, lane, [&](int n0, int pp, f32x4 v) { *(f32x4*)(ST + pp * 128 + n0) = v; });
    }
    __syncthreads();
    {
        LAS bf16_t* Sc = BmT;
        mm16<128, 128, 128>(Cm, 136, Bm, 136, wid, lane, [&](int li, int s, float v) { Sc[li * 136 + s] = (li >= s) ? (bf16_t)f2bf(v * __expf(acum[li] - acum[s]) * dtv[s]) : (bf16_t)0; });
    }
    __syncthreads();
    {
        const float Dh = pin(p, I_SD)[l * 4 + h];
        float* Y = (float*)(ws + WS_YS);
        mm16v<64, 128, 128, true, false>(XSt, 136, BmT, 136, wid, lane, [&](int p0, int li, f32x4 v) {
#pragma unroll
            for (int i = 0; i < 4; ++i) v[i] += Dh * bf2f(XSt[TSW(p0 + i, li)]);
            *(f32x4*)(Y + (size_t)(tok0 + li) * 256 + h * 64 + p0) = v; });
        if (tid < 128) ((float*)(ws + WS_EA))[(size_t)(tok0 + tid) * 4 + h] = __expf(acum[tid]);
        if (tid == 0) ((float*)(ws + WS_EA + 512 * 1024))[unit] = __expf(acum[127]);
    }
    __syncthreads();
}
__device__ __forceinline__ void ssd_scan_unit(const Params& p, int su, int tid) {
    asm volatile("" : "+v"(tid));
    unsigned char* ws = wsp(p); const int b = su >> 2, h = su & 3;
    f32x4 hs[4];
#pragma unroll
    for (int j = 0; j < 4; ++j) hs[j] = (f32x4){0.f, 0.f, 0.f, 0.f};
    const float* DEC = (const float*)(ws + WS_EA + 512 * 1024);
    for (int c = 0; c < 32; ++c) {
        const int unit = (b * 32 + c) * 4 + h;
        const float* src = (const float*)(ws + WS_ST) + (size_t)unit * 8192; bf16_t* dst = (bf16_t*)(ws + WS_HP) + (size_t)unit * 8192;
        const float dec = DEC[unit];
#pragma unroll
        for (int j = 0; j < 4; ++j) { const int e = (tid + 512 * j) * 4; u32x2 w; w.x = pk2(hs[j][0], hs[j][1]); w.y = pk2(hs[j][2], hs[j][3]); *(u32x2*)(dst + e) = w; hs[j] = hs[j] * dec + *(const f32x4*)(src + e); }
    }
}

__device__ __forceinline__ void gdn_prep_unit(const Params& p, int l, int gu, LAS unsigned char* lds, int tid, int lane, int wid) {
    asm volatile("" : "+v"(lds));
    unsigned char* ws = wsp(p);
    const int c = gu & 63, h = (gu >> 6) & 3, b = gu >> 8;
    unsigned char* gob = (unsigned char*)outp(p);
    const int tok0 = b * SEQ + c * 64;
    const bf16_t* PROJ = (const bf16_t*)(ws + WS_PROJ); const float* SM = (const float*)(ws + WS_SM);
    LAS float* QKVf = (LAS float*)lds;
    LAS bf16_t* Qs = (LAS bf16_t*)(lds + 49408); LAS bf16_t* Ks = (LAS bf16_t*)(lds + 58624);
    LAS float* Tm = (LAS float*)(lds + 67840);
    LAS float* RHS = (LAS float*)(lds + 85248);
    LAS float* betas = (LAS float*)(lds + 119040); LAS float* gcs = (LAS float*)(lds + 119296);
    if (tid < 64) {
        const float braw = SM[(size_t)(tok0 + tid) * 12 + 4 + h], araw = SM[(size_t)(tok0 + tid) * 12 + 8 + h];
        betas[tid] = sigmoid_f(braw);
        const float gl = -__expf(pin(p, I_GALOG)[l * 4 + h]) * softplus_f(araw + pin(p, I_GDTB)[l * 4 + h]);
        gcs[tid] = wave_incl_scan(gl, lane);
    }
    if (tid < 384) {
        const int o = tid % 24, tg = tid / 24;
        const int ch = (o >> 3) * 256 + h * 64 + (o & 7) * 8;
        const float* cw = pin(p, I_GCW) + (size_t)l * 4 * 768 + ch;
        float w0[8], w1[8], w2[8], w3[8];
#pragma unroll
        for (int j = 0; j < 8; ++j) { w0[j] = cw[j]; w1[j] = cw[768 + j]; w2[j] = cw[2 * 768 + j]; w3[j] = cw[3 * 768 + j]; }
        const bf16_t* src = PROJ + (size_t)tok0 * PN + 2560 + ch;
        int t0 = tg * 4; asm volatile("" : "+v"(t0));
        const int sp = c * 64 + t0;
        const bf16_t* rp = src + (ptrdiff_t)(t0 - 3) * PN;
        u32x4 raw[7];
#pragma unroll
        for (int r = 0; r < 7; ++r) { const bool ok = (r >= 3) || (sp + r - 3 >= 0); raw[r] = *(const u32x4*)(ok ? rp + (size_t)r * PN : src); if (!ok) raw[r] = (u32x4){0u, 0u, 0u, 0u}; }
        float x0[8], x1[8], x2[8], cur[8];
        unpack8(raw[0], x0); unpack8(raw[1], x1); unpack8(raw[2], x2);
#pragma unroll
        for (int tt = 0; tt < 4; ++tt) {
            const int t = t0 + tt;
            unpack8(raw[tt + 3], cur);
#pragma unroll
            for (int j = 0; j < 8; ++j) { const float a = (w0[j] * x0[j] + w1[j] * x1[j]) + (w2[j] * x2[j] + w3[j] * cur[j]); QKVf[t * 193 + o * 8 + j] = silu_f(a); x0[j] = x1[j]; x1[j] = x2[j]; x2[j] = cur[j]; }
        }
    }
    __syncthreads();
    LAS bf16_t* KT = (LAS bf16_t*)(lds + 120320);
    {
        const int t = tid >> 3, which = (tid >> 2) & 1, q4 = tid & 3;
        const LAS float* row = QKVf + t * 193 + which * 64 + q4 * 16;
        float e[16]; float ss = 0.f;
#pragma unroll
        for (int d = 0; d < 16; ++d) { e[d] = row[d]; ss += e[d] * e[d]; }
        ss += dpp_f<0xB1>(ss); ss += dpp_f<0x4E>(ss);
        const float rinv = rsqrtf(ss + 1e-6f);
        const float gct = gcs[t];
        if (which == 0) {
            const float sc = rinv * 0.125f, eg = __expf(gct);
            u32x4 g0, g1;
#pragma unroll
            for (int d = 0; d < 16; d += 2) { const float v0 = e[d] * sc, v1 = e[d + 1] * sc; *(LAS unsigned*)(Qs + t * 72 + q4 * 16 + d) = pk2(v0, v1); const unsigned w = pk2(v0 * eg, v1 * eg); if (d < 8) g0[d >> 1] = w; else g1[(d - 8) >> 1] = w; }
            bf16_t* QG = (bf16_t*)(gob + GO_QG) + (size_t)gu * 4096 + t * 64 + q4 * 16;
            *(u32x4*)QG = g0; *(u32x4*)(QG + 8) = g1;
        } else {
            const float bt = betas[t] * __expf(gct), ek = __expf(gcs[63] - gct);
#pragma unroll
            for (int d = 0; d < 16; d += 2) { const float v0 = e[d] * rinv, v1 = e[d + 1] * rinv; *(LAS unsigned*)(Ks + t * 72 + q4 * 16 + d) = pk2(v0, v1);
                KT[(q4 * 16 + d) * 72 + t] = (bf16_t)f2bf(v0 * ek); KT[(q4 * 16 + d + 1) * 72 + t] = (bf16_t)f2bf(v1 * ek); }
#pragma unroll
            for (int d = 0; d < 16; d += 4) *(LAS f32x4*)(RHS + t * 132 + 64 + q4 * 16 + d) = (f32x4){e[d] * rinv * bt, e[d + 1] * rinv * bt, e[d + 2] * rinv * bt, e[d + 3] * rinv * bt};
        }
    }
    for (int idx = tid; idx < 4096; idx += 512) { const int t = idx >> 6, d = idx & 63; RHS[t * 132 + d] = QKVf[t * 193 + 128 + d] * betas[t]; }
    __syncthreads();
    { const int r = tid >> 3, c8 = (tid & 7) * 8; *(u32x4*)((bf16_t*)(gob + GO_KGT) + (size_t)gu * 4096 + r * 64 + c8) = *(const LAS u32x4*)(KT + r * 72 + c8); }
    mm16<64, 64, 64>(Ks, 72, Ks, 72, wid, lane, [&](int i, int j, float v) { Tm[i * 68 + j] = (i > j) ? v * betas[i] * __expf(gcs[i] - gcs[j]) : 0.f; });
    {
        bf16_t* ATT = (bf16_t*)(gob + GO_ATT) + (size_t)gu * 4096;
        mm16v<64, 64, 64>(Ks, 72, Qs, 72, wid, lane, [&](int j0, int i, f32x4 v) { const float gi = gcs[i]; float o[4];
#pragma unroll
            for (int q = 0; q < 4; ++q) o[q] = (i >= j0 + q) ? v[q] * __expf(gi - gcs[j0 + q]) : 0.f;
            u32x2 w; w.x = pk2(o[0], o[1]); w.y = pk2(o[2], o[3]); *(u32x2*)(ATT + i * 64 + j0) = w; });
    }
    if (tid == 0) ((float*)(ws + WS_EA + 768 * 1024))[gu] = __expf(gcs[63]);
    __syncthreads();
    if (tid < 128) {
        float x[64];
#pragma unroll
        for (int bi = 0; bi < 4; ++bi) {
            float a[16];
#pragma unroll
            for (int r = 0; r < 16; ++r) a[r] = RHS[(16 * bi + r) * 132 + tid];
#pragma unroll
            for (int j4 = 0; j4 < 4 * bi; ++j4) {
                f32x4 t[16];
#pragma unroll
                for (int r = 0; r < 16; ++r) t[r] = *(const LAS f32x4*)(Tm + (16 * bi + r) * 68 + 4 * j4);
#pragma unroll
                for (int r = 0; r < 16; ++r)
#pragma unroll
                    for (int q = 0; q < 4; ++q) a[r] -= t[r][q] * x[4 * j4 + q];
            }
            f32x4 cur[4], nxt[4];
#pragma unroll
            for (int q4 = 0; q4 < 4; ++q4) { cur[q4] = (f32x4){0.f, 0.f, 0.f, 0.f}; nxt[q4] = (f32x4){0.f, 0.f, 0.f, 0.f}; }
#pragma unroll
            for (int r = 0; r < 16; ++r) {
                if (r + 1 < 16) {
#pragma unroll
                    for (int q4 = 0; q4 < (r + 1 + 3) / 4; ++q4) nxt[q4] = *(const LAS f32x4*)(Tm + (16 * bi + r + 1) * 68 + 16 * bi + 4 * q4);
                }
                __builtin_amdgcn_sched_barrier(0);
                float acc = a[r];
#pragma unroll
                for (int j = 0; j < r; ++j) acc -= cur[j >> 2][j & 3] * x[16 * bi + j];
                x[16 * bi + r] = acc;
#pragma unroll
                for (int q4 = 0; q4 < 4; ++q4) cur[q4] = nxt[q4];
            }
        }
        if (tid < 64) { float* U = (float*)(ws + WS_GU) + (size_t)gu * 4096 + tid;
#pragma unroll
            for (int i = 0; i < 64; ++i) U[i * 64] = x[i];
        } else { bf16_t* W = (bf16_t*)(gob + GO_W) + (size_t)gu * 4096 + (tid - 64);
#pragma unroll
            for (int i = 0; i < 64; ++i) W[i * 64] = (bf16_t)f2bf(x[i]); }
    }
    __syncthreads();
}

__device__ __forceinline__ void gdn_chain_unit(const Params& p, int cu, LAS unsigned char* lds, int tid, int lane, int wid) {
    asm volatile("" : "+v"(lds));
    unsigned char* ws = wsp(p); const int b = cu >> 2, h = cu & 3;
    unsigned char* gob = (unsigned char*)outp(p);
    const int fr = lane & 15, fq = lane >> 4;
    constexpr int BUF = 54272;
    LAS bf16_t* St0 = (LAS bf16_t*)(lds + 2 * BUF); LAS bf16_t* VnT = (LAS bf16_t*)(lds + 2 * BUF + 18432);
    const bf16_t* gW = (const bf16_t*)(gob + GO_W) + (size_t)cu * 64 * 4096; const bf16_t* gQG = (const bf16_t*)(gob + GO_QG) + (size_t)cu * 64 * 4096;
    const bf16_t* gAT = (const bf16_t*)(gob + GO_ATT) + (size_t)cu * 64 * 4096; const bf16_t* gKT = (const bf16_t*)(gob + GO_KGT) + (size_t)cu * 64 * 4096;
    const float* gU = (const float*)(ws + WS_GU) + (size_t)cu * 64 * 4096; const float* GL = (const float*)(ws + WS_EA + 768 * 1024) + cu * 64;
    float* OG = (float*)(ws + WS_OG);
    f32x4 sreg[2] = {(f32x4){0.f, 0.f, 0.f, 0.f}, (f32x4){0.f, 0.f, 0.f, 0.f}};
    for (int i = tid; i < 64 * 72 / 2; i += 512) ((LAS unsigned*)St0)[i] = 0u;
    const int lrow = tid >> 3, lc8 = (tid & 7) * 8;
    u32x4 rw, rq, ra, rk; f32x4 ru[2];
    auto gload = [&](int c) { const size_t o = (size_t)c * 4096 + lrow * 64 + lc8; rw = *(const u32x4*)(gW + o); rq = *(const u32x4*)(gQG + o); ra = *(const u32x4*)(gAT + o); rk = *(const u32x4*)(gKT + o);
#pragma unroll
        for (int i = 0; i < 2; ++i) ru[i] = *(const f32x4*)(gU + (size_t)c * 4096 + (tid + 512 * i) * 4); };
    auto lstore = [&](int buf) { LAS unsigned char* B = lds + buf * BUF; const int o = (lrow * 72 + lc8) * 2;
        *(LAS u32x4*)(B + o) = rw; *(LAS u32x4*)(B + 9216 + o) = rq; *(LAS u32x4*)(B + 18432 + o) = ra; *(LAS u32x4*)(B + 27648 + o) = rk;
#pragma unroll
        for (int i = 0; i < 2; ++i) { const int idx = tid + 512 * i; *(LAS f32x4*)(B + 36864 + ((idx >> 4) * 68 + (idx & 15) * 4) * 4) = ru[i]; } };
    gload(0); lstore(0);
    __syncthreads();
    for (int c = 0; c < 64; ++c) {
        LAS unsigned char* B = lds + (c & 1) * BUF;
        const LAS bf16_t* Wt = (const LAS bf16_t*)B; const LAS bf16_t* QGt = (const LAS bf16_t*)(B + 9216); const LAS bf16_t* ATt = (const LAS bf16_t*)(B + 18432); const LAS bf16_t* KTt = (const LAS bf16_t*)(B + 27648);
        const LAS float* Ut = (const LAS float*)(B + 36864);
        LAS bf16_t* St = St0 + (c & 1) * 4608; LAS bf16_t* Stn = St0 + ((c + 1) & 1) * 4608;
        if (c + 1 < 64) gload(c + 1);
        mm16<64, 64, 64>(Wt, 72, St, 72, wid, lane, [&](int t, int dv, float v) { VnT[dv * 72 + t] = (bf16_t)f2bf(Ut[t * 68 + dv] - v); });
        __syncthreads();
        const float gl = GL[c];
        const int tokc = b * SEQ + c * 64;
#pragma unroll
        for (int bi = 0; bi < 2; ++bi) {
            const int blk = wid + 8 * bi, mb = blk >> 2, nb = blk & 3;
            f32x4 acc = {0.f, 0.f, 0.f, 0.f}, acs = {0.f, 0.f, 0.f, 0.f};
            const LAS bf16_t* sp = St + (nb * 16 + fr) * 72 + fq * 8; const LAS bf16_t* vp = VnT + (nb * 16 + fr) * 72 + fq * 8;
            const int ao = (mb * 16 + fr) * 72 + fq * 8;
#pragma unroll
            for (int k0 = 0; k0 < 64; k0 += 32) {
                acc = __builtin_amdgcn_mfma_f32_16x16x32_bf16(*(const LAS bf16x8*)(QGt + ao + k0), *(const LAS bf16x8*)(sp + k0), acc, 0, 0, 0);
                acc = __builtin_amdgcn_mfma_f32_16x16x32_bf16(*(const LAS bf16x8*)(ATt + ao + k0), *(const LAS bf16x8*)(vp + k0), acc, 0, 0, 0);
                acs = __builtin_amdgcn_mfma_f32_16x16x32_bf16(*(const LAS bf16x8*)(KTt + ao + k0), *(const LAS bf16x8*)(vp + k0), acs, 0, 0, 0);
            }
#pragma unroll
            for (int i = 0; i < 4; ++i) OG[(size_t)(tokc + mb * 16 + fq * 4 + i) * 256 + h * 64 + nb * 16 + fr] = acc[i];
            sreg[bi] = sreg[bi] * gl + acs;
        }
#pragma unroll
        for (int bi = 0; bi < 2; ++bi) { const int blk = wid + 8 * bi, mb = blk >> 2, nb = blk & 3;
            u32x2 w; w.x = pk2(sreg[bi][0], sreg[bi][1]); w.y = pk2(sreg[bi][2], sreg[bi][3]);
            *(LAS u32x2*)(Stn + (nb * 16 + fr) * 72 + mb * 16 + fq * 4) = w; }
        if (c + 1 < 64) lstore((c + 1) & 1);
        __syncthreads();
    }
}

__device__ __forceinline__ void phase_e_unit(const Params& p, int l, int tile, LAS unsigned char* lds, int tid, int lane, int wid) {
    asm volatile("" : "+v"(lds));
    unsigned char* ws = wsp(p);
    const int tok0 = tile * 64, b = tile >> 6, c = (tile & 63) >> 1;
    const bf16_t* PROJ = (const bf16_t*)(ws + WS_PROJ); bf16_t* CAT = (bf16_t*)(ws + WS_CAT);
    const float lambda_init = 0.8f - 0.6f * __expf(-0.3f * (float)l);
    float lam;
    { const float d1 = wave_sum(pin(p, I_LQ1)[l * 64 + lane] * pin(p, I_LK1)[l * 64 + lane], lane), d2 = wave_sum(pin(p, I_LQ2)[l * 64 + lane] * pin(p, I_LK2)[l * 64 + lane], lane); lam = __expf(d1) - __expf(d2) + lambda_init; }
    {
        const bf16_t* AO = (const bf16_t*)(ws + WS_AO); const float* sg = pin(p, I_SUBG) + l * 128;
        const int hh = lane >> 4, cmap = (lane >> 3) & 1, eh = (lane >> 2) & 1, dp = lane & 3;
        float gsub[16];
#pragma unroll
        for (int j = 0; j < 16; ++j) gsub[j] = sg[eh * 64 + dp * 16 + j];
        const float post = 1.f - lambda_init;
#pragma unroll 2
        for (int i = 0; i < 8; ++i) { const size_t tok = tok0 + wid + 8 * i;
            const u32x4 r0 = *(const u32x4*)(AO + tok * 1024 + lane * 16), r1 = *(const u32x4*)(AO + tok * 1024 + lane * 16 + 8);
            float mine[16], oth[16]; unpack8(r0, *(float(*)[8])&mine[0]); unpack8(r1, *(float(*)[8])&mine[8]);
#pragma unroll
            for (int j = 0; j < 16; ++j) oth[j] = dpp_f<0x128>(mine[j]);
            float v[16]; float sq = 0.f;
#pragma unroll
            for (int j = 0; j < 16; ++j) { v[j] = mine[j] - lam * oth[j]; sq += v[j] * v[j]; }
            if (cmap) sq = 0.f;
            sq += dpp_f<0xB1>(sq); sq += dpp_f<0x4E>(sq); sq += dpp_f<0x141>(sq); sq += dpp_f<0x140>(sq);
            const float rr = rsqrtf(sq * (1.f / 128.f) + NORM_EPS) * post;
            if (!cmap) { bf16_t* o = CAT + tok * 1024 + hh * 128 + eh * 64 + dp * 16;
                u32x4 w0, w1;
#pragma unroll
                for (int j = 0; j < 4; ++j) { w0[j] = pk2(v[2 * j] * rr * gsub[2 * j], v[2 * j + 1] * rr * gsub[2 * j + 1]); w1[j] = pk2(v[8 + 2 * j] * rr * gsub[8 + 2 * j], v[9 + 2 * j] * rr * gsub[9 + 2 * j]); }
                *(u32x4*)o = w0; *(u32x4*)(o + 8) = w1; }
        }
    }
    {
        const float* OG = (const float*)(ws + WS_OG); const f32x4 gn = *(const f32x4*)(pin(p, I_GNG) + l * 64 + (lane & 15) * 4);
#pragma unroll 4
        for (int i = 0; i < 8; ++i) { const size_t tok = tok0 + wid + 8 * i;
            const f32x4 v = *(const f32x4*)(OG + tok * 256 + lane * 4); const u32x2 zz = *(const u32x2*)(PROJ + tok * PN + 3328 + lane * 4);
            float sq = dot4v(v);
            sq += dpp_f<0xB1>(sq); sq += dpp_f<0x4E>(sq); sq += dpp_f<0x141>(sq); sq += dpp_f<0x140>(sq);
            const float rr = rsqrtf(sq * (1.f / 64.f) + NORM_EPS);
            const float z0 = __builtin_bit_cast(float, zz.x << 16), z1 = __builtin_bit_cast(float, zz.x & 0xffff0000u), z2 = __builtin_bit_cast(float, zz.y << 16), z3 = __builtin_bit_cast(float, zz.y & 0xffff0000u);
            u32x2 w; w.x = pk2(v[0] * rr * gn[0] * silu_f(z0), v[1] * rr * gn[1] * silu_f(z1)); w.y = pk2(v[2] * rr * gn[2] * silu_f(z2), v[3] * rr * gn[3] * silu_f(z3));
            *(u32x2*)(CAT + tok * 1024 + 768 + lane * 4) = w; }
    }
    LAS bf16_t* CMg = (LAS bf16_t*)lds; LAS bf16_t* HPs = (LAS bf16_t*)(lds + 17408); LAS float* Yb = (LAS float*)(lds + 17408 + 34816);
    const float* Y = (const float*)(ws + WS_YS); const float* EA = (const float*)(ws + WS_EA);
    for (int g = 0; g < 2; ++g) {
        {
            u32x4 r0[2], r1[4];
#pragma unroll
            for (int i = 0; i < 2; ++i) { const int idx = tid + 512 * i; r0[i] = *(const u32x4*)((const bf16_t*)(ws + WS_CM) + (size_t)(tok0 + (idx >> 4)) * 256 + g * 128 + (idx & 15) * 8); }
#pragma unroll
            for (int i = 0; i < 4; ++i) { const int idx = tid + 512 * i; const int hh = idx >> 10, r = (idx >> 4) & 63;
                r1[i] = *(const u32x4*)((const bf16_t*)(ws + WS_HP) + (size_t)((b * 32 + c) * 4 + 2 * g + hh) * 8192 + r * 128 + (idx & 15) * 8); }
#pragma unroll
            for (int i = 0; i < 2; ++i) { const int idx = tid + 512 * i; *(LAS u32x4*)(CMg + (idx >> 4) * 136 + (idx & 15) * 8) = r0[i]; }
#pragma unroll
            for (int i = 0; i < 4; ++i) { const int idx = tid + 512 * i; const int hh = idx >> 10, r = (idx >> 4) & 63; *(LAS u32x4*)(HPs + (hh * 64 + r) * 136 + (idx & 15) * 8) = r1[i]; }
        }
        __syncthreads();
        for (int hh = 0; hh < 2; ++hh)
            mm16<64, 64, 128>(CMg, 136, HPs + hh * 64 * 136, 136, wid, lane, [&](int r, int pp, float v) { Yb[r * 132 + hh * 64 + pp] = v; });
        __syncthreads();
        {
            f32x4 yv[4]; u32x2 zv[4]; float ea[4];
#pragma unroll
            for (int i = 0; i < 4; ++i) { const int idx = tid + 512 * i; const int r = idx >> 5, c4 = (idx & 31) * 4; const size_t tok = tok0 + r;
                yv[i] = *(const f32x4*)(Y + tok * 256 + g * 128 + c4); zv[i] = *(const u32x2*)(PROJ + tok * PN + 1536 + g * 128 + c4); ea[i] = EA[tok * 4 + 2 * g + (c4 >> 6)]; }
#pragma unroll
            for (int i = 0; i < 4; ++i) { const int idx = tid + 512 * i; const int r = idx >> 5, c4 = (idx & 31) * 4;
                const f32x4 yo = *(const LAS f32x4*)(Yb + r * 132 + c4); f32x4 o;
                const float z0 = __builtin_bit_cast(float, zv[i].x << 16), z1 = __builtin_bit_cast(float, zv[i].x & 0xffff0000u), z2 = __builtin_bit_cast(float, zv[i].y << 16), z3 = __builtin_bit_cast(float, zv[i].y & 0xffff0000u);
                o[0] = (yv[i][0] + yo[0] * ea[i]) * silu_f(z0); o[1] = (yv[i][1] + yo[1] * ea[i]) * silu_f(z1); o[2] = (yv[i][2] + yo[2] * ea[i]) * silu_f(z2); o[3] = (yv[i][3] + yo[3] * ea[i]) * silu_f(z3);
                *(LAS f32x4*)(Yb + r * 132 + c4) = o; }
        }
        __syncthreads();
        { const float* gn = pin(p, I_SNG) + l * 256 + g * 128; const float g0 = gn[lane], g1 = gn[64 + lane];
#pragma unroll
            for (int i = 0; i < 8; ++i) { const int r = wid + 8 * i; const float v0 = Yb[r * 132 + lane], v1 = Yb[r * 132 + 64 + lane];
                const float rr = rsqrtf(wave_sum(v0 * v0 + v1 * v1, lane) * (1.f / 128.f) + NORM_EPS);
                bf16_t* o = CAT + (size_t)(tok0 + r) * 1024 + 512 + g * 128 + lane; o[0] = (bf16_t)f2bf(v0 * rr * g0); o[64] = (bf16_t)f2bf(v1 * rr * g1); } }
        __syncthreads();
    }
}
}

namespace mk {
__device__ __forceinline__ int q_next(unsigned* ctr, LAS unsigned char* lds, int tid) {
    LAS int* slot = (LAS int*)(lds + LDS_SLOT);
    __syncthreads();
    if (tid == 0) *slot = (int)atomicAdd(ctr, 1u);
    __syncthreads();
    return __builtin_amdgcn_readfirstlane(*slot);
}
}

#ifndef PROBE_REP_D1
#define PROBE_REP_D1 1
#endif
#ifndef PROBE_REP_D2
#define PROBE_REP_D2 1
#endif
#ifndef PROBE_XSYNC
#define PROBE_XSYNC 0
#endif
#ifndef PROBE_REP_A
#define PROBE_REP_A 1
#endif
#ifndef PROBE_REP_EPIINPROJ
#define PROBE_REP_EPIINPROJ 1
#endif
#ifndef PROBE_REP_EPIQPROJ
#define PROBE_REP_EPIQPROJ 1
#endif
#ifndef PROBE_REP_EPISOFTMAX
#define PROBE_REP_EPISOFTMAX 1
#endif
#ifndef PROBE_REP_EPIBF16
#define PROBE_REP_EPIBF16 1
#endif
#ifndef PROBE_REP_EPISWIGLU
#define PROBE_REP_EPISWIGLU 1
#endif
#ifndef PROBE_REP_GP
#define PROBE_REP_GP 1
#endif
#ifndef PROBE_REP_ATT
#define PROBE_REP_ATT 1
#endif
#ifndef PROBE_REP_SP
#define PROBE_REP_SP 1
#endif
#ifndef PROBE_REP_CH
#define PROBE_REP_CH 1
#endif
#ifndef PROBE_REP_E
#define PROBE_REP_E 1
#endif
#ifndef MK_LAYERS
#define MK_LAYERS DEPTH
#endif

#define IDS int tid; asm volatile("v_mbcnt_lo_u32_b32 %0, -1, 0\n\tv_mbcnt_hi_u32_b32 %0, -1, %0" : "=v"(tid)); tid += wid0 * 64; asm volatile("" : "+v"(tid)); const int lane = tid & 63, wid = __builtin_amdgcn_readfirstlane(tid >> 6); (void)lane; (void)wid
#define WSV unsigned char* ws = wsp(p); unsigned* ctl = (unsigned*)(ws + WS_CTL); bf16_t* H = (bf16_t*)(ws + WS_H); bf16_t* PROJ = (bf16_t*)(ws + WS_PROJ); bf16_t* AO = (bf16_t*)(ws + WS_AO); bf16_t* CAT = (bf16_t*)(ws + WS_CAT); \
    bf16_t* QX = AO; bf16_t* PB = PROJ; bf16_t* OX = CAT; bf16_t* HID = PROJ; (void)ctl; (void)H; (void)PROJ; (void)AO; (void)CAT; (void)QX; (void)PB; (void)OX; (void)HID
__global__ void __launch_bounds__(512, 2) mega_fwd(mk::Params p) {
    using namespace mk;
    extern __shared__ __attribute__((aligned(16))) unsigned char lds_raw[];
    cg::grid_group grid = cg::this_grid();
    LAS unsigned char* lds = (LAS unsigned char*)lds_raw;
    const int bid = blockIdx.x;
    const int wid0 = __builtin_amdgcn_readfirstlane((int)threadIdx.x >> 6);
    {
        IDS; volatile LAS unsigned* st = (volatile LAS unsigned*)(lds + LDS_SLOT + 16);
        if (tid < 2) st[tid] = 0u;
        __syncthreads();
        { unsigned char* wv = p.ws; asm volatile("" : "+v"(wv));
          (void)xcd_barrier_post((unsigned*)(wv + WS_CTL) + 4096, st, tid); }
    }
#define GSYNC() do { IDS; XcdBarrier b_; b_.bar = (unsigned*)(wsp(p) + WS_CTL) + 4096; b_.x = xb_xcc_id(); b_.st = (volatile LAS unsigned*)(lds + LDS_SLOT + 16); xcd_barrier(b_, tid); } while (0)
    { IDS; phase_a(p, 0, lds, tid, lane, wid); }
    if (gridDim.x == 0x7fffffffu) grid.sync();
    GSYNC();
    {
        WSV; pg8::SchedOne S; S.have = bid < 128; const int ll = bid >> 5, r = bid & 31;
        S.u0.pm = r >> 3; S.u0.pn = r & 7; S.u0.kind = 0; S.u0.aux = ll;
        S.u0.a = (const char*)(ws + WS_MEMN) + ((size_t)ll * NMEM + S.u0.pm * 256) * DM * 2;
        S.u0.b = (const char*)(ws + WS_WCKV) + ((size_t)ll * 2048 + S.u0.pn * 256) * DM * 2;
        pg8::EpiKV E{(bf16_t*)(ws + WS_KN), (bf16_t*)(ws + WS_VT), pin(p, I_XKG)};
        { IDS; pg8::gemm_phase<pg8::EpiKV, pg8::SchedOne, false, true>(lds, pg8::Gemm{DM, DM, DM}, S, E, tid); }
        __syncthreads();
    }
#pragma unroll 1
    for (int l = 0; l < MK_LAYERS; ++l) {
        {
            WSV; pg8::SchedDense S; S.init(H, ws + woff(0, l & 1), DM, DM, MTOK / 256, PN / 256 + 1);
            pg8::EpiInProj E{PROJ, pin(p, I_QG) + l * 64, pin(p, I_KG) + l * 64, (const float*)(ws + WS_SSP), (float*)(ws + WS_SM)};
            for (int rep = 0; rep < PROBE_REP_EPIINPROJ; ++rep) { IDS; pg8::gemm_phase<pg8::EpiInProj, pg8::SchedDense, true, true>(lds, pg8::Gemm{DM, DM, DM}, S, E, tid); }
        }
        GSYNC();
        {
            IDS;
#pragma unroll 1
            for (int u = bid; u < 1024; u += gridDim.x) gdn_prep_unit(p, l, u, lds, tid, lane, wid);
#pragma unroll 1
            for (int u = bid; u < 512; u += gridDim.x) ssd_prep_unit(p, l, u, lds, tid, lane, wid);
            if (l > 0) for (int u = bid; u < (CI_DN + 7) / 8; u += gridDim.x) conv_unit(p, l, u, true, lds, lane, wid);
        }
        GSYNC();
        for (int rep = 0; rep < PROBE_REP_D2; ++rep) {
            IDS; WSV; unsigned* ctr = ctl + ((l * 2 + 1) * 4 + rep) * 64;
            const int nq2 = 32 + 1024 + (l + 1 < MK_LAYERS ? (CI_MAIN + 7) / 8 : 0);
            for (;;) { const int idx = q_next(ctr, lds, tid); if (idx >= nq2) break;
                if (idx >= 32 + 1024) { conv_unit(p, l + 1, idx - (32 + 1024), false, lds, lane, wid); continue; }
#ifndef SKIP_GCHAIN
                if (idx < 16) { for (int r2 = 0; r2 < PROBE_REP_CH; ++r2) gdn_chain_unit(p, idx, lds, tid, lane, wid); }
#endif
                if (idx >= 16 && idx < 32) ssd_scan_unit(p, idx - 16, tid);
#ifndef SKIP_ATTN
                if (idx >= 32) { const int a = idx - 32, qb = 15 - (a >> 6), bh = a & 63;
                    for (int r2 = 0; r2 < PROBE_REP_ATT; ++r2) attn_body::attn_unit<8>(bh >> 4, bh & 15, qb, (const attn_body::bf16*)PROJ, (const attn_body::bf16*)PROJ, (const attn_body::bf16*)PROJ, (attn_body::bf16*)AO, (char*)lds_raw, tid); }
#endif
            }
        }
        GSYNC();
#ifndef SKIP_E
        { IDS; for (int tile = bid; tile < MTOK / 64; tile += gridDim.x) for (int r2 = 0; r2 < PROBE_REP_E; ++r2) phase_e_unit(p, l, tile, lds, tid, lane, wid); }
#endif
        GSYNC();
        {
            WSV; pg8::SchedDense S; S.init(CAT, ws + woff(1, l & 1), DM, DM, MTOK / 256, 4);
            pg8::EpiResid E{H, (float*)(ws + WS_SSP + 1 * MiB), nullptr};
#ifdef PROBE_NULL_RESID
            { pg8::EpiNull EN{(float*)(ws + WS_SM)}; IDS; pg8::gemm_phase<pg8::EpiNull, pg8::SchedDense, true, true>(lds, pg8::Gemm{DM, DM, DM}, S, EN, tid); }
#endif
            { IDS; pg8::gemm_phase<pg8::EpiResid, pg8::SchedDense, true, true>(lds, pg8::Gemm{DM, DM, DM}, S, E, tid); }
        }
        GSYNC();
        {
            WSV; pg8::SchedDense S; S.init(H, ws + woff(2, l & 1), DM, DM, MTOK / 256, 4);
            pg8::EpiQProj E{QX, pin(p, I_XQG) + l * 256, (const float*)(ws + WS_SSP + 1 * MiB)};
            for (int rep = 0; rep < PROBE_REP_EPIQPROJ; ++rep) { IDS; pg8::gemm_phase<pg8::EpiQProj, pg8::SchedDense, false, true>(lds, pg8::Gemm{DM, DM, DM}, S, E, tid); }
        }
        asm volatile("s_waitcnt vmcnt(0)" ::: "memory"); __syncthreads();
        {
            WSV; pg8::SchedX<0> S; S.init(QX, ws + WS_KN + (size_t)l * NMEM * DM * 2);
            pg8::EpiSoftmax E{PB};
            for (int rep = 0; rep < PROBE_REP_EPISOFTMAX; ++rep) { IDS; pg8::gemm_phase<pg8::EpiSoftmax, pg8::SchedX<0>, false, true>(lds, pg8::Gemm{DM, DM, 256}, S, E, tid); }
        }
        asm volatile("s_waitcnt vmcnt(0)" ::: "memory"); __syncthreads();
        {
            WSV; pg8::SchedX<1> S; S.init(PB, ws + WS_VT + (size_t)l * 16 * 65536 * 2);
            pg8::EpiBf16 E{OX};
            for (int rep = 0; rep < PROBE_REP_EPIBF16; ++rep) { IDS; pg8::gemm_phase<pg8::EpiBf16, pg8::SchedX<1>, false, true>(lds, pg8::Gemm{DM, 256, 256}, S, E, tid); }
        }
        GSYNC();
        {
            WSV; pg8::SchedDense S; S.init(OX, ws + woff(3, l & 1), DM, DM, MTOK / 256, 4);
            pg8::EpiResid E{H, (float*)(ws + WS_SSP + 2 * MiB), nullptr};
#ifdef PROBE_NULL_RESID
            { pg8::EpiNull EN{(float*)(ws + WS_SM)}; IDS; pg8::gemm_phase<pg8::EpiNull, pg8::SchedDense, true, true>(lds, pg8::Gemm{DM, DM, DM}, S, EN, tid); }
#endif
            { IDS; pg8::gemm_phase<pg8::EpiResid, pg8::SchedDense, true, true>(lds, pg8::Gemm{DM, DM, DM}, S, E, tid); }
        }
        GSYNC();
        {
            WSV; pg8::SchedDense S; S.init(H, ws + woff(4, l & 1), DM, DM, MTOK / 256, 2 * D_FF / 256);
            pg8::EpiSwiGLU E{HID, (const float*)(ws + WS_SSP + 2 * MiB)};
            for (int rep = 0; rep < PROBE_REP_EPISWIGLU; ++rep) { IDS; pg8::gemm_phase<pg8::EpiSwiGLU, pg8::SchedDense, true, true>(lds, pg8::Gemm{DM, DM, DM}, S, E, tid); }
        }
        GSYNC();
        {
            WSV; pg8::SchedDense S; S.init(HID, ws + WS_WDN, D_FF, D_FF, MTOK / 256, 4);
            pg8::EpiResid E{H, (float*)(ws + WS_SSP), l + 1 < MK_LAYERS ? nullptr : outp(p)};
#ifdef PROBE_NULL_RESID
            { pg8::EpiNull EN{(float*)(ws + WS_SM)}; IDS; pg8::gemm_phase<pg8::EpiNull, pg8::SchedDense, true, true>(lds, pg8::Gemm{D_FF, D_FF, D_FF}, S, EN, tid); }
#endif
            { IDS; pg8::gemm_phase<pg8::EpiResid, pg8::SchedDense, true, true>(lds, pg8::Gemm{D_FF, D_FF, D_FF}, S, E, tid); }
        }
        GSYNC();
        for (int xs = 0; xs < PROBE_XSYNC; ++xs) GSYNC();

    }
}

extern "C" void kernel_launch(void* const* d_in, const int* in_sizes, int n_in, void* d_out, int out_size, void* d_ws, size_t ws_size, hipStream_t stream) {
    static int grid = 0;
    if (grid == 0) {
        if (n_in != 32 || out_size != MTOK * DM || ws_size < mk::WS_END) { fprintf(stderr, "kernel_launch: unexpected shapes: n_in %d out %d ws %zu (need %zu)\n", n_in, out_size, ws_size, (size_t)mk::WS_END); grid = -1; return; }
        int dev = 0, cus = 0, per_cu = 0;
        hipGetDevice(&dev); hipDeviceGetAttribute(&cus, hipDeviceAttributeMultiprocessorCount, dev);
        if (hipFuncSetAttribute((const void*)mega_fwd, hipFuncAttributeMaxDynamicSharedMemorySize, mk::LDS_BYTES) != hipSuccess) { fprintf(stderr, "kernel_launch: hipFuncSetAttribute failed\n"); grid = -1; return; }
        hipOccupancyMaxActiveBlocksPerMultiprocessor(&per_cu, (const void*)mega_fwd, 512, mk::LDS_BYTES);
        (void)hipGetLastError();
        if (per_cu < 1) fprintf(stderr, "kernel_launch: occupancy query says %d blocks/CU\n", per_cu);
        grid = cus;
        if (grid != 256) fprintf(stderr, "kernel_launch: %d CUs; this kernel is built for 256\n", grid);
    }
    if (grid < 0) return;
    (void)hipMemsetAsync((char*)d_ws + mk::WS_CTL, 0, mk::CTL_BYTES, stream);
    mk::Params p{};
    for (int i = 0; i < 32; ++i) p.in[i] = (const float*)d_in[i];
    p.out = (float*)d_out; p.ws = (unsigned char*)d_ws;
    void* args[] = {&p};
    hipError_t e = hipLaunchCooperativeKernel((const void*)mega_fwd, dim3(grid), dim3(512), args, mk::LDS_BYTES, stream);
    if (e != hipSuccess) fprintf(stderr, "cooperative launch failed: %s (grid %d)\n", hipGetErrorString(e), grid);
}
```

```cpp
#include <hip/hip_runtime.h>
#include <hip/hip_cooperative_groups.h>
#include <hip/hip_bf16.h>
#include <cstdio>
#include <cstdint>
#include <cmath>
namespace cg = cooperative_groups;

#define LAS __attribute__((address_space(3)))
typedef unsigned short bf16_t;
typedef short bf16x8 __attribute__((ext_vector_type(8)));
typedef float f32x4 __attribute__((ext_vector_type(4)));
typedef float f32x2 __attribute__((ext_vector_type(2)));
typedef unsigned u32x4 __attribute__((ext_vector_type(4)));
typedef unsigned u32x2 __attribute__((ext_vector_type(2)));

constexpr int BATCH = 4, SEQ = 4096, DM = 1024, DEPTH = 4, MTOK = BATCH * SEQ;
constexpr int MEM_LEN = 256, NMEM = BATCH * MEM_LEN;
constexpr int P_IN = 3596, PN = 3584;
constexpr int D_FF = 2816;
constexpr float NORM_EPS = 1e-6f;
constexpr float LOG2E = 1.4426950408889634f;

typedef __bf16 hw_bf16x2 __attribute__((ext_vector_type(2)));
__device__ __forceinline__ unsigned pk2(float lo, float hi) { const f32x2 v = {lo, hi}; return __builtin_bit_cast(unsigned, __builtin_convertvector(v, hw_bf16x2)); }
__device__ __forceinline__ unsigned f2bf(float f) { return pk2(f, 0.f) & 0xffffu; }
__device__ __forceinline__ float bf2f(bf16_t b) { return __builtin_bit_cast(float, (unsigned)b << 16); }
__device__ __forceinline__ float lane_xor(float v, int o, int lane) { return __builtin_bit_cast(float, __builtin_amdgcn_ds_bpermute((lane ^ o) << 2, __builtin_bit_cast(int, v))); }
template <int CTRL> __device__ __forceinline__ float dpp_f(float v) { return __builtin_bit_cast(float, __builtin_amdgcn_update_dpp(0, __builtin_bit_cast(int, v), CTRL, 0xF, 0xF, true)); }
__device__ __forceinline__ float wave_sum(float v, int lane) {
    v += dpp_f<0xB1>(v);
    v += dpp_f<0x4E>(v);
    v += dpp_f<0x141>(v);
    v += dpp_f<0x140>(v);
    v += lane_xor(v, 16, lane);
    v += lane_xor(v, 32, lane);
    return v;
}
__device__ __forceinline__ float wave_incl_scan(float v, int lane) {
#pragma unroll
    for (int o = 1; o < 64; o <<= 1) { const float n = __builtin_bit_cast(float, __builtin_amdgcn_ds_bpermute((lane - o) << 2, __builtin_bit_cast(int, v))); if (lane >= o) v += n; }
    return v;
}
__device__ __forceinline__ float dot4v(f32x4 a) { return (a[0] * a[0] + a[1] * a[1]) + (a[2] * a[2] + a[3] * a[3]); }
__device__ __forceinline__ float silu_f(float x) { return x * __builtin_amdgcn_rcpf(1.f + __expf(-x)); }
__device__ __forceinline__ float sigmoid_f(float x) { return __builtin_amdgcn_rcpf(1.f + __expf(-x)); }
__device__ __forceinline__ float softplus_f(float x) { return fmaxf(x, 0.f) + __logf(1.f + __expf(-fabsf(x))); }

namespace pg8 {
#define PG8_LAS __attribute__((address_space(3)))
constexpr int BM = 256, BK = 64, HALF = 128, HTB = HALF * BK * 2  , STAGE_BYTES = 8 * HTB, NXCD = 8, WGM = 8;

__host__ __device__ __forceinline__ int lds_byte(int r, int c) { const int st = (r >> 4) * 2 + (c >> 5), rr = r & 15, cc = c & 31, ob = rr * 64 + cc * 2; return st * 1024 + (ob ^ (((ob >> 9) & 1) << 5)); }
__host__ __device__ __forceinline__ void stage_rc(int b, int& R, int& C) { const int st = b / 1024, sb = b % 1024, swz = sb ^ (((sb >> 9) & 1) << 5); R = (st >> 1) * 16 + swz / 64; C = (st & 1) * 32 + (swz % 64) / 2; }
__host__ __device__ __forceinline__ int perm32(int rho) { const int n = rho >> 4, i = rho & 15; return 8 * (i >> 2) + 4 * n + (i & 3); }

struct Unit { int pm, pn, kind, aux; const char* a; const char* b; };
struct Gemm { int lda, ldb, K; };

struct GridOrder {
    int nM, nN, nwg, G, c;
    __device__ void init(int nM_, int nN_, int G_, int c_) { nM = nM_; nN = nN_; nwg = nM * nN; G = G_; c = c_; }
    __device__ bool tile(int i, int& pm, int& pn) const {
        const long L = (long)i * G + c; if (L >= nwg) return false;
        int wgid = (int)L; { const int q = nwg / NXCD, r = nwg % NXCD, xcd = wgid % NXCD, off = wgid / NXCD; wgid = (xcd < r ? xcd * (q + 1) : r * (q + 1) + (xcd - r) * q) + off; }
        const int nig = WGM * nN, gid = wgid / nig, fm = gid * WGM, gsz = (nM - fm) < WGM ? (nM - fm) : WGM;
        pm = fm + ((wgid % nig) % gsz); pn = (wgid % nig) / gsz; return true;
    }
};
__device__ __forceinline__ unsigned cvt_pk_bf16(float lo, float hi) { unsigned r; asm volatile("v_cvt_pk_bf16_f32 %0, %1, %2" : "=v"(r) : "v"(lo), "v"(hi)); return r; }
template <class Epi, class Sched, bool ALIGN_EPI = false, bool SP2 = false>
__device__ __forceinline__ void gemm_phase(PG8_LAS unsigned char* lds, const Gemm g, const Sched& S, const Epi& E, int tid_in) {
    int tid_l = tid_in; asm volatile("" : "+v"(tid_l));
    const int tid = tid_l, wid = __builtin_amdgcn_readfirstlane(tid >> 6), lane = tid & 63, wr = wid >> 2, wc = wid & 3, fr = lane & 15, fq = lane >> 4;
    const int K = g.K, nt = K / BK;
    unsigned voffA[2], voffB[2];
#pragma unroll
    for (int i = 0; i < 2; ++i) { int R, C; stage_rc(tid * 16 + i * 8192, R, C); const int Rb = Epi::PERM ? ((R & ~31) + perm32(R & 31)) : R;
        voffA[i] = (unsigned)(R * g.lda + C) * 2u; voffB[i] = (unsigned)(Rb * g.ldb + C) * 2u; }
    const size_t kstep = (size_t)(BK * 2);
    const size_t hstepA = (size_t)HALF * g.lda * 2, hstepB = (size_t)HALF * g.ldb * 2;
    const unsigned ldsw = (unsigned)wid * 1024u;
    const int aoff = lds_byte(wr * 64 + fr, fq * 8), boff = lds_byte(wc * 32 + fr, fq * 8);
#define PG8_SA(b, h) (((b) * 2 + (h)) * HTB)
#define PG8_SB(b, h) ((4 + (b) * 2 + (h)) * HTB)
#define PG8_STAGE(bufoff, gbase, voff) do { _Pragma("unroll") for (int _i = 0; _i < 2; ++_i) \
        __builtin_amdgcn_global_load_lds((const unsigned*)((const char*)(gbase) + (voff)[_i]), (PG8_LAS unsigned*)(lds + (bufoff) + ldsw + _i * 8192), 16, 0, 0); } while (0)
#define PG8_LDA(dst, b, h) do { _Pragma("unroll") for (int m = 0; m < 4; ++m) _Pragma("unroll") for (int k = 0; k < 2; ++k) dst[m][k] = *(const PG8_LAS bf16x8*)(lds + PG8_SA(b, h) + aoff + m * 2048 + k * 1024); } while (0)
#define PG8_LDB(dst, b, h) do { _Pragma("unroll") for (int n = 0; n < 2; ++n) _Pragma("unroll") for (int k = 0; k < 2; ++k) dst[n][k] = *(const PG8_LAS bf16x8*)(lds + PG8_SB(b, h) + boff + n * 2048 + k * 1024); } while (0)
#define PG8_MMA(ai, bj, At, Bt) do { __builtin_amdgcn_s_setprio(1); _Pragma("unroll") for (int m = 0; m < 4; ++m) _Pragma("unroll") for (int n = 0; n < 2; ++n) _Pragma("unroll") for (int k = 0; k < 2; ++k) \
        acc[ai][bj][m][n] = __builtin_amdgcn_mfma_f32_16x16x32_bf16(Bt[n][k], At[m][k], acc[ai][bj][m][n], 0, 0, 0); __builtin_amdgcn_s_setprio(0); } while (0)
#define PG8_WAIT_V(n) asm volatile("s_waitcnt vmcnt(" #n ")" ::: "memory")
#define PG8_WAIT_L(n) asm volatile("s_waitcnt lgkmcnt(" #n ")" ::: "memory")
#define PG8_BAR __builtin_amdgcn_s_barrier()
#define PG8_SCHED __builtin_amdgcn_sched_barrier(0)
    Unit cur, nxt; int ui = 0;
    if (!S.next(0, cur)) return;
    f32x4 acc[2][2][4][2];
#pragma unroll
    for (int a = 0; a < 2; ++a)
#pragma unroll
        for (int b = 0; b < 2; ++b)
#pragma unroll
            for (int m = 0; m < 4; ++m)
#pragma unroll
                for (int n = 0; n < 2; ++n) acc[a][b][m][n] = (f32x4){0.f, 0.f, 0.f, 0.f};
    bf16x8 At[4][2], B0[2][2], B1[2][2];
    const char* cA = cur.a; const char* cB = cur.b;
    S.a_ready(cur);
    if constexpr (SP2) {
        PG8_STAGE(PG8_SB(0, 0), cB, voffB); PG8_STAGE(PG8_SB(0, 1), cB + hstepB, voffB); PG8_STAGE(PG8_SA(0, 0), cA, voffA); PG8_STAGE(PG8_SA(0, 1), cA + hstepA, voffA);
        if (wr == 1) PG8_BAR;
        PG8_WAIT_V(2); PG8_BAR;
        PG8_STAGE(PG8_SB(1, 0), cB + kstep, voffB); PG8_STAGE(PG8_SA(1, 0), cA + kstep, voffA); PG8_STAGE(PG8_SB(1, 1), cB + hstepB + kstep, voffB);
        PG8_WAIT_V(6); PG8_BAR;
    } else {
        PG8_STAGE(PG8_SB(0, 0), cB, voffB); PG8_STAGE(PG8_SA(0, 0), cA, voffA); PG8_STAGE(PG8_SB(0, 1), cB + hstepB, voffB); PG8_STAGE(PG8_SA(0, 1), cA + hstepA, voffA);
        if (wr == 1) PG8_BAR;
        PG8_WAIT_V(4); PG8_BAR;
        PG8_STAGE(PG8_SB(1, 0), cB + kstep, voffB); PG8_STAGE(PG8_SA(1, 0), cA + kstep, voffA); PG8_STAGE(PG8_SB(1, 1), cB + hstepB + kstep, voffB);
        PG8_WAIT_V(6); PG8_BAR;
    }
    for (;;) {
        const bool has_next = S.next(ui + 1, nxt);
        const char* nA = has_next ? nxt.a : cA; const char* nB = has_next ? nxt.b : cB;
        for (int t = 0; t < nt; t += 2) {
            const bool last = (t == nt - 2);
            const char* a1 = cA + (size_t)(t + 1) * kstep;
            const char* a2 = last ? nA : cA + (size_t)(t + 2) * kstep; const char* b2 = last ? nB : cB + (size_t)(t + 2) * kstep;
            const char* a3 = a2 + kstep; const char* b3 = b2 + kstep;
            if (last && has_next) S.a_ready(nxt);
            if constexpr (SP2) {
            PG8_LDB(B0, 0, 0); PG8_LDB(B1, 0, 1); PG8_SCHED; PG8_LDA(At, 0, 0); PG8_STAGE(PG8_SA(1, 1), a1 + hstepA, voffA);
            PG8_WAIT_V(8); PG8_WAIT_L(0); PG8_BAR; PG8_MMA(0, 0, At, B0); PG8_MMA(0, 1, At, B1); PG8_BAR; PG8_SCHED;
            PG8_LDA(At, 0, 1); PG8_STAGE(PG8_SB(0, 0), b2, voffB); PG8_STAGE(PG8_SB(0, 1), b2 + hstepB, voffB); PG8_STAGE(PG8_SA(0, 0), a2, voffA);
            PG8_WAIT_V(8); PG8_WAIT_L(0); PG8_BAR; PG8_MMA(1, 0, At, B0); PG8_MMA(1, 1, At, B1); PG8_BAR; PG8_SCHED;
            PG8_LDB(B0, 1, 0); PG8_LDB(B1, 1, 1); PG8_SCHED; PG8_LDA(At, 1, 0); PG8_STAGE(PG8_SA(0, 1), a2 + hstepA, voffA);
            PG8_WAIT_V(8); PG8_WAIT_L(0); PG8_BAR; PG8_MMA(0, 0, At, B0); PG8_MMA(0, 1, At, B1); PG8_BAR; PG8_SCHED;
            PG8_LDA(At, 1, 1); PG8_STAGE(PG8_SB(1, 0), b3, voffB); PG8_STAGE(PG8_SB(1, 1), b3 + hstepB, voffB); PG8_STAGE(PG8_SA(1, 0), a3, voffA);
            PG8_WAIT_V(8); PG8_WAIT_L(0); PG8_BAR; PG8_MMA(1, 0, At, B0); PG8_MMA(1, 1, At, B1); PG8_BAR; PG8_SCHED;
            } else {
            PG8_LDB(B0, 0, 0); PG8_SCHED; PG8_LDA(At, 0, 0); PG8_STAGE(PG8_SA(1, 1), a1 + hstepA, voffA);
            PG8_WAIT_L(8); PG8_BAR; PG8_WAIT_L(0); PG8_MMA(0, 0, At, B0); PG8_BAR; PG8_SCHED;
            PG8_LDB(B1, 0, 1); PG8_STAGE(PG8_SB(0, 0), b2, voffB);
            PG8_BAR; PG8_WAIT_L(0); PG8_MMA(0, 1, At, B1); PG8_BAR;
            PG8_LDA(At, 0, 1); PG8_STAGE(PG8_SA(0, 0), a2, voffA);
            PG8_BAR; PG8_WAIT_L(0); PG8_MMA(1, 0, At, B0); PG8_BAR; PG8_SCHED;
            PG8_STAGE(PG8_SB(0, 1), b2 + hstepB, voffB);
            PG8_WAIT_V(6); PG8_BAR; PG8_MMA(1, 1, At, B1); PG8_BAR;
            PG8_LDB(B0, 1, 0); PG8_SCHED; PG8_LDA(At, 1, 0); PG8_STAGE(PG8_SA(0, 1), a2 + hstepA, voffA);
            PG8_WAIT_L(8); PG8_BAR; PG8_WAIT_L(0); PG8_MMA(0, 0, At, B0); PG8_BAR; PG8_SCHED;
            PG8_LDB(B1, 1, 1); PG8_STAGE(PG8_SB(1, 0), b3, voffB);
            PG8_BAR; PG8_WAIT_L(0); PG8_MMA(0, 1, At, B1); PG8_BAR;
            PG8_LDA(At, 1, 1); PG8_STAGE(PG8_SA(1, 0), a3, voffA);
            PG8_BAR; PG8_WAIT_L(0); PG8_MMA(1, 0, At, B0); PG8_BAR; PG8_SCHED;
            PG8_STAGE(PG8_SB(1, 1), b3 + hstepB, voffB);
            PG8_WAIT_V(6); PG8_BAR; PG8_MMA(1, 1, At, B1); PG8_BAR;
            }
        }
        if constexpr (ALIGN_EPI) { if (wr == 0) PG8_BAR; }
        if constexpr (!Epi::AFTER_DRAIN) { E(acc, cur, wr, wc, fr, fq); S.done(cur); }
        if (!has_next) break;
#pragma unroll
        for (int a = 0; a < 2; ++a)
#pragma unroll
            for (int b = 0; b < 2; ++b)
#pragma unroll
                for (int m = 0; m < 4; ++m)
#pragma unroll
                    for (int n = 0; n < 2; ++n) acc[a][b][m][n] = (f32x4){0.f, 0.f, 0.f, 0.f};
        cur = nxt; cA = nA; cB = nB; ++ui;
        if constexpr (ALIGN_EPI) { if (wr == 1) PG8_BAR; }
    }
    PG8_WAIT_V(0);
    if constexpr (!ALIGN_EPI) { if (wr == 0) PG8_BAR; }
    PG8_BAR;
    if constexpr (Epi::AFTER_DRAIN) { E.fused(acc, cur, wr, wc, fr, fq, lds, wid, lane); S.done(cur); }
#undef PG8_SA
#undef PG8_SB
#undef PG8_STAGE
#undef PG8_LDA
#undef PG8_LDB
#undef PG8_MMA
#undef PG8_WAIT_V
#undef PG8_WAIT_L
#undef PG8_BAR
#undef PG8_SCHED
}
}

namespace pg8 {
typedef f32x4 Acc[2][2][4][2];
constexpr float ATT_C2 = 0.125f * 1.4426950408889634f;
__device__ __forceinline__ float dot4(f32x4 a) { return (a[0] * a[0] + a[1] * a[1]) + (a[2] * a[2] + a[3] * a[3]); }
__device__ __forceinline__ void st_bf16x4(bf16_t* p, f32x4 v) { u32x2 w; w.x = cvt_pk_bf16(v[0], v[1]); w.y = cvt_pk_bf16(v[2], v[3]); *(u32x2*)p = w; }

__device__ __forceinline__ float row_rstd(const float* ssp, int row, int fr, int fq) {
    const f32x4 v = *(const f32x4*)(ssp + (size_t)row * 16 + 4 * fq); float s = (v[0] + v[1]) + (v[2] + v[3]);
    s += lane_xor(s, 16, fq * 16 + fr); s += lane_xor(s, 32, fq * 16 + fr);
    return rsqrtf(s * (1.f / DM) + NORM_EPS);
}
__device__ __forceinline__ void st_bf16x8(bf16_t* p, f32x4 a, f32x4 b) { u32x4 w; w.x = cvt_pk_bf16(a[0], a[1]); w.y = cvt_pk_bf16(a[2], a[3]); w.z = cvt_pk_bf16(b[0], b[1]); w.w = cvt_pk_bf16(b[2], b[3]); *(u32x4*)p = w; }
__device__ __forceinline__ void rstd8(const float* ssp, int row0, int fr, int fq, float (&rs)[2][4]) {
    f32x4 v[2][4];
#pragma unroll
    for (int ai = 0; ai < 2; ++ai)
#pragma unroll
        for (int m = 0; m < 4; ++m) v[ai][m] = *(const f32x4*)(ssp + (size_t)(row0 + ai * 128 + m * 16) * 16 + 4 * fq);
#pragma unroll
    for (int ai = 0; ai < 2; ++ai)
#pragma unroll
        for (int m = 0; m < 4; ++m) { float s = (v[ai][m][0] + v[ai][m][1]) + (v[ai][m][2] + v[ai][m][3]);
            s += lane_xor(s, 16, fq * 16 + fr); s += lane_xor(s, 32, fq * 16 + fr); rs[ai][m] = rsqrtf(s * (1.f / DM) + NORM_EPS); }
}
struct SchedDense {
    GridOrder go; const char* A; const char* Bt; size_t ta, tb;
    __device__ void init(const void* A_, const void* Bt_, int lda, int ldb, int nM, int nN) { go.init(nM, nN, gridDim.x, blockIdx.x); A = (const char*)A_; Bt = (const char*)Bt_; ta = (size_t)256 * lda * 2; tb = (size_t)256 * ldb * 2; }
    __device__ bool next(int i, Unit& u) const { int pm, pn; if (!go.tile(i, pm, pn)) return false; u.pm = pm; u.pn = pn; u.kind = 0; u.aux = 0; u.a = A + pm * ta; u.b = Bt + pn * tb; return true; }
    __device__ __forceinline__ void a_ready(const Unit&) const {}
    __device__ __forceinline__ void done(const Unit&) const {}
};
template <int MODE> struct SchedX {
    GridOrder go; const char* A; const char* B;
    __device__ void init(const void* A_, const void* B_) { go.init(MTOK / 256, 4, gridDim.x, blockIdx.x); A = (const char*)A_; B = (const char*)B_; }
    __device__ bool next(int i, Unit& u) const { int pm, pn; if (!go.tile(i, pm, pn)) return false; u.pm = pm; u.pn = pn; u.kind = 0; u.aux = 0;
        u.a = A + ((size_t)pm * 256 * DM + pn * 256) * 2;
        u.b = MODE == 0 ? B + ((size_t)(pm >> 4) * 256 * DM + pn * 256) * 2 : B + ((size_t)((pm >> 4) * 4 + pn) * 65536) * 2; return true; }
    __device__ __forceinline__ void a_ready(const Unit&) const {}
    __device__ __forceinline__ void done(const Unit&) const {}
};
struct SchedOne {
    Unit u0; bool have;
    __device__ bool next(int i, Unit& u) const { if (i != 0 || !have) return false; u = u0; return true; }
    __device__ __forceinline__ void a_ready(const Unit&) const {}
    __device__ __forceinline__ void done(const Unit&) const {}
};

struct EpiInProj {
    static constexpr bool PERM = true, AFTER_DRAIN = false;
    bf16_t* O; const float* qg; const float* kg; const float* ss; float* SM;
    __device__ __forceinline__ void operator()(const Acc& acc, const Unit& u, int wr, int wc, int fr, int fq) const {
        const int row0 = u.pm * 256 + wr * 64 + fr, colb = u.pn * 256 + 64 * wc + 8 * fq;
        float rs8[2][4]; rstd8(ss, row0, fr, fq, rs8);
        if (u.pn < 4) {
            const float* g = u.pn < 2 ? qg : kg; const float sc = u.pn < 2 ? ATT_C2 : 1.f;
            f32x4 gv[2][2];
#pragma unroll
            for (int bj = 0; bj < 2; ++bj)
#pragma unroll
                for (int n = 0; n < 2; ++n) gv[bj][n] = *(const f32x4*)(g + 32 * bj + 8 * fq + 4 * n);
#pragma unroll
            for (int ai = 0; ai < 2; ++ai)
#pragma unroll
                for (int m = 0; m < 4; ++m) {
                    const int row = row0 + ai * 128 + m * 16;
                    const float rstd = rs8[ai][m];
                    float s2 = (dot4(acc[ai][0][m][0]) + dot4(acc[ai][0][m][1])) + (dot4(acc[ai][1][m][0]) + dot4(acc[ai][1][m][1]));
                    s2 += lane_xor(s2, 16, fq * 16 + fr); s2 += lane_xor(s2, 32, fq * 16 + fr);
                    const float r = rstd * rsqrtf(rstd * rstd * s2 * (1.f / 64.f) + NORM_EPS) * sc;
                    bf16_t* rowp = O + (size_t)row * PN + colb;
#pragma unroll
                    for (int bj = 0; bj < 2; ++bj) { const f32x4 v0 = acc[ai][bj][m][0] * r * gv[bj][0], v1 = acc[ai][bj][m][1] * r * gv[bj][1];
                        u32x4 w; w.x = cvt_pk_bf16(v0[0], v0[1]); w.y = cvt_pk_bf16(v0[2], v0[3]); w.z = cvt_pk_bf16(v1[0], v1[1]); w.w = cvt_pk_bf16(v1[2], v1[3]); *(u32x4*)(rowp + 32 * bj) = w; }
                }
        } else if (u.pn < 14) {
#pragma unroll
            for (int ai = 0; ai < 2; ++ai)
#pragma unroll
                for (int m = 0; m < 4; ++m) {
                    const int row = row0 + ai * 128 + m * 16;
                    const float rstd = rs8[ai][m];
                    bf16_t* rowp = O + (size_t)row * PN + colb;
#pragma unroll
                    for (int bj = 0; bj < 2; ++bj) { const f32x4 v0 = acc[ai][bj][m][0] * rstd, v1 = acc[ai][bj][m][1] * rstd;
                        u32x4 w; w.x = cvt_pk_bf16(v0[0], v0[1]); w.y = cvt_pk_bf16(v0[2], v0[3]); w.z = cvt_pk_bf16(v1[0], v1[1]); w.w = cvt_pk_bf16(v1[2], v1[3]); *(u32x4*)(rowp + 32 * bj) = w; }
                }
        } else {
#pragma unroll
            for (int ai = 0; ai < 2; ++ai)
#pragma unroll
                for (int m = 0; m < 4; ++m) {
                    const int row = row0 + ai * 128 + m * 16;
                    const float rstd = rs8[ai][m];
                    if (wc == 0 && fq < 2) { *(f32x4*)(SM + (size_t)row * 12 + 8 * fq) = acc[ai][0][m][0] * rstd; if (fq == 0) *(f32x4*)(SM + (size_t)row * 12 + 4) = acc[ai][0][m][1] * rstd; }
                }
        }
    }
};
struct EpiResid {
    static constexpr bool PERM = true, AFTER_DRAIN = false;
    bf16_t* xb; float* ss; float* outf;
    __device__ __forceinline__ void operator()(const Acc& acc, const Unit& u, int wr, int wc, int fr, int fq) const {
        const int row0 = u.pm * 256 + wr * 64 + fr, col0 = u.pn * 256 + wc * 32 + 8 * fq;
#pragma unroll
        for (int ai = 0; ai < 2; ++ai) {
            u32x4 b[4][2];
#pragma unroll
            for (int m = 0; m < 4; ++m)
#pragma unroll
                for (int bj = 0; bj < 2; ++bj) b[m][bj] = *(const u32x4*)(xb + (size_t)(row0 + ai * 128 + m * 16) * DM + col0 + bj * 128);
#pragma unroll
            for (int m = 0; m < 4; ++m) { const int row = row0 + ai * 128 + m * 16; const size_t off = (size_t)row * DM + col0; float sq = 0.f;
#pragma unroll
                for (int bj = 0; bj < 2; ++bj) { const u32x4 bb = b[m][bj];
                    f32x4 v0, v1; v0[0] = __builtin_bit_cast(float, bb.x << 16); v0[1] = __builtin_bit_cast(float, bb.x & 0xffff0000u); v0[2] = __builtin_bit_cast(float, bb.y << 16); v0[3] = __builtin_bit_cast(float, bb.y & 0xffff0000u);
                    v1[0] = __builtin_bit_cast(float, bb.z << 16); v1[1] = __builtin_bit_cast(float, bb.z & 0xffff0000u); v1[2] = __builtin_bit_cast(float, bb.w << 16); v1[3] = __builtin_bit_cast(float, bb.w & 0xffff0000u);
                    v0 = v0 + acc[ai][bj][m][0]; v1 = v1 + acc[ai][bj][m][1]; st_bf16x8(xb + off + bj * 128, v0, v1);
                    if (outf) { *(f32x4*)(outf + off + bj * 128) = v0; *(f32x4*)(outf + off + bj * 128 + 4) = v1; } sq += dot4(v0) + dot4(v1); }
                sq += lane_xor(sq, 16, fq * 16 + fr); sq += lane_xor(sq, 32, fq * 16 + fr);
                if (fq == 0) ss[(size_t)row * 16 + u.pn * 4 + wc] = sq;
            }
            asm volatile("" ::: "memory");
        }
    }
};
struct EpiNull { static constexpr bool PERM = false, AFTER_DRAIN = false; float* sink; __device__ __forceinline__ void operator()(const Acc& acc, const Unit& u, int wr, int wc, int fr, int fq) const { if (acc[0][0][0][0][0] == 123456.789f) sink[0] = 1.f; } };
struct EpiSwiGLU {
    static constexpr bool PERM = true, AFTER_DRAIN = false;
    bf16_t* O; const float* ss;
    __device__ __forceinline__ void operator()(const Acc& acc, const Unit& u, int wr, int wc, int fr, int fq) const {
        const int row0 = u.pm * 256 + wr * 64 + fr, col0 = u.pn * 128 + wc * 32 + 8 * fq;
        float rs8[2][4]; rstd8(ss, row0, fr, fq, rs8);
#pragma unroll
        for (int ai = 0; ai < 2; ++ai)
#pragma unroll
            for (int m = 0; m < 4; ++m) { const int row = row0 + ai * 128 + m * 16; bf16_t* rowp = O + (size_t)row * D_FF + col0; const float rstd = rs8[ai][m];
                u32x4 w;
#pragma unroll
                for (int n = 0; n < 2; ++n) { const f32x4 g = acc[ai][0][m][n] * rstd, up = acc[ai][1][m][n] * rstd; f32x4 v;
#pragma unroll
                    for (int i = 0; i < 4; ++i) v[i] = g[i] * __builtin_amdgcn_rcpf(1.f + __expf(-g[i])) * up[i];
                    w[2 * n] = cvt_pk_bf16(v[0], v[1]); w[2 * n + 1] = cvt_pk_bf16(v[2], v[3]); }
                *(u32x4*)rowp = w; }
    }
};
struct EpiBf16 {
    static constexpr bool PERM = true, AFTER_DRAIN = false;
    bf16_t* O;
    __device__ __forceinline__ void operator()(const Acc& acc, const Unit& u, int wr, int wc, int fr, int fq) const {
        const int row0 = u.pm * 256 + wr * 64 + fr, col0 = u.pn * 256 + wc * 32 + 8 * fq;
#pragma unroll
        for (int ai = 0; ai < 2; ++ai)
#pragma unroll
            for (int m = 0; m < 4; ++m) { bf16_t* rowp = O + (size_t)(row0 + ai * 128 + m * 16) * DM + col0;
#pragma unroll
                for (int bj = 0; bj < 2; ++bj) st_bf16x8(rowp + bj * 128, acc[ai][bj][m][0], acc[ai][bj][m][1]); }
    }
};
#define PG8_BARRIER() do { asm volatile("s_waitcnt lgkmcnt(0)" ::: "memory"); __builtin_amdgcn_s_barrier(); asm volatile("" ::: "memory"); } while (0)
__device__ __forceinline__ void tile_row_rstd(const Acc& acc, float (&rs)[2][4], int wr, int wc, int fr, int fq, PG8_LAS unsigned char* lds) {
    PG8_LAS float* P = (PG8_LAS float*)lds;
#pragma unroll
    for (int ai = 0; ai < 2; ++ai)
#pragma unroll
        for (int m = 0; m < 4; ++m) {
            float ss = (dot4(acc[ai][0][m][0]) + dot4(acc[ai][0][m][1])) + (dot4(acc[ai][1][m][0]) + dot4(acc[ai][1][m][1]));
            ss += lane_xor(ss, 16, fq * 16 + fr); ss += lane_xor(ss, 32, fq * 16 + fr);
            if (fq == 0) P[(ai * 128 + wr * 64 + m * 16 + fr) * 4 + wc] = ss;
        }
    PG8_BARRIER();
#pragma unroll
    for (int ai = 0; ai < 2; ++ai)
#pragma unroll
        for (int m = 0; m < 4; ++m) { const f32x4 p = *(const PG8_LAS f32x4*)(P + (ai * 128 + wr * 64 + m * 16 + fr) * 4); rs[ai][m] = rsqrtf(((p[0] + p[1]) + (p[2] + p[3])) * (1.f / 256.f) + NORM_EPS); }
}
struct EpiQProj {
    static constexpr bool PERM = true, AFTER_DRAIN = true;
    bf16_t* O; const float* g; const float* ss;
    __device__ __forceinline__ void fused(Acc& acc, const Unit& u, int wr, int wc, int fr, int fq, PG8_LAS unsigned char* lds, int wid, int lane) const {
        const int row0 = u.pm * 256 + wr * 64 + fr, cl = wc * 32 + 8 * fq;
        float rs8[2][4]; rstd8(ss, row0, fr, fq, rs8);
#pragma unroll
        for (int ai = 0; ai < 2; ++ai)
#pragma unroll
            for (int m = 0; m < 4; ++m) { const float rstd = rs8[ai][m];
#pragma unroll
                for (int bj = 0; bj < 2; ++bj)
#pragma unroll
                    for (int n = 0; n < 2; ++n) acc[ai][bj][m][n] = acc[ai][bj][m][n] * rstd; }
        float rs[2][4]; tile_row_rstd(acc, rs, wr, wc, fr, fq, lds);
#pragma unroll
        for (int bj = 0; bj < 2; ++bj) { const f32x4 g0 = *(const f32x4*)(g + cl + bj * 128), g1 = *(const f32x4*)(g + cl + bj * 128 + 4);
#pragma unroll
            for (int ai = 0; ai < 2; ++ai)
#pragma unroll
                for (int m = 0; m < 4; ++m) st_bf16x8(O + (size_t)(row0 + ai * 128 + m * 16) * DM + u.pn * 256 + cl + bj * 128, acc[ai][bj][m][0] * rs[ai][m] * g0, acc[ai][bj][m][1] * rs[ai][m] * g1); }
    }
};
struct EpiKV {
    static constexpr bool PERM = false, AFTER_DRAIN = true;
    bf16_t* KN; bf16_t* VT; const float* g;
    __device__ __forceinline__ void fused(Acc& acc, const Unit& u, int wr, int wc, int fr, int fq, PG8_LAS unsigned char* lds, int wid, int lane) const {
        const int l = u.aux;
        if (u.pn < 4) {
            float rs[2][4]; tile_row_rstd(acc, rs, wr, wc, fr, fq, lds);
            bf16_t* Ob = KN + (size_t)l * NMEM * DM; const float* gl = g + l * 256;
            const int row0 = u.pm * 256 + wr * 64 + fr, cl = wc * 32 + 4 * fq;
#pragma unroll
            for (int bj = 0; bj < 2; ++bj)
#pragma unroll
                for (int n = 0; n < 2; ++n) { const f32x4 gv = *(const f32x4*)(gl + cl + bj * 128 + n * 16);
#pragma unroll
                    for (int ai = 0; ai < 2; ++ai)
#pragma unroll
                        for (int m = 0; m < 4; ++m) st_bf16x4(Ob + (size_t)(row0 + ai * 128 + m * 16) * DM + u.pn * 256 + cl + bj * 128 + n * 16, acc[ai][bj][m][n] * rs[ai][m] * gv); }
        } else {
            bf16_t* Ob = VT + ((size_t)(l * 4 + u.pm) * 4 + (u.pn - 4)) * 65536;
            const int r0 = wr * 64 + fr, c0 = wc * 32 + 4 * fq;
#pragma unroll
            for (int ai = 0; ai < 2; ++ai)
#pragma unroll
                for (int m = 0; m < 4; ++m)
#pragma unroll
                    for (int bj = 0; bj < 2; ++bj)
#pragma unroll
                        for (int n = 0; n < 2; ++n)
#pragma unroll
                            for (int i = 0; i < 4; ++i) Ob[(size_t)(c0 + bj * 128 + n * 16 + i) * 256 + r0 + ai * 128 + m * 16] = (bf16_t)f2bf(acc[ai][bj][m][n][i]);
        }
    }
};
struct EpiSoftmax {
    static constexpr bool PERM = true, AFTER_DRAIN = true;
    bf16_t* O;
    __device__ __forceinline__ void fused(Acc& acc, const Unit& u, int wr, int wc, int fr, int fq, PG8_LAS unsigned char* lds, int wid, int lane) const {
        PG8_LAS float* P = (PG8_LAS float*)lds; PG8_LAS float* P2 = (PG8_LAS float*)(lds + 4096);
        const float sc = 0.0625f * LOG2E;
#pragma unroll
        for (int ai = 0; ai < 2; ++ai)
#pragma unroll
            for (int m = 0; m < 4; ++m) {
                float mx = -INFINITY;
#pragma unroll
                for (int bj = 0; bj < 2; ++bj)
#pragma unroll
                    for (int n = 0; n < 2; ++n) { const f32x4 a = acc[ai][bj][m][n]; mx = fmaxf(mx, fmaxf(fmaxf(a[0], a[1]), fmaxf(a[2], a[3]))); }
                mx = fmaxf(mx, lane_xor(mx, 16, fq * 16 + fr)); mx = fmaxf(mx, lane_xor(mx, 32, fq * 16 + fr));
                if (fq == 0) P[(ai * 128 + wr * 64 + m * 16 + fr) * 4 + wc] = mx;
            }
        PG8_BARRIER();
#pragma unroll
        for (int ai = 0; ai < 2; ++ai)
#pragma unroll
            for (int m = 0; m < 4; ++m) {
                const int row = ai * 128 + wr * 64 + m * 16 + fr;
                const f32x4 p = *(const PG8_LAS f32x4*)(P + row * 4); const float mx = fmaxf(fmaxf(p[0], p[1]), fmaxf(p[2], p[3])) * sc;
                float s = 0.f;
#pragma unroll
                for (int bj = 0; bj < 2; ++bj)
#pragma unroll
                    for (int n = 0; n < 2; ++n) { f32x4 a = acc[ai][bj][m][n];
#pragma unroll
                        for (int i = 0; i < 4; ++i) { a[i] = __builtin_amdgcn_exp2f(a[i] * sc - mx); s += a[i]; }
                        acc[ai][bj][m][n] = a; }
                s += lane_xor(s, 16, fq * 16 + fr); s += lane_xor(s, 32, fq * 16 + fr);
                if (fq == 0) P2[row * 4 + wc] = s;
            }
        PG8_BARRIER();
        const int row0 = u.pm * 256 + wr * 64 + fr, col0 = u.pn * 256 + wc * 32 + 8 * fq;
#pragma unroll
        for (int ai = 0; ai < 2; ++ai)
#pragma unroll
            for (int m = 0; m < 4; ++m) {
                const int row = ai * 128 + wr * 64 + m * 16 + fr;
                const f32x4 p = *(const PG8_LAS f32x4*)(P2 + row * 4); const float inv = __builtin_amdgcn_rcpf((p[0] + p[1]) + (p[2] + p[3]));
                bf16_t* rowp = O + (size_t)(row0 + ai * 128 + m * 16) * DM + col0;
#pragma unroll
                for (int bj = 0; bj < 2; ++bj) st_bf16x8(rowp + bj * 128, acc[ai][bj][m][0] * inv, acc[ai][bj][m][1] * inv);
            }
    }
};
}
namespace attn_body {
using bf16=__hip_bfloat16;
using bf16x8=__attribute__((ext_vector_type(8)))short;
using s16x4=__attribute__((ext_vector_type(4)))short;
using f32x16=__attribute__((ext_vector_type(16)))float;
using u32x4=__attribute__((ext_vector_type(4)))unsigned;
constexpr int BATCH=4,NHEAD=16,SEQ=4096,D=64,PQ=3584,PO=1024;
constexpr int NW=8,QBLK=32,QB=QBLK*NW,KVBLK=64,NQB=SEQ/QB;
constexpr int ATTN_UNIT_ROWS=QB;
__device__ __forceinline__ int crow(int r,int hi){return (r&3)+8*(r>>2)+4*hi;}
#define SBAR() __builtin_amdgcn_sched_barrier(0)
__device__ __forceinline__ void cmask(f32x16&p0,f32x16&p1,int jb,int qrel,int hi){
  const float NEG=-INFINITY; int kb=64*jb+4*hi;
  #pragma unroll
  for(int r=0;r<16;++r){int kv=kb+(r&3)+8*(r>>2); if(kv>qrel)p0[r]=NEG; if(kv+32>qrel)p1[r]=NEG;}
}

constexpr int NSLOT=3, SLOTB=8192;
constexpr int LDS_K=0, LDS_V=NSLOT*SLOTB, LDS_WS=2*NSLOT*SLOTB, LDS_OST=LDS_WS+NW*64*4, LDS_BYTES=LDS_OST+NW*4096;
constexpr float C2=0.125f*1.4426950408889634f;
__device__ __forceinline__ void glds16(const void*gsrc,unsigned lds_dst){unsigned keep;
  asm volatile("s_mov_b32 %0, m0\n\ts_mov_b32 m0, %2\n\ts_nop 0\n\tglobal_load_lds_dwordx4 %1, off\n\ts_mov_b32 m0, %0":"=&s"(keep):"v"(gsrc),"s"(lds_dst):"memory");}
__device__ __forceinline__ float max3f(float a,float b,float c){float r;asm("v_max3_f32 %0, %1, %2, %3":"=v"(r):"v"(a),"v"(b),"v"(c));return r;}
__device__ __forceinline__ float max2f(float a,float b){float r;asm("v_max_f32_e32 %0, %1, %2":"=v"(r):"v"(a),"v"(b));return r;}
__device__ __forceinline__ float fadd_s(float a,float b){float r;asm("v_add_f32_e32 %0, %1, %2":"=v"(r):"v"(a),"v"(b));return r;}
__device__ __forceinline__ float fsub_s(float a,float b){float r;asm("v_sub_f32_e32 %0, %1, %2":"=v"(r):"v"(a),"v"(b));return r;}
typedef float f32x2_t __attribute__((ext_vector_type(2))); typedef __bf16 bf16x2_t __attribute__((ext_vector_type(2)));
__device__ __forceinline__ unsigned cvtpk_s(float lo,float hi){f32x2_t v={lo,hi};bf16x2_t b=__builtin_convertvector(v,bf16x2_t);return __builtin_bit_cast(unsigned,b);}
#define WAIT_BAR(N) asm volatile("s_waitcnt vmcnt(" #N ") lgkmcnt(0)\n\ts_barrier":::"memory")

__device__ __forceinline__ void qkt(f32x16&p0,f32x16&p1,const char*Kslot,const bf16x8*qr,const f32x16&negm,int r32,int hi){
  const char*kb=Kslot+hi*1024+r32*16;
  #pragma unroll
  for(int d0=0;d0<4;++d0){
    const bf16x8 b0=*reinterpret_cast<const bf16x8*>(kb+d0*2048);
    const bf16x8 b1=*reinterpret_cast<const bf16x8*>(kb+d0*2048+512);
    if(d0==0){p0=__builtin_amdgcn_mfma_f32_32x32x16_bf16(b0,qr[0],negm,0,0,0);p1=__builtin_amdgcn_mfma_f32_32x32x16_bf16(b1,qr[0],negm,0,0,0);}
    else{p0=__builtin_amdgcn_mfma_f32_32x32x16_bf16(b0,qr[d0],p0,0,0,0);p1=__builtin_amdgcn_mfma_f32_32x32x16_bf16(b1,qr[d0],p1,0,0,0);}}
}
typedef __attribute__((address_space(3))) const char* lds_cptr;
typedef short v4i16_t __attribute__((ext_vector_type(4)));
__device__ __forceinline__ void kload8(bf16x8*kf,lds_cptr kp){
  kf[0]=*(const __attribute__((address_space(3))) bf16x8*)(kp);      kf[1]=*(const __attribute__((address_space(3))) bf16x8*)(kp+512);
  kf[2]=*(const __attribute__((address_space(3))) bf16x8*)(kp+2048); kf[3]=*(const __attribute__((address_space(3))) bf16x8*)(kp+2560);
  kf[4]=*(const __attribute__((address_space(3))) bf16x8*)(kp+4096); kf[5]=*(const __attribute__((address_space(3))) bf16x8*)(kp+4608);
  kf[6]=*(const __attribute__((address_space(3))) bf16x8*)(kp+6144); kf[7]=*(const __attribute__((address_space(3))) bf16x8*)(kp+6656);
}
__device__ __forceinline__ void kload2(bf16x8*kf,lds_cptr kp,int j){ kf[2*j]=*(const __attribute__((address_space(3))) bf16x8*)(kp+j*2048); kf[2*j+1]=*(const __attribute__((address_space(3))) bf16x8*)(kp+j*2048+512); }
__device__ __forceinline__ s16x4 vtr(lds_cptr p){ return __builtin_bit_cast(s16x4,__builtin_amdgcn_ds_read_tr16_b64_v4i16((__attribute__((address_space(3))) v4i16_t*)p)); }
__device__ __forceinline__ float rowmax(const f32x16&p0,const f32x16&p1){
  float a=max3f(p0[0],p0[1],p1[0]),b=max3f(p0[2],p0[3],p1[1]);a=max3f(a,p1[2],p1[3]);
  #pragma unroll
  for(int r=4;r<16;r+=4){a=max3f(a,p0[r],p0[r+1]);b=max3f(b,p0[r+2],p0[r+3]);a=max3f(a,p1[r],p1[r+1]);b=max3f(b,p1[r+2],p1[r+3]);}
  const float m=max2f(a,b);
  auto rr=__builtin_amdgcn_permlane32_swap(__float_as_uint(m),__float_as_uint(m),false,false);
  return max2f(__uint_as_float(rr[0]),__uint_as_float(rr[1]));
}
__device__ __forceinline__ void pv(f32x16*o,int vb,bf16x8 pa0,bf16x8 pa1,bf16x8 pa2,bf16x8 pa3){
  #pragma unroll
  for(int d0=0;d0<2;++d0){s16x4 lo[4],hi[4];
    #pragma unroll
    for(int ks=0;ks<4;++ks){
      asm volatile("ds_read_b64_tr_b16 %0,%1 offset:%c2":"=&v"(lo[ks]):"v"(vb),"i"(d0*4096+ks*1024):"memory");
      asm volatile("ds_read_b64_tr_b16 %0,%1 offset:%c2":"=&v"(hi[ks]):"v"(vb),"i"(d0*4096+ks*1024+512):"memory");}
    asm volatile("s_waitcnt lgkmcnt(0)":::"memory");SBAR();
    #define PK(k) (bf16x8){lo[k][0],lo[k][1],lo[k][2],lo[k][3],hi[k][0],hi[k][1],hi[k][2],hi[k][3]}
    o[d0]=__builtin_amdgcn_mfma_f32_32x32x16_bf16(pa0,PK(0),o[d0],0,0,0);
    o[d0]=__builtin_amdgcn_mfma_f32_32x32x16_bf16(pa1,PK(1),o[d0],0,0,0);
    o[d0]=__builtin_amdgcn_mfma_f32_32x32x16_bf16(pa2,PK(2),o[d0],0,0,0);
    o[d0]=__builtin_amdgcn_mfma_f32_32x32x16_bf16(pa3,PK(3),o[d0],0,0,0);
    #undef PK
  }
}

#ifndef ATTN_STORE16
#define ATTN_STORE16(p,v) (*(u32x4*)(p)=(v))
#endif
template<int THRL> __device__ __forceinline__ void attn_unit(int b,int h,int qb,const bf16*Q,const bf16*__restrict__ K,const bf16*__restrict__ V,bf16*O,char*shm,int tid_in){
  int tid_l=tid_in; asm volatile("":"+v"(tid_l)); const int tid=tid_l,lane=tid&63,r32=lane&31,hi=lane>>5; const int wid=__builtin_amdgcn_readfirstlane(tid>>6);
  const long rowbase=(long)b*SEQ; const int q0=qb*QB;
  const bf16*Qw=Q+(rowbase+q0+wid*QBLK)*PQ+(h>>1)*D;
  const bf16*Kh=K+rowbase*PQ+512+(h>>1)*D,*Vh=V+rowbase*PQ+1024+(h>>2)*128+(h&1)*D;
  const unsigned lds0=(unsigned)(uintptr_t)shm;
  float*wsf=(float*)(shm+LDS_WS)+wid*64;
  const bf16*ksrc=Kh+(long)lane*PQ+wid*8;
  const bf16*vsrc=Vh+(long)(16*(wid&3)+(lane>>2))*PQ+(wid>>2)*32+(lane&3)*8;
  const unsigned kdst=lds0+LDS_K+wid*1024, vdst=lds0+LDS_V+wid*1024;
  #define DMA_K(t,slot) glds16(ksrc+(long)(t)*KVBLK*PQ,(unsigned)__builtin_amdgcn_readfirstlane(kdst+(slot)))
  #define DMA_V(t,slot) glds16(vsrc+(long)(t)*KVBLK*PQ,(unsigned)__builtin_amdgcn_readfirstlane(vdst+(slot)))
  const int vb0=(int)(lds0+LDS_V)+((lane>>4)&1)*32+(lane&3)*8+(4*hi+((lane&15)>>2))*64;
  const char*Kbase=shm+LDS_K; bf16x8 kf[8];
  const lds_cptr shm3=(lds_cptr)shm; const lds_cptr kp0=shm3+LDS_K+hi*1024+r32*16; const lds_cptr vp0=shm3+LDS_V+((lane>>4)&1)*32+(lane&3)*8+(4*hi+((lane&15)>>2))*64;
  const int NT=(q0+QB)/KVBLK;
  DMA_K(0,0);DMA_V(0,0);DMA_K(1,SLOTB);
  bf16x8 qr[4];
  #pragma unroll
  for(int d0=0;d0<4;++d0)qr[d0]=*reinterpret_cast<const bf16x8*>(&Qw[(long)r32*PQ+d0*16+hi*8]);
  float mhat=0.f,l_reg=0.f;f32x16 o[2];o[0]=f32x16{};o[1]=f32x16{};f32x16 negm=f32x16{};asm volatile("":"+v"(negm));
  const int qrel=wid*QBLK+r32;
  #define CMASK(P0,P1,t) do{int jb_=(t)-(NT-4); if(jb_>=0)cmask(P0,P1,jb_,qrel,hi);}while(0)
  bool resc=false;
  #define START(P0,P1) do{ const float rm=rowmax(P0,P1); resc=false; \
    { const float dl=rm; mhat=fadd_s(mhat,dl); \
      _Pragma("unroll") for(int r=0;r<16;++r){P0[r]=fsub_s(P0[r],dl);P1[r]=fsub_s(P1[r],dl);} \
      _Pragma("unroll") for(int r=0;r<16;++r)negm[r]=-mhat; asm volatile("":"+v"(negm)); } \
    _Pragma("unroll") for(int r=0;r<16;++r)P0[r]=__builtin_amdgcn_exp2f(P0[r]); }while(0)
  #define RESC() do{ if(resc){ asm volatile("s_waitcnt lgkmcnt(0)":::"memory"); \
      _Pragma("unroll") for(int d_=0;d_<2;++d_) _Pragma("unroll") for(int r=0;r<16;++r)o[d_][r]*=wsf[crow(r,hi)]; } }while(0)
  f32x16 pA0,pA1,pB0,pB1;
  int sl_prev=0,sl_cur=0,sl_next=SLOTB;
  #define ROT() do{sl_prev=sl_cur;sl_cur=sl_next;sl_next=(sl_next==(NSLOT-1)*SLOTB)?0:sl_next+SLOTB;}while(0)
  DMA_K(2,2*SLOTB);
  WAIT_BAR(3);
  qkt(pA0,pA1,Kbase,qr,negm,r32,hi);asm volatile("s_nop 15\n\ts_nop 7":"+v"(pA0),"+v"(pA1));CMASK(pA0,pA1,0);
  START(pA0,pA1);
  _Pragma("unroll") for(int r=0;r<16;++r)pA1[r]=__builtin_amdgcn_exp2f(pA1[r]);
  WAIT_BAR(0);
  DMA_K(3,0);DMA_V(1,SLOTB);
  ROT();
  kload8(kf,kp0+sl_cur);
  WAIT_BAR(2);
  s16x4 vlo[8],vhi[8]; u32x4 pw0,pw1,pw2,pw3;
  #define PKW(P,B) cvtpk_s(P[B],P[B+1])
  #define PAF(k) __builtin_bit_cast(bf16x8,pw##k)
  #define VFR(i) (bf16x8){vlo[i][0],vlo[i][1],vlo[i][2],vlo[i][3],vhi[i][0],vhi[i][1],vhi[i][2],vhi[i][3]}
  #define PIN(x) asm volatile("":"+v"(x))
  #define MX3(a,b,c) __builtin_fmaxf(__builtin_fmaxf((a),(b)),(c))
  #define GAPA(MF,A0,A1,A2,A3,W0,W1,PW) do{ MF; sacc+=A0; sacc+=A1; sacc+=A2; sacc+=A3; PIN(sacc); W0; W1; PIN(PW); SBAR(); }while(0)
  #define EX(v) __builtin_amdgcn_exp2f(v)
  #define GAPB(MF,X,B) do{ MF; X[B]=EX(X[B]); X[B+1]=EX(X[B+1]); X[B+2]=EX(X[B+2]); X[B+3]=EX(X[B+3]); PIN(X); SBAR(); }while(0)
  #define VRD(i) do{ vlo[i]=vtr(vp_+(((i)>>2)*4096+((i)&3)*1024)); vhi[i]=vtr(vp_+(((i)>>2)*4096+((i)&3)*1024+512)); }while(0)
  #define KRD(G,j) do{ if(G){ kload2(kf,kp0+sl_next,j); SBAR(); } }while(0)
  #define STEP(C0,C1,P0,P1,t,GK,GV,GL) do{ SBAR(); \
    const lds_cptr vp_=vp0+sl_prev; \
    VRD(0); SBAR(); float sacc=(P0[0]+P0[1]); \
    GAPA(C0=__builtin_amdgcn_mfma_f32_32x32x16_bf16(kf[0],qr[0],negm,0,0,0), P0[2],P0[3],P0[4],P0[5],     pw0[0]=PKW(P0,0), pw0[1]=PKW(P0,2), pw0); \
    VRD(4); SBAR(); GAPA(C1=__builtin_amdgcn_mfma_f32_32x32x16_bf16(kf[1],qr[0],negm,0,0,0), P0[6],P0[7],P0[8],P0[9],     pw0[2]=PKW(P0,4), pw0[3]=PKW(P0,6), pw0); \
    VRD(1); SBAR(); GAPA(C0=__builtin_amdgcn_mfma_f32_32x32x16_bf16(kf[2],qr[1],C0,0,0,0),   P0[10],P0[11],P0[12],P0[13], pw1[0]=PKW(P0,8), pw1[1]=PKW(P0,10), pw1); \
    VRD(5); SBAR(); GAPA(C1=__builtin_amdgcn_mfma_f32_32x32x16_bf16(kf[3],qr[1],C1,0,0,0),   P0[14],P0[15],P1[0],P1[1],   pw1[2]=PKW(P0,12),pw1[3]=PKW(P0,14), pw1); \
    VRD(2); SBAR(); GAPA(C0=__builtin_amdgcn_mfma_f32_32x32x16_bf16(kf[4],qr[2],C0,0,0,0),   P1[2],P1[3],P1[4],P1[5],     pw2[0]=PKW(P1,0), pw2[1]=PKW(P1,2), pw2); \
    VRD(6); SBAR(); GAPA(C1=__builtin_amdgcn_mfma_f32_32x32x16_bf16(kf[5],qr[2],C1,0,0,0),   P1[6],P1[7],P1[8],P1[9],     pw2[2]=PKW(P1,4), pw2[3]=PKW(P1,6), pw2); \
    VRD(3); SBAR(); GAPA(C0=__builtin_amdgcn_mfma_f32_32x32x16_bf16(kf[6],qr[3],C0,0,0,0),   P1[10],P1[11],P1[12],P1[13], pw3[0]=PKW(P1,8), pw3[1]=PKW(P1,10), pw3); \
    VRD(7); SBAR(); GAPA(C1=__builtin_amdgcn_mfma_f32_32x32x16_bf16(kf[7],qr[3],C1,0,0,0),   P1[14],P1[15],0.f,0.f,       pw3[2]=PKW(P1,12),pw3[3]=PKW(P1,14), pw3); \
    l_reg+=sacc; \
    if(GK){DMA_K((t)+3,sl_cur);} if(GV){DMA_V((t)+1,sl_next);} \
    CMASK(C0,C1,t); \
    { float a=MX3(C0[0],C0[1],C1[0]),b=MX3(C0[2],C0[3],C1[1]); a=MX3(a,C1[2],C1[3]); \
      _Pragma("unroll") for(int r=4;r<16;r+=4){a=MX3(a,C0[r],C0[r+1]);b=MX3(b,C0[r+2],C0[r+3]);a=MX3(a,C1[r],C1[r+1]);b=MX3(b,C1[r+2],C1[r+3]);} \
      float rm=__builtin_fmaxf(a,b); { auto rr=__builtin_amdgcn_permlane32_swap(__float_as_uint(rm),__float_as_uint(rm),false,false); rm=__builtin_fmaxf(__uint_as_float(rr[0]),__uint_as_float(rr[1])); } \
      resc=false; \
      if(__builtin_expect(__any(rm>(float)THRL),0)){ const float dl=__builtin_fmaxf(rm,0.f); mhat+=dl; \
        _Pragma("unroll") for(int r=0;r<16;++r){C0[r]-=dl;C1[r]-=dl;} \
        _Pragma("unroll") for(int r=0;r<16;++r)negm[r]=-mhat; asm volatile("":"+v"(negm)); \
        const float f=__builtin_amdgcn_exp2f(-dl); l_reg*=f; if(hi==0)wsf[r32]=f; resc=true; } } \
    SBAR(); \
    GAPB(o[0]=__builtin_amdgcn_mfma_f32_32x32x16_bf16(PAF(0),VFR(0),o[0],0,0,0), C0,0); \
    GAPB(o[1]=__builtin_amdgcn_mfma_f32_32x32x16_bf16(PAF(0),VFR(4),o[1],0,0,0), C0,4); \
    KRD(GL,0); GAPB(o[0]=__builtin_amdgcn_mfma_f32_32x32x16_bf16(PAF(1),VFR(1),o[0],0,0,0), C0,8); \
    KRD(GL,1); GAPB(o[1]=__builtin_amdgcn_mfma_f32_32x32x16_bf16(PAF(1),VFR(5),o[1],0,0,0), C0,12); \
    KRD(GL,2); GAPB(o[0]=__builtin_amdgcn_mfma_f32_32x32x16_bf16(PAF(2),VFR(2),o[0],0,0,0), C1,0); \
    KRD(GL,3); GAPB(o[1]=__builtin_amdgcn_mfma_f32_32x32x16_bf16(PAF(2),VFR(6),o[1],0,0,0), C1,4); \
    GAPB(o[0]=__builtin_amdgcn_mfma_f32_32x32x16_bf16(PAF(3),VFR(3),o[0],0,0,0), C1,8); \
    GAPB(o[1]=__builtin_amdgcn_mfma_f32_32x32x16_bf16(PAF(3),VFR(7),o[1],0,0,0), C1,12); \
    }while(0)
  int t=1;
  #undef CMASK
  #define CMASK(P0,P1,t) do{}while(0)
  for(;t+5<NT;t+=2){
    STEP(pB0,pB1,pA0,pA1,t,true,true,true);     WAIT_BAR(2); RESC(); ROT();
    STEP(pA0,pA1,pB0,pB1,t+1,true,true,true);   WAIT_BAR(2); RESC(); ROT();
  }
  #undef CMASK
  #define CMASK(P0,P1,t) do{int jb_=(t)-(NT-4); if(jb_>=0)cmask(P0,P1,jb_,qrel,hi);}while(0)
  #define ENDW(tt) do{ if((tt)+3<NT){WAIT_BAR(2);} else if((tt)+2<NT){WAIT_BAR(1);} else {WAIT_BAR(0);} }while(0)
  for(;t+1<NT;t+=2){
    STEP(pB0,pB1,pA0,pA1,t,(t+3<NT),(t+1<NT),(t+1<NT));       ENDW(t);   RESC(); ROT();
    STEP(pA0,pA1,pB0,pB1,t+1,(t+4<NT),(t+2<NT),(t+2<NT));     ENDW(t+1); RESC(); ROT();
  }
  STEP(pB0,pB1,pA0,pA1,NT-1,false,false,false); RESC();
  { float sacc=pB0[0]+pB0[1]; _Pragma("unroll") for(int r=2;r<16;++r)sacc+=pB0[r]; _Pragma("unroll") for(int r=0;r<16;++r)sacc+=pB1[r]; l_reg+=sacc;
    pw0=(u32x4){PKW(pB0,0),PKW(pB0,2),PKW(pB0,4),PKW(pB0,6)};pw1=(u32x4){PKW(pB0,8),PKW(pB0,10),PKW(pB0,12),PKW(pB0,14)};pw2=(u32x4){PKW(pB1,0),PKW(pB1,2),PKW(pB1,4),PKW(pB1,6)};pw3=(u32x4){PKW(pB1,8),PKW(pB1,10),PKW(pB1,12),PKW(pB1,14)};
    SBAR(); pv(o,vb0+sl_cur,PAF(0),PAF(1),PAF(2),PAF(3)); }
  #undef PKW
  #undef PAF
  #undef VFR
  #undef PIN
  #undef MX3
  #undef GAPA
  #undef GAPB
  #undef EX
  #undef VRD
  #undef KRD
  #undef STEP
  #undef ENDW
  {auto rr=__builtin_amdgcn_permlane32_swap(__float_as_uint(l_reg),__float_as_uint(l_reg),false,false);l_reg=__uint_as_float(rr[0])+__uint_as_float(rr[1]);}
  if(hi==0)wsf[32+r32]=l_reg;asm volatile("s_waitcnt lgkmcnt(0)":::"memory");
  float rli[16];
  #pragma unroll
  for(int r=0;r<16;++r)rli[r]=__builtin_amdgcn_rcpf(wsf[32+crow(r,hi)]);
  bf16*Ow=O+(rowbase+q0+wid*QBLK)*PO+h*D;
  { bf16*stg=(bf16*)(shm+LDS_OST)+wid*2048;
    #pragma unroll
    for(int r=0;r<16;++r){const int orow=crow(r,hi);
      #pragma unroll
      for(int d0=0;d0<2;++d0)stg[orow*64+d0*32+r32]=__float2bfloat16(o[d0][r]*rli[r]);}
    asm volatile("s_waitcnt lgkmcnt(0)":::"memory");
    #pragma unroll
    for(int i=0;i<4;++i){const int row=i*8+(lane>>3),ch=lane&7; const u32x4 v=*(const u32x4*)(stg+row*64+ch*8); ATTN_STORE16(Ow+(long)row*PO+ch*8,v);} }
  asm volatile("s_waitcnt lgkmcnt(0)\n\ts_barrier":::"memory");
  #undef DMA_K
  #undef DMA_V
  #undef CMASK
  #undef START
  #undef RESC
  #undef ROT
}
constexpr int ATTN_LDS_BYTES=LDS_BYTES;
#undef SBAR
#undef WAIT_BAR
}

#define XB_TMO      128
#define XB_XCNT(j)  (256  + 64 * (j))
#define XB_XSUB(j)  (1280 + 64 * (j))
#define XB_XGEN(j)  (2304 + 64 * (j))
#define XB_TOP      3328
#define XB_TOPGEN   3392
#define XCD_BAR_WORDS 3456
#define XB_SPIN_CAP (1u << 18)

__device__ __forceinline__ unsigned xb_ld(unsigned* p)              { return __hip_atomic_load(p, __ATOMIC_RELAXED, __HIP_MEMORY_SCOPE_AGENT); }
__device__ __forceinline__ unsigned xb_add(unsigned* p, unsigned v) { return __hip_atomic_fetch_add(p, v, __ATOMIC_RELAXED, __HIP_MEMORY_SCOPE_AGENT); }
__device__ __forceinline__ unsigned xb_xcc_id() { unsigned r; asm volatile("s_getreg_b32 %0, hwreg(20, 0, 4)" : "=s"(r)); r &= 0xFu; asm volatile("" : "+v"(r)); return r; }
#define XB_SPIN(cond, bar) do { unsigned _sp = 0; while (cond) { __builtin_amdgcn_s_sleep(1); \
    if ((++_sp & 255u) == 0u) { if (xb_ld(&(bar)[XB_TMO])) break; if (_sp > XB_SPIN_CAP) { atomicAdd(&(bar)[XB_TMO], 1u); break; } } } } while (0)

struct XcdBarrier {
    unsigned* bar; unsigned x;
    volatile LAS unsigned* st;
};

__device__ __forceinline__ XcdBarrier xcd_barrier_post(unsigned* bar, volatile LAS unsigned* st, int tid) {
    XcdBarrier b; b.bar = bar; b.x = xb_xcc_id(); b.st = st;
    if (tid == 0) (void)xb_add(&bar[XB_XCNT(b.x)], 1u);
    return b;
}
__device__ __forceinline__ void xcd_barrier_complete(unsigned* bar, unsigned x, unsigned& nloc, unsigned& nx) {
    const unsigned G = gridDim.x * gridDim.y * gridDim.z;
    unsigned sum, cnt, mine, sp = 0u;
    for (;;) {
        sum = 0u; cnt = 0u; mine = 0u;
#pragma unroll
        for (unsigned j = 0; j < 16; ++j) { const unsigned c = xb_ld(&bar[XB_XCNT(j)]); sum += c; cnt += (c > 0u) ? 1u : 0u; mine = (j == x) ? c : mine; }
        if (sum == G) break;
        __builtin_amdgcn_s_sleep(1);
        if ((++sp & 255u) == 0u) { if (xb_ld(&bar[XB_TMO])) break; if (sp > XB_SPIN_CAP) { atomicAdd(&bar[XB_TMO], 1u); break; } }
    }
    nloc = mine > 0u ? mine : 1u; nx = cnt > 0u ? cnt : 1u;
}

__device__ __forceinline__ void xcd_barrier(const XcdBarrier& b, int tid) {
    asm volatile("s_waitcnt vmcnt(0)" ::: "memory");
    __syncthreads();
    if (tid == 0) {
        unsigned* bar = b.bar;
        __builtin_amdgcn_s_waitcnt(0);
        unsigned nloc = b.st[0], nx = b.st[1];
        if (nloc == 0u) { xcd_barrier_complete(bar, b.x, nloc, nx); b.st[0] = nloc; b.st[1] = nx; }
        const unsigned old = xb_add(&bar[XB_XSUB(b.x)], 1u);
        const unsigned gen = old / nloc;
        if (old + 1u == (gen + 1u) * nloc) {
            __builtin_amdgcn_fence(__ATOMIC_RELEASE, "agent");
            asm volatile("s_waitcnt vmcnt(0)" ::: "memory");
            const unsigned og = xb_add(&bar[XB_TOP], 1u);
            const unsigned tg = og / nx;
            if (og + 1u == (tg + 1u) * nx) xb_add(&bar[XB_TOPGEN], 1u);
            else XB_SPIN(xb_ld(&bar[XB_TOPGEN]) == tg, bar);
            __builtin_amdgcn_fence(__ATOMIC_ACQUIRE, "agent");
            xb_add(&bar[XB_XGEN(b.x)], 1u);
            asm volatile("s_waitcnt vmcnt(0)" ::: "memory");
        } else {
            XB_SPIN(xb_ld(&bar[XB_XGEN(b.x)]) == gen, bar);
            __builtin_amdgcn_fence(__ATOMIC_ACQUIRE, "agent");
            asm volatile("s_waitcnt vmcnt(0)" ::: "memory");
        }
    }
    __syncthreads();
}


namespace mk {
struct Params { const float* in[32]; float* out; unsigned char* ws; };
enum { I_X = 0, I_MEM, I_NMIX, I_WIN, I_WOUT, I_QG, I_KG, I_LQ1, I_LK1, I_LQ2, I_LK2, I_SUBG, I_SCW, I_SCB, I_SDTB, I_SALOG, I_SD, I_SNG,
       I_GCW, I_GALOG, I_GDTB, I_GNG, I_NX, I_NMEM, I_WCQ, I_WCKV, I_XQG, I_XKG, I_WCO, I_NFFN, I_WGU, I_WDN };
#define GAS __attribute__((address_space(1)))
__device__ __forceinline__ const float* pin(const Params& p, int i) { asm volatile("" : "+s"(i)); const GAS float* w = (const GAS float*)p.in[i]; asm volatile("" : "+s"(w)); return (const float*)w; }
__device__ __forceinline__ unsigned char* wsp(const Params& p) { GAS unsigned char* w = (GAS unsigned char*)p.ws; asm volatile("" : "+s"(w)); return (unsigned char*)w; }
__device__ __forceinline__ float* outp(const Params& p) { GAS float* w = (GAS float*)p.out; asm volatile("" : "+s"(w)); return (float*)w; }
constexpr size_t MiB = 1u << 20;
constexpr size_t WS_CTL = 0, CTL_BYTES = 64 * 1024;
constexpr size_t WS_SS = 128 * 1024;
constexpr size_t WS_WIN = 1 * MiB, WS_WOUT = 9 * MiB, WS_WCQ = 11 * MiB, WS_WCO = 13 * MiB, WS_WGU = 15 * MiB, WS_WDN = 26 * MiB;
constexpr size_t WS_WCKV = 32 * MiB;
constexpr size_t WS_MEMN = 48 * MiB;
constexpr size_t WS_KN = 56 * MiB;
constexpr size_t WS_VT = 64 * MiB;
constexpr size_t WS_H = 72 * MiB;
constexpr size_t WS_SM = 104 * MiB;
constexpr size_t WS_PROJ = 106 * MiB;
constexpr size_t WS_AO = 218 * MiB;
constexpr size_t WS_CAT = 250 * MiB;
constexpr size_t WS_YS = 282 * MiB;
constexpr size_t WS_ST = 298 * MiB;
constexpr size_t WS_HP = 314 * MiB;
constexpr size_t WS_CM = 322 * MiB;
constexpr size_t WS_EA = 330 * MiB;
constexpr size_t WS_OG = 331 * MiB;
constexpr size_t WS_SSP = 347 * MiB;
constexpr size_t WS_END = 352 * MiB;
__device__ __forceinline__ size_t woff(int which, int par) {
    if (par == 0) return which == 0 ? WS_WIN : which == 1 ? WS_WOUT : which == 2 ? WS_WCQ : which == 3 ? WS_WCO : WS_WGU;
    return which == 0 ? 32 * MiB : which == 1 ? 39 * MiB + MiB / 2 : which == 2 ? 41 * MiB + MiB / 2 : which == 3 ? 350 * MiB : 43 * MiB + MiB / 2;
}
constexpr size_t GO_W = 0, GO_QG = 8 * MiB, GO_ATT = 16 * MiB, GO_KGT = 24 * MiB;
constexpr size_t WS_GU = WS_CAT;
constexpr int LDS_BYTES = 160 * 1024;
constexpr int LDS_SLOT = LDS_BYTES - 256;

__device__ __forceinline__ void lds_wait() { asm volatile("s_waitcnt lgkmcnt(0)" ::: "memory"); }

#define TSW(n, t) ((n) * 136 + (((((t) >> 3) ^ (((n) >> 3) & 7))) << 3) + ((t) & 7))
template <int M, int N, int K, bool SWA = false, bool SWB = false, class Epi>
__device__ __forceinline__ void mm16(const LAS bf16_t* A, int lda, const LAS bf16_t* Bt, int ldb, int wid, int lane, Epi epi) {
    const int fr = lane & 15, fq = lane >> 4;
    constexpr int NB = N / 16, NBLK = (M / 16) * NB;
    for (int blk = wid; blk < NBLK; blk += 8) {
        const int mb = blk / NB, nb = blk % NB;
        f32x4 acc = {0.f, 0.f, 0.f, 0.f};
        const int ra = mb * 16 + fr, rb = nb * 16 + fr;
        const LAS bf16_t* ap = A + ra * lda; const LAS bf16_t* bp = Bt + rb * ldb;
        const int sa = SWA ? ((ra >> 3) & 7) : 0, sb = SWB ? ((rb >> 3) & 7) : 0;
#pragma unroll
        for (int k0 = 0; k0 < K; k0 += 32) acc = __builtin_amdgcn_mfma_f32_16x16x32_bf16(*(const LAS bf16x8*)(ap + ((((k0 >> 3) + fq) ^ sa) << 3)), *(const LAS bf16x8*)(bp + ((((k0 >> 3) + fq) ^ sb) << 3)), acc, 0, 0, 0);
#pragma unroll
        for (int i = 0; i < 4; ++i) epi(mb * 16 + fq * 4 + i, nb * 16 + fr, acc[i]);
    }
}

template <int M, int N, int K, bool SWA = false, bool SWB = false, class Epi>
__device__ __forceinline__ void mm16v(const LAS bf16_t* A, int lda, const LAS bf16_t* Bt, int ldb, int wid, int lane, Epi epi) {
    const int fr = lane & 15, fq = lane >> 4;
    constexpr int NB = N / 16, NBLK = (M / 16) * NB;
    for (int blk = wid; blk < NBLK; blk += 8) {
        const int mb = blk / NB, nb = blk % NB;
        f32x4 acc = {0.f, 0.f, 0.f, 0.f};
        const int ra = mb * 16 + fr, rb = nb * 16 + fr;
        const LAS bf16_t* ap = A + ra * lda; const LAS bf16_t* bp = Bt + rb * ldb;
        const int sa = SWA ? ((ra >> 3) & 7) : 0, sb = SWB ? ((rb >> 3) & 7) : 0;
#pragma unroll
        for (int k0 = 0; k0 < K; k0 += 32) acc = __builtin_amdgcn_mfma_f32_16x16x32_bf16(*(const LAS bf16x8*)(ap + ((((k0 >> 3) + fq) ^ sa) << 3)), *(const LAS bf16x8*)(bp + ((((k0 >> 3) + fq) ^ sb) << 3)), acc, 0, 0, 0);
        epi(mb * 16 + fq * 4, nb * 16 + fr, acc);
    }
}

__device__ __forceinline__ int maprow(int mode, int n) {
    if (mode == 0) return n;
    if (mode == 1) { if (n >= 2560 && n < 2564) return 3584 + (n - 2560); if (n >= 3588) return 3588 + (n - 3588); const int c = n < 2560 ? n : n - 4; const int cl = c & 255; return (c & ~255) + 128 * ((cl >> 5) & 1) + 32 * (cl >> 6) + (cl & 31); }
    if (n < D_FF) return (n >> 7) * 256 + (n & 127);
    const int n2 = n - D_FF; return (n2 >> 7) * 256 + 128 + (n2 & 127);
}
__device__ __forceinline__ void transpose_item(const float* W, int K, int N, bf16_t* WT, int mode, LAS float* scr, int item, int lane, const float* gk = nullptr) {
    const int nblk = (N + 63) / 64, kb = item / nblk, nb = item % nblk, k0 = 64 * kb, n0 = 64 * nb;
    const int nq = (lane & 15) * 4; const bool okn = n0 + nq < N;
    f32x4 v[16];
#pragma unroll
    for (int i = 0; i < 16; ++i) { const int kk = 4 * i + (lane >> 4); v[i] = okn ? *(const f32x4*)(W + (size_t)(k0 + kk) * N + n0 + nq) : (f32x4){0.f, 0.f, 0.f, 0.f}; if (gk) v[i] = v[i] * gk[k0 + kk]; }
#pragma unroll
    for (int i = 0; i < 16; ++i) { const int kk = 4 * i + (lane >> 4);
#pragma unroll
        for (int q = 0; q < 4; ++q) scr[kk * 65 + nq + q] = v[i][q]; }
    lds_wait(); asm volatile("" ::: "memory");
    const int c = lane & 7;
#pragma unroll
    for (int j = 0; j < 8; ++j) { const int nn = (lane >> 3) + 8 * j; const int n = n0 + nn; const int row = n < N ? maprow(mode, n) : -1; const LAS float* s = scr + (8 * c) * 65 + nn;
        u32x4 o; o.x = pk2(s[0 * 65], s[1 * 65]); o.y = pk2(s[2 * 65], s[3 * 65]); o.z = pk2(s[4 * 65], s[5 * 65]); o.w = pk2(s[6 * 65], s[7 * 65]);
        if (row >= 0) *(u32x4*)(WT + (size_t)row * K + k0 + 8 * c) = o; }
    lds_wait(); asm volatile("" ::: "memory");
}
__device__ __forceinline__ void norm_row(const float* xrow, const float* g, bf16_t* orow, int lane, f32x4 (&y)[4]) {
    const f32x4* xr = (const f32x4*)xrow + lane; const f32x4* gr = (const f32x4*)g + lane;
    float s = 0.f;
#pragma unroll
    for (int j = 0; j < 4; ++j) { y[j] = xr[64 * j]; s += dot4v(y[j]); }
    const float rstd = rsqrtf(wave_sum(s, lane) * (1.f / DM) + NORM_EPS);
    unsigned long long* o8 = (unsigned long long*)orow + lane;
#pragma unroll
    for (int j = 0; j < 4; ++j) { y[j] = y[j] * rstd * gr[64 * j]; o8[64 * j] = (unsigned long long)pk2(y[j][0], y[j][1]) | ((unsigned long long)pk2(y[j][2], y[j][3]) << 32); }
}

constexpr int CI_IN = 16 * 57, CI_SQ = 16 * 16, CI_GU = 16 * 88, CI_DN = 44 * 16, CI_MAIN = CI_IN + 3 * CI_SQ + CI_GU;
__device__ __forceinline__ void conv_item_main(const Params& p, unsigned char* ws, int l, int r, LAS float* scr, int lane) {
    const int par = l & 1;
    if (r < CI_IN) { transpose_item(pin(p, I_WIN) + (size_t)l * DM * P_IN, DM, P_IN, (bf16_t*)(ws + woff(0, par)), 1, scr, r, lane, pin(p, I_NMIX) + l * DM); return; } r -= CI_IN;
    if (r < CI_SQ) { transpose_item(pin(p, I_WOUT) + (size_t)l * DM * DM, DM, DM, (bf16_t*)(ws + woff(1, par)), 0, scr, r, lane); return; } r -= CI_SQ;
    if (r < CI_SQ) { transpose_item(pin(p, I_WCQ) + (size_t)l * DM * DM, DM, DM, (bf16_t*)(ws + woff(2, par)), 0, scr, r, lane, pin(p, I_NX) + l * DM); return; } r -= CI_SQ;
    if (r < CI_SQ) { transpose_item(pin(p, I_WCO) + (size_t)l * DM * DM, DM, DM, (bf16_t*)(ws + woff(3, par)), 0, scr, r, lane); return; } r -= CI_SQ;
    transpose_item(pin(p, I_WGU) + (size_t)l * DM * 2 * D_FF, DM, 2 * D_FF, (bf16_t*)(ws + woff(4, par)), 2, scr, r, lane, pin(p, I_NFFN) + l * DM);
}
__device__ __forceinline__ void conv_item_dn(const Params& p, unsigned char* ws, int l, int r, LAS float* scr, int lane) {
    transpose_item(pin(p, I_WDN) + (size_t)l * D_FF * DM, D_FF, DM, (bf16_t*)(ws + WS_WDN), 0, scr, r, lane);
}
__device__ __forceinline__ void conv_unit(const Params& p, int l, int cu, bool dn, LAS unsigned char* lds, int lane, int wid) {
    asm volatile("" : "+v"(lds)); asm volatile("" : "+v"(lane));
    unsigned char* ws = wsp(p); LAS float* scr = (LAS float*)(lds + wid * 16896); const int item = cu * 8 + wid;
    if (dn) { if (item < CI_DN) conv_item_dn(p, ws, l, item, scr, lane); } else { if (item < CI_MAIN) conv_item_main(p, ws, l, item, scr, lane); }
}
__device__ __forceinline__ void phase_a(const Params& p, int l, LAS unsigned char* lds, int tid, int lane, int wid) {
    asm volatile("" : "+v"(lds));
    unsigned char* ws = p.ws;
    const int gw = blockIdx.x * 8 + wid, NGW = gridDim.x * 8;
    LAS float* scr = (LAS float*)(lds + wid * 16896);
    {
        for (int it = gw; it < CI_MAIN + CI_DN; it += NGW) { if (it < CI_MAIN) conv_item_main(p, ws, l, it, scr, lane); else conv_item_dn(p, ws, l, it - CI_MAIN, scr, lane); }
        if (l == 0) {
            for (int it = gw; it < 4 * 512; it += NGW) { const int ll = it >> 9;
                transpose_item(pin(p, I_WCKV) + (size_t)ll * DM * 2048, DM, 2048, (bf16_t*)(ws + WS_WCKV) + (size_t)ll * 2048 * DM, 0, scr, it & 511, lane); }
            for (int m = gw; m < 4 * NMEM; m += NGW) { const int ll = m >> 10, r = m & 1023; f32x4 y[4];
                norm_row(pin(p, I_MEM) + (size_t)r * DM, pin(p, I_NMEM) + ll * DM, (bf16_t*)(ws + WS_MEMN) + (size_t)m * DM, lane, y); }
        }
    }
    if (l == 0) {
        const float* xin = pin(p, I_X); bf16_t* H = (bf16_t*)(ws + WS_H); float* SS = (float*)(ws + WS_SSP);
        for (int m = gw; m < MTOK; m += NGW) {
            const f32x4* xr = (const f32x4*)(xin + (size_t)m * DM) + lane; unsigned long long* o8 = (unsigned long long*)(H + (size_t)m * DM) + lane;
            float sq = 0.f;
#pragma unroll
            for (int j = 0; j < 4; ++j) { const f32x4 v = xr[64 * j]; sq += dot4v(v); o8[64 * j] = (unsigned long long)pk2(v[0], v[1]) | ((unsigned long long)pk2(v[2], v[3]) << 32); }
            sq = wave_sum(sq, lane);
            if (lane < 16) SS[(size_t)m * 16 + lane] = lane == 0 ? sq : 0.f;
        }
    }
}
__device__ __forceinline__ void phase_norm(const Params& p, const float* g, int lane, int wid) {
    const int gw = blockIdx.x * 8 + wid, NGW = gridDim.x * 8;
    bf16_t* H = (bf16_t*)(wsp(p) + WS_H);
    for (int m = gw; m < MTOK; m += NGW) { f32x4 y[4]; norm_row(outp(p) + (size_t)m * DM, g, H + (size_t)m * DM, lane, y); }
}

__device__ __forceinline__ void unpack8(u32x4 v, float (&f)[8]) {
#pragma unroll
    for (int i = 0; i < 4; ++i) { f[2 * i] = __builtin_bit_cast(float, v[i] << 16); f[2 * i + 1] = __builtin_bit_cast(float, v[i] & 0xffff0000u); }
}

__device__ __forceinline__ void ssd_prep_unit(const Params& p, int l, int unit, LAS unsigned char* lds, int tid, int lane, int wid) {
    asm volatile("" : "+v"(lds));
    unsigned char* ws = wsp(p);
    const int h = unit & 3, c = (unit >> 2) & 31, b = unit >> 7, g = h >> 1;
    const int tok0 = b * SEQ + c * 128;
    const bf16_t* PROJ = (const bf16_t*)(ws + WS_PROJ); const float* SM = (const float*)(ws + WS_SM);
    LAS bf16_t* Cm = (LAS bf16_t*)(lds); LAS bf16_t* Bm = (LAS bf16_t*)(lds + 34816); LAS bf16_t* BmT = (LAS bf16_t*)(lds + 69632);
    LAS bf16_t* XSt = (LAS bf16_t*)(lds + 104448); LAS bf16_t* XDt = (LAS bf16_t*)(lds + 121856);
    LAS float* dtv = (LAS float*)(lds + 139264); LAS float* acum = (LAS float*)(lds + 139264 + 512);
    const float a_neg = -__expf(pin(p, I_SALOG)[l * 4 + h]);
    if (tid < 128) dtv[tid] = softplus_f(SM[(size_t)(tok0 + tid) * 12 + h] + pin(p, I_SDTB)[l * 4 + h]);
    __syncthreads();
    if (wid == 0) { const float s0 = wave_incl_scan(dtv[lane] * a_neg, lane); const float tot = __builtin_bit_cast(float, __builtin_amdgcn_readlane(__builtin_bit_cast(int, s0), 63)); const float s1 = wave_incl_scan(dtv[lane + 64] * a_neg, lane) + tot; acum[lane] = s0; acum[lane + 64] = s1; }
    __syncthreads();
    if (tid < 320) {
        const int o = tid % 40, tg = tid / 40;
        int ch; if (o < 8) ch = h * 64 + o * 8; else if (o < 24) ch = 256 + g * 128 + (o - 8) * 8; else ch = 512 + g * 128 + (o - 24) * 8;
        const float* cw = pin(p, I_SCW) + (size_t)l * 4 * 768 + ch; const float* cb = pin(p, I_SCB) + (size_t)l * 768 + ch;
        float w0[8], w1[8], w2[8], w3[8], bs[8];
#pragma unroll
        for (int j = 0; j < 8; ++j) { w0[j] = cw[j]; w1[j] = cw[768 + j]; w2[j] = cw[2 * 768 + j]; w3[j] = cw[3 * 768 + j]; bs[j] = cb[j]; }
        const bf16_t* src = PROJ + (size_t)tok0 * PN + 1792 + ch;
        int t0 = tg * 16; asm volatile("" : "+v"(t0));
        const int sp = c * 128 + t0;
        const bf16_t* rp = src + (ptrdiff_t)(t0 - 3) * PN;
        u32x4 raw[19];
#pragma unroll
        for (int r = 0; r < 19; ++r) { const bool ok = (r >= 3) || (sp + r - 3 >= 0); raw[r] = *(const u32x4*)(ok ? rp + (size_t)r * PN : src); if (!ok) raw[r] = (u32x4){0u, 0u, 0u, 0u}; }
        float x0[8], x1[8], x2[8], cur[8];
        unpack8(raw[0], x0); unpack8(raw[1], x1); unpack8(raw[2], x2);
        const float alast = acum[127];
#pragma unroll
        for (int tt = 0; tt < 16; ++tt) {
            const int t = t0 + tt;
            unpack8(raw[tt + 3], cur);
            float v[8];
#pragma unroll
            for (int j = 0; j < 8; ++j) { const float a = bs[j] + ((w0[j] * x0[j] + w1[j] * x1[j]) + (w2[j] * x2[j] + w3[j] * cur[j])); v[j] = silu_f(a); x0[j] = x1[j]; x1[j] = x2[j]; x2[j] = cur[j]; }
            if (o < 8) {
                const float sc = dtv[t] * __expf(alast - acum[t]);
#pragma unroll
                for (int j = 0; j < 8; ++j) { XSt[TSW(o * 8 + j, t)] = (bf16_t)f2bf(v[j]); XDt[TSW(o * 8 + j, t)] = (bf16_t)f2bf(v[j] * sc); }
            } else {
                u32x4 pk; pk.x = pk2(v[0], v[1]); pk.y = pk2(v[2], v[3]); pk.z = pk2(v[4], v[5]); pk.w = pk2(v[6], v[7]);
                if (o < 24) { const int n0 = (o - 8) * 8; *(LAS u32x4*)(Bm + t * 136 + n0) = pk;
#pragma unroll
                    for (int j = 0; j < 8; ++j) BmT[TSW(n0 + j, t)] = (bf16_t)f2bf(v[j]);
                } else { const int n0 = (o - 24) * 8; *(LAS u32x4*)(Cm + t * 136 + n0) = pk;
                    if ((h & 1) == 0) *(u32x4*)((bf16_t*)(ws + WS_CM) + (size_t)(tok0 + t) * 256 + g * 128 + n0) = pk; }
            }
        }
    }
    __syncthreads();
    {
        float* ST = (float*)(ws + WS_ST) + (size_t)unit * 8192;
        mm16v<128, 64, 128, true, true>(BmT, 136, XDt, 136, wid, lane, [&](int n0, int pp, f32x4 v) { *(f32x4*)(ST + pp * 128 + n0) = v; });
    }
    __syncthreads();
    {
        LAS bf16_t* Sc = BmT;
        mm16<128, 128, 128>(Cm, 136, Bm, 136, wid, lane, [&](int li, int s, float v) { Sc[li * 136 + s] = (li >= s) ? (bf16_t)f2bf(v * __expf(acum[li] - acum[s]) * dtv[s]) : (bf16_t)0; });
    }
    __syncthreads();
    {
        const float Dh = pin(p, I_SD)[l * 4 + h];
        float* Y = (float*)(ws + WS_YS);
        mm16v<64, 128, 128, true, false>(XSt, 136, BmT, 136, wid, lane, [&](int p0, int li, f32x4 v) {
#pragma unroll
            for (int i = 0; i < 4; ++i) v[i] += Dh * bf2f(XSt[TSW(p0 + i, li)]);
            *(f32x4*)(Y + (size_t)(tok0 + li) * 256 + h * 64 + p0) = v; });
        if (tid < 128) ((float*)(ws + WS_EA))[(size_t)(tok0 + tid) * 4 + h] = __expf(acum[tid]);
        if (tid == 0) ((float*)(ws + WS_EA + 512 * 1024))[unit] = __expf(acum[127]);
    }
    __syncthreads();
}
__device__ __forceinline__ void ssd_scan_unit(const Params& p, int su, int tid) {
    asm volatile("" : "+v"(tid));
    unsigned char* ws = wsp(p); const int b = su >> 2, h = su & 3;
    f32x4 hs[4];
#pragma unroll
    for (int j = 0; j < 4; ++j) hs[j] = (f32x4){0.f, 0.f, 0.f, 0.f};
    const float* DEC = (const float*)(ws + WS_EA + 512 * 1024);
    for (int c = 0; c < 32; ++c) {
        const int unit = (b * 32 + c) * 4 + h;
        const float* src = (const float*)(ws + WS_ST) + (size_t)unit * 8192; bf16_t* dst = (bf16_t*)(ws + WS_HP) + (size_t)unit * 8192;
        const float dec = DEC[unit];
#pragma unroll
        for (int j = 0; j < 4; ++j) { const int e = (tid + 512 * j) * 4; u32x2 w; w.x = pk2(hs[j][0], hs[j][1]); w.y = pk2(hs[j][2], hs[j][3]); *(u32x2*)(dst + e) = w; hs[j] = hs[j] * dec + *(const f32x4*)(src + e); }
    }
}

__device__ __forceinline__ void gdn_prep_unit(const Params& p, int l, int gu, LAS unsigned char* lds, int tid, int lane, int wid) {
    asm volatile("" : "+v"(lds));
    unsigned char* ws = wsp(p);
    const int c = gu & 63, h = (gu >> 6) & 3, b = gu >> 8;
    unsigned char* gob = (unsigned char*)outp(p);
    const int tok0 = b * SEQ + c * 64;
    const bf16_t* PROJ = (const bf16_t*)(ws + WS_PROJ); const float* SM = (const float*)(ws + WS_SM);
    LAS float* QKVf = (LAS float*)lds;
    LAS bf16_t* Qs = (LAS bf16_t*)(lds + 49408); LAS bf16_t* Ks = (LAS bf16_t*)(lds + 58624);
    LAS float* Tm = (LAS float*)(lds + 67840);
    LAS float* RHS = (LAS float*)(lds + 85248);
    LAS float* betas = (LAS float*)(lds + 119040); LAS float* gcs = (LAS float*)(lds + 119296);
    if (tid < 64) {
        const float braw = SM[(size_t)(tok0 + tid) * 12 + 4 + h], araw = SM[(size_t)(tok0 + tid) * 12 + 8 + h];
        betas[tid] = sigmoid_f(braw);
        const float gl = -__expf(pin(p, I_GALOG)[l * 4 + h]) * softplus_f(araw + pin(p, I_GDTB)[l * 4 + h]);
        gcs[tid] = wave_incl_scan(gl, lane);
    }
    if (tid < 384) {
        const int o = tid % 24, tg = tid / 24;
        const int ch = (o >> 3) * 256 + h * 64 + (o & 7) * 8;
        const float* cw = pin(p, I_GCW) + (size_t)l * 4 * 768 + ch;
        float w0[8], w1[8], w2[8], w3[8];
#pragma unroll
        for (int j = 0; j < 8; ++j) { w0[j] = cw[j]; w1[j] = cw[768 + j]; w2[j] = cw[2 * 768 + j]; w3[j] = cw[3 * 768 + j]; }
        const bf16_t* src = PROJ + (size_t)tok0 * PN + 2560 + ch;
        int t0 = tg * 4; asm volatile("" : "+v"(t0));
        const int sp = c * 64 + t0;
        const bf16_t* rp = src + (ptrdiff_t)(t0 - 3) * PN;
        u32x4 raw[7];
#pragma unroll
        for (int r = 0; r < 7; ++r) { const bool ok = (r >= 3) || (sp + r - 3 >= 0); raw[r] = *(const u32x4*)(ok ? rp + (size_t)r * PN : src); if (!ok) raw[r] = (u32x4){0u, 0u, 0u, 0u}; }
        float x0[8], x1[8], x2[8], cur[8];
        unpack8(raw[0], x0); unpack8(raw[1], x1); unpack8(raw[2], x2);
#pragma unroll
        for (int tt = 0; tt < 4; ++tt) {
            const int t = t0 + tt;
            unpack8(raw[tt + 3], cur);
#pragma unroll
            for (int j = 0; j < 8; ++j) { const float a = (w0[j] * x0[j] + w1[j] * x1[j]) + (w2[j] * x2[j] + w3[j] * cur[j]); QKVf[t * 193 + o * 8 + j] = silu_f(a); x0[j] = x1[j]; x1[j] = x2[j]; x2[j] = cur[j]; }
        }
    }
    __syncthreads();
    LAS bf16_t* KT = (LAS bf16_t*)(lds + 120320);
    {
        const int t = tid >> 3, which = (tid >> 2) & 1, q4 = tid & 3;
        const LAS float* row = QKVf + t * 193 + which * 64 + q4 * 16;
        float e[16]; float ss = 0.f;
#pragma unroll
        for (int d = 0; d < 16; ++d) { e[d] = row[d]; ss += e[d] * e[d]; }
        ss += dpp_f<0xB1>(ss); ss += dpp_f<0x4E>(ss);
        const float rinv = rsqrtf(ss + 1e-6f);
        const float gct = gcs[t];
        if (which == 0) {
            const float sc = rinv * 0.125f, eg = __expf(gct);
            u32x4 g0, g1;
#pragma unroll
            for (int d = 0; d < 16; d += 2) { const float v0 = e[d] * sc, v1 = e[d + 1] * sc; *(LAS unsigned*)(Qs + t * 72 + q4 * 16 + d) = pk2(v0, v1); const unsigned w = pk2(v0 * eg, v1 * eg); if (d < 8) g0[d >> 1] = w; else g1[(d - 8) >> 1] = w; }
            bf16_t* QG = (bf16_t*)(gob + GO_QG) + (size_t)gu * 4096 + t * 64 + q4 * 16;
            *(u32x4*)QG = g0; *(u32x4*)(QG + 8) = g1;
        } else {
            const float bt = betas[t] * __expf(gct), ek = __expf(gcs[63] - gct);
#pragma unroll
            for (int d = 0; d < 16; d += 2) { const float v0 = e[d] * rinv, v1 = e[d + 1] * rinv; *(LAS unsigned*)(Ks + t * 72 + q4 * 16 + d) = pk2(v0, v1);
                KT[(q4 * 16 + d) * 72 + t] = (bf16_t)f2bf(v0 * ek); KT[(q4 * 16 + d + 1) * 72 + t] = (bf16_t)f2bf(v1 * ek); }
#pragma unroll
            for (int d = 0; d < 16; d += 4) *(LAS f32x4*)(RHS + t * 132 + 64 + q4 * 16 + d) = (f32x4){e[d] * rinv * bt, e[d + 1] * rinv * bt, e[d + 2] * rinv * bt, e[d + 3] * rinv * bt};
        }
    }
    for (int idx = tid; idx < 4096; idx += 512) { const int t = idx >> 6, d = idx & 63; RHS[t * 132 + d] = QKVf[t * 193 + 128 + d] * betas[t]; }
    __syncthreads();
    { const int r = tid >> 3, c8 = (tid & 7) * 8; *(u32x4*)((bf16_t*)(gob + GO_KGT) + (size_t)gu * 4096 + r * 64 + c8) = *(const LAS u32x4*)(KT + r * 72 + c8); }
    mm16<64, 64, 64>(Ks, 72, Ks, 72, wid, lane, [&](int i, int j, float v) { Tm[i * 68 + j] = (i > j) ? v * betas[i] * __expf(gcs[i] - gcs[j]) : 0.f; });
    {
        bf16_t* ATT = (bf16_t*)(gob + GO_ATT) + (size_t)gu * 4096;
        mm16v<64, 64, 64>(Ks, 72, Qs, 72, wid, lane, [&](int j0, int i, f32x4 v) { const float gi = gcs[i]; float o[4];
#pragma unroll
            for (int q = 0; q < 4; ++q) o[q] = (i >= j0 + q) ? v[q] * __expf(gi - gcs[j0 + q]) : 0.f;
            u32x2 w; w.x = pk2(o[0], o[1]); w.y = pk2(o[2], o[3]); *(u32x2*)(ATT + i * 64 + j0) = w; });
    }
    if (tid == 0) ((float*)(ws + WS_EA + 768 * 1024))[gu] = __expf(gcs[63]);
    __syncthreads();
    if (tid < 128) {
        float x[64];
#pragma unroll
        for (int bi = 0; bi < 4; ++bi) {
            float a[16];
#pragma unroll
            for (int r = 0; r < 16; ++r) a[r] = RHS[(16 * bi + r) * 132 + tid];
#pragma unroll
            for (int j4 = 0; j4 < 4 * bi; ++j4) {
                f32x4 t[16];
#pragma unroll
                for (int r = 0; r < 16; ++r) t[r] = *(const LAS f32x4*)(Tm + (16 * bi + r) * 68 + 4 * j4);
#pragma unroll
                for (int r = 0; r < 16; ++r)
#pragma unroll
                    for (int q = 0; q < 4; ++q) a[r] -= t[r][q] * x[4 * j4 + q];
            }
            f32x4 cur[4], nxt[4];
#pragma unroll
            for (int q4 = 0; q4 < 4; ++q4) { cur[q4] = (f32x4){0.f, 0.f, 0.f, 0.f}; nxt[q4] = (f32x4){0.f, 0.f, 0.f, 0.f}; }
#pragma unroll
            for (int r = 0; r < 16; ++r) {
                if (r + 1 < 16) {
#pragma unroll
                    for (int q4 = 0; q4 < (r + 1 + 3) / 4; ++q4) nxt[q4] = *(const LAS f32x4*)(Tm + (16 * bi + r + 1) * 68 + 16 * bi + 4 * q4);
                }
                __builtin_amdgcn_sched_barrier(0);
                float acc = a[r];
#pragma unroll
                for (int j = 0; j < r; ++j) acc -= cur[j >> 2][j & 3] * x[16 * bi + j];
                x[16 * bi + r] = acc;
#pragma unroll
                for (int q4 = 0; q4 < 4; ++q4) cur[q4] = nxt[q4];
            }
        }
        if (tid < 64) { float* U = (float*)(ws + WS_GU) + (size_t)gu * 4096 + tid;
#pragma unroll
            for (int i = 0; i < 64; ++i) U[i * 64] = x[i];
        } else { bf16_t* W = (bf16_t*)(gob + GO_W) + (size_t)gu * 4096 + (tid - 64);
#pragma unroll
            for (int i = 0; i < 64; ++i) W[i * 64] = (bf16_t)f2bf(x[i]); }
    }
    __syncthreads();
}

__device__ __forceinline__ void gdn_chain_unit(const Params& p, int cu, LAS unsigned char* lds, int tid, int lane, int wid) {
    asm volatile("" : "+v"(lds));
    unsigned char* ws = wsp(p); const int b = cu >> 2, h = cu & 3;
    unsigned char* gob = (unsigned char*)outp(p);
    const int fr = lane & 15, fq = lane >> 4;
    constexpr int BUF = 54272;
    LAS bf16_t* St0 = (LAS bf16_t*)(lds + 2 * BUF); LAS bf16_t* VnT = (LAS bf16_t*)(lds + 2 * BUF + 18432);
    const bf16_t* gW = (const bf16_t*)(gob + GO_W) + (size_t)cu * 64 * 4096; const bf16_t* gQG = (const bf16_t*)(gob + GO_QG) + (size_t)cu * 64 * 4096;
    const bf16_t* gAT = (const bf16_t*)(gob + GO_ATT) + (size_t)cu * 64 * 4096; const bf16_t* gKT = (const bf16_t*)(gob + GO_KGT) + (size_t)cu * 64 * 4096;
    const float* gU = (const float*)(ws + WS_GU) + (size_t)cu * 64 * 4096; const float* GL = (const float*)(ws + WS_EA + 768 * 1024) + cu * 64;
    float* OG = (float*)(ws + WS_OG);
    f32x4 sreg[2] = {(f32x4){0.f, 0.f, 0.f, 0.f}, (f32x4){0.f, 0.f, 0.f, 0.f}};
    for (int i = tid; i < 64 * 72 / 2; i += 512) ((LAS unsigned*)St0)[i] = 0u;
    const int lrow = tid >> 3, lc8 = (tid & 7) * 8;
    u32x4 rw, rq, ra, rk; f32x4 ru[2];
    auto gload = [&](int c) { const size_t o = (size_t)c * 4096 + lrow * 64 + lc8; rw = *(const u32x4*)(gW + o); rq = *(const u32x4*)(gQG + o); ra = *(const u32x4*)(gAT + o); rk = *(const u32x4*)(gKT + o);
#pragma unroll
        for (int i = 0; i < 2; ++i) ru[i] = *(const f32x4*)(gU + (size_t)c * 4096 + (tid + 512 * i) * 4); };
    auto lstore = [&](int buf) { LAS unsigned char* B = lds + buf * BUF; const int o = (lrow * 72 + lc8) * 2;
        *(LAS u32x4*)(B + o) = rw; *(LAS u32x4*)(B + 9216 + o) = rq; *(LAS u32x4*)(B + 18432 + o) = ra; *(LAS u32x4*)(B + 27648 + o) = rk;
#pragma unroll
        for (int i = 0; i < 2; ++i) { const int idx = tid + 512 * i; *(LAS f32x4*)(B + 36864 + ((idx >> 4) * 68 + (idx & 15) * 4) * 4) = ru[i]; } };
    gload(0); lstore(0);
    __syncthreads();
    for (int c = 0; c < 64; ++c) {
        LAS unsigned char* B = lds + (c & 1) * BUF;
        const LAS bf16_t* Wt = (const LAS bf16_t*)B; const LAS bf16_t* QGt = (const LAS bf16_t*)(B + 9216); const LAS bf16_t* ATt = (const LAS bf16_t*)(B + 18432); const LAS bf16_t* KTt = (const LAS bf16_t*)(B + 27648);
        const LAS float* Ut = (const LAS float*)(B + 36864);
        LAS bf16_t* St = St0 + (c & 1) * 4608; LAS bf16_t* Stn = St0 + ((c + 1) & 1) * 4608;
        if (c + 1 < 64) gload(c + 1);
        mm16<64, 64, 64>(Wt, 72, St, 72, wid, lane, [&](int t, int dv, float v) { VnT[dv * 72 + t] = (bf16_t)f2bf(Ut[t * 68 + dv] - v); });
        __syncthreads();
        const float gl = GL[c];
        const int tokc = b * SEQ + c * 64;
#pragma unroll
        for (int bi = 0; bi < 2; ++bi) {
            const int blk = wid + 8 * bi, mb = blk >> 2, nb = blk & 3;
            f32x4 acc = {0.f, 0.f, 0.f, 0.f}, acs = {0.f, 0.f, 0.f, 0.f};
            const LAS bf16_t* sp = St + (nb * 16 + fr) * 72 + fq * 8; const LAS bf16_t* vp = VnT + (nb * 16 + fr) * 72 + fq * 8;
            const int ao = (mb * 16 + fr) * 72 + fq * 8;
#pragma unroll
            for (int k0 = 0; k0 < 64; k0 += 32) {
                acc = __builtin_amdgcn_mfma_f32_16x16x32_bf16(*(const LAS bf16x8*)(QGt + ao + k0), *(const LAS bf16x8*)(sp + k0), acc, 0, 0, 0);
                acc = __builtin_amdgcn_mfma_f32_16x16x32_bf16(*(const LAS bf16x8*)(ATt + ao + k0), *(const LAS bf16x8*)(vp + k0), acc, 0, 0, 0);
                acs = __builtin_amdgcn_mfma_f32_16x16x32_bf16(*(const LAS bf16x8*)(KTt + ao + k0), *(const LAS bf16x8*)(vp + k0), acs, 0, 0, 0);
            }
#pragma unroll
            for (int i = 0; i < 4; ++i) OG[(size_t)(tokc + mb * 16 + fq * 4 + i) * 256 + h * 64 + nb * 16 + fr] = acc[i];
            sreg[bi] = sreg[bi] * gl + acs;
        }
#pragma unroll
        for (int bi = 0; bi < 2; ++bi) { const int blk = wid + 8 * bi, mb = blk >> 2, nb = blk & 3;
            u32x2 w; w.x = pk2(sreg[bi][0], sreg[bi][1]); w.y = pk2(sreg[bi][2], sreg[bi][3]);
            *(LAS u32x2*)(Stn + (nb * 16 + fr) * 72 + mb * 16 + fq * 4) = w; }
        if (c + 1 < 64) lstore((c + 1) & 1);
        __syncthreads();
    }
}

__device__ __forceinline__ void phase_e_unit(const Params& p, int l, int tile, LAS unsigned char* lds, int tid, int lane, int wid) {
    asm volatile("" : "+v"(lds));
    unsigned char* ws = wsp(p);
    const int tok0 = tile * 64, b = tile >> 6, c = (tile & 63) >> 1;
    const bf16_t* PROJ = (const bf16_t*)(ws + WS_PROJ); bf16_t* CAT = (bf16_t*)(ws + WS_CAT);
    const float lambda_init = 0.8f - 0.6f * __expf(-0.3f * (float)l);
    float lam;
    { const float d1 = wave_sum(pin(p, I_LQ1)[l * 64 + lane] * pin(p, I_LK1)[l * 64 + lane], lane), d2 = wave_sum(pin(p, I_LQ2)[l * 64 + lane] * pin(p, I_LK2)[l * 64 + lane], lane); lam = __expf(d1) - __expf(d2) + lambda_init; }
    {
        const bf16_t* AO = (const bf16_t*)(ws + WS_AO); const float* sg = pin(p, I_SUBG) + l * 128;
        const int hh = lane >> 4, cmap = (lane >> 3) & 1, eh = (lane >> 2) & 1, dp = lane & 3;
        float gsub[16];
#pragma unroll
        for (int j = 0; j < 16; ++j) gsub[j] = sg[eh * 64 + dp * 16 + j];
        const float post = 1.f - lambda_init;
#pragma unroll 2
        for (int i = 0; i < 8; ++i) { const size_t tok = tok0 + wid + 8 * i;
            const u32x4 r0 = *(const u32x4*)(AO + tok * 1024 + lane * 16), r1 = *(const u32x4*)(AO + tok * 1024 + lane * 16 + 8);
            float mine[16], oth[16]; unpack8(r0, *(float(*)[8])&mine[0]); unpack8(r1, *(float(*)[8])&mine[8]);
#pragma unroll
            for (int j = 0; j < 16; ++j) oth[j] = dpp_f<0x128>(mine[j]);
            float v[16]; float sq = 0.f;
#pragma unroll
            for (int j = 0; j < 16; ++j) { v[j] = mine[j] - lam * oth[j]; sq += v[j] * v[j]; }
            if (cmap) sq = 0.f;
            sq += dpp_f<0xB1>(sq); sq += dpp_f<0x4E>(sq); sq += dpp_f<0x141>(sq); sq += dpp_f<0x140>(sq);
            const float rr = rsqrtf(sq * (1.f / 128.f) + NORM_EPS) * post;
            if (!cmap) { bf16_t* o = CAT + tok * 1024 + hh * 128 + eh * 64 + dp * 16;
                u32x4 w0, w1;
#pragma unroll
                for (int j = 0; j < 4; ++j) { w0[j] = pk2(v[2 * j] * rr * gsub[2 * j], v[2 * j + 1] * rr * gsub[2 * j + 1]); w1[j] = pk2(v[8 + 2 * j] * rr * gsub[8 + 2 * j], v[9 + 2 * j] * rr * gsub[9 + 2 * j]); }
                *(u32x4*)o = w0; *(u32x4*)(o + 8) = w1; }
        }
    }
    {
        const float* OG = (const float*)(ws + WS_OG); const f32x4 gn = *(const f32x4*)(pin(p, I_GNG) + l * 64 + (lane & 15) * 4);
#pragma unroll 4
        for (int i = 0; i < 8; ++i) { const size_t tok = tok0 + wid + 8 * i;
            const f32x4 v = *(const f32x4*)(OG + tok * 256 + lane * 4); const u32x2 zz = *(const u32x2*)(PROJ + tok * PN + 3328 + lane * 4);
            float sq = dot4v(v);
            sq += dpp_f<0xB1>(sq); sq += dpp_f<0x4E>(sq); sq += dpp_f<0x141>(sq); sq += dpp_f<0x140>(sq);
            const float rr = rsqrtf(sq * (1.f / 64.f) + NORM_EPS);
            const float z0 = __builtin_bit_cast(float, zz.x << 16), z1 = __builtin_bit_cast(float, zz.x & 0xffff0000u), z2 = __builtin_bit_cast(float, zz.y << 16), z3 = __builtin_bit_cast(float, zz.y & 0xffff0000u);
            u32x2 w; w.x = pk2(v[0] * rr * gn[0] * silu_f(z0), v[1] * rr * gn[1] * silu_f(z1)); w.y = pk2(v[2] * rr * gn[2] * silu_f(z2), v[3] * rr * gn[3] * silu_f(z3));
            *(u32x2*)(CAT + tok * 1024 + 768 + lane * 4) = w; }
    }
    LAS bf16_t* CMg = (LAS bf16_t*)lds; LAS bf16_t* HPs = (LAS bf16_t*)(lds + 17408); LAS float* Yb = (LAS float*)(lds + 17408 + 34816);
    const float* Y = (const float*)(ws + WS_YS); const float* EA = (const float*)(ws + WS_EA);
    for (int g = 0; g < 2; ++g) {
        {
            u32x4 r0[2], r1[4];
#pragma unroll
            for (int i = 0; i < 2; ++i) { const int idx = tid + 512 * i; r0[i] = *(const u32x4*)((const bf16_t*)(ws + WS_CM) + (size_t)(tok0 + (idx >> 4)) * 256 + g * 128 + (idx & 15) * 8); }
#pragma unroll
            for (int i = 0; i < 4; ++i) { const int idx = tid + 512 * i; const int hh = idx >> 10, r = (idx >> 4) & 63;
                r1[i] = *(const u32x4*)((const bf16_t*)(ws + WS_HP) + (size_t)((b * 32 + c) * 4 + 2 * g + hh) * 8192 + r * 128 + (idx & 15) * 8); }
#pragma unroll
            for (int i = 0; i < 2; ++i) { const int idx = tid + 512 * i; *(LAS u32x4*)(CMg + (idx >> 4) * 136 + (idx & 15) * 8) = r0[i]; }
#pragma unroll
            for (int i = 0; i < 4; ++i) { const int idx = tid + 512 * i; const int hh = idx >> 10, r = (idx >> 4) & 63; *(LAS u32x4*)(HPs + (hh * 64 + r) * 136 + (idx & 15) * 8) = r1[i]; }
        }
        __syncthreads();
        for (int hh = 0; hh < 2; ++hh)
            mm16<64, 64, 128>(CMg, 136, HPs + hh * 64 * 136, 136, wid, lane, [&](int r, int pp, float v) { Yb[r * 132 + hh * 64 + pp] = v; });
        __syncthreads();
        {
            f32x4 yv[4]; u32x2 zv[4]; float ea[4];
#pragma unroll
            for (int i = 0; i < 4; ++i) { const int idx = tid + 512 * i; const int r = idx >> 5, c4 = (idx & 31) * 4; const size_t tok = tok0 + r;
                yv[i] = *(const f32x4*)(Y + tok * 256 + g * 128 + c4); zv[i] = *(const u32x2*)(PROJ + tok * PN + 1536 + g * 128 + c4); ea[i] = EA[tok * 4 + 2 * g + (c4 >> 6)]; }
#pragma unroll
            for (int i = 0; i < 4; ++i) { const int idx = tid + 512 * i; const int r = idx >> 5, c4 = (idx & 31) * 4;
                const f32x4 yo = *(const LAS f32x4*)(Yb + r * 132 + c4); f32x4 o;
                const float z0 = __builtin_bit_cast(float, zv[i].x << 16), z1 = __builtin_bit_cast(float, zv[i].x & 0xffff0000u), z2 = __builtin_bit_cast(float, zv[i].y << 16), z3 = __builtin_bit_cast(float, zv[i].y & 0xffff0000u);
                o[0] = (yv[i][0] + yo[0] * ea[i]) * silu_f(z0); o[1] = (yv[i][1] + yo[1] * ea[i]) * silu_f(z1); o[2] = (yv[i][2] + yo[2] * ea[i]) * silu_f(z2); o[3] = (yv[i][3] + yo[3] * ea[i]) * silu_f(z3);
                *(LAS f32x4*)(Yb + r * 132 + c4) = o; }
        }
        __syncthreads();
        { const float* gn = pin(p, I_SNG) + l * 256 + g * 128; const float g0 = gn[lane], g1 = gn[64 + lane];
#pragma unroll
            for (int i = 0; i < 8; ++i) { const int r = wid + 8 * i; const float v0 = Yb[r * 132 + lane], v1 = Yb[r * 132 + 64 + lane];
                const float rr = rsqrtf(wave_sum(v0 * v0 + v1 * v1, lane) * (1.f / 128.f) + NORM_EPS);
                bf16_t* o = CAT + (size_t)(tok0 + r) * 1024 + 512 + g * 128 + lane; o[0] = (bf16_t)f2bf(v0 * rr * g0); o[64] = (bf16_t)f2bf(v1 * rr * g1); } }
        __syncthreads();
    }
}
}

namespace mk {
__device__ __forceinline__ int q_next(unsigned* ctr, LAS unsigned char* lds, int tid) {
    LAS int* slot = (LAS int*)(lds + LDS_SLOT);
    __syncthreads();
    if (tid == 0) *slot = (int)atomicAdd(ctr, 1u);
    __syncthreads();
    return __builtin_amdgcn_readfirstlane(*slot);
}
}

#ifndef PROBE_REP_D1
#define PROBE_REP_D1 1
#endif
#ifndef PROBE_REP_D2
#define PROBE_REP_D2 1
#endif
#ifndef PROBE_XSYNC
#define PROBE_XSYNC 0
#endif
#ifndef PROBE_REP_A
#define PROBE_REP_A 1
#endif
#ifndef PROBE_REP_EPIINPROJ
#define PROBE_REP_EPIINPROJ 1
#endif
#ifndef PROBE_REP_EPIQPROJ
#define PROBE_REP_EPIQPROJ 1
#endif
#ifndef PROBE_REP_EPISOFTMAX
#define PROBE_REP_EPISOFTMAX 1
#endif
#ifndef PROBE_REP_EPIBF16
#define PROBE_REP_EPIBF16 1
#endif
#ifndef PROBE_REP_EPISWIGLU
#define PROBE_REP_EPISWIGLU 1
#endif
#ifndef PROBE_REP_GP
#define PROBE_REP_GP 1
#endif
#ifndef PROBE_REP_ATT
#define PROBE_REP_ATT 1
#endif
#ifndef PROBE_REP_SP
#define PROBE_REP_SP 1
#endif
#ifndef PROBE_REP_CH
#define PROBE_REP_CH 1
#endif
#ifndef PROBE_REP_E
#define PROBE_REP_E 1
#endif
#ifndef MK_LAYERS
#define MK_LAYERS DEPTH
#endif

#define IDS int tid; asm volatile("v_mbcnt_lo_u32_b32 %0, -1, 0\n\tv_mbcnt_hi_u32_b32 %0, -1, %0" : "=v"(tid)); tid += wid0 * 64; asm volatile("" : "+v"(tid)); const int lane = tid & 63, wid = __builtin_amdgcn_readfirstlane(tid >> 6); (void)lane; (void)wid
#define WSV unsigned char* ws = wsp(p); unsigned* ctl = (unsigned*)(ws + WS_CTL); bf16_t* H = (bf16_t*)(ws + WS_H); bf16_t* PROJ = (bf16_t*)(ws + WS_PROJ); bf16_t* AO = (bf16_t*)(ws + WS_AO); bf16_t* CAT = (bf16_t*)(ws + WS_CAT); \
    bf16_t* QX = AO; bf16_t* PB = PROJ; bf16_t* OX = CAT; bf16_t* HID = PROJ; (void)ctl; (void)H; (void)PROJ; (void)AO; (void)CAT; (void)QX; (void)PB; (void)OX; (void)HID
__global__ void __launch_bounds__(512, 2) mega_fwd(mk::Params p) {
    using namespace mk;
    extern __shared__ __attribute__((aligned(16))) unsigned char lds_raw[];
    cg::grid_group grid = cg::this_grid();
    LAS unsigned char* lds = (LAS unsigned char*)lds_raw;
    const int bid = blockIdx.x;
    const int wid0 = __builtin_amdgcn_readfirstlane((int)threadIdx.x >> 6);
    {
        IDS; volatile LAS unsigned* st = (volatile LAS unsigned*)(lds + LDS_SLOT + 16);
        if (tid < 2) st[tid] = 0u;
        __syncthreads();
        { unsigned char* wv = p.ws; asm volatile("" : "+v"(wv));
          (void)xcd_barrier_post((unsigned*)(wv + WS_CTL) + 4096, st, tid); }
    }
#define GSYNC() do { IDS; XcdBarrier b_; b_.bar = (unsigned*)(wsp(p) + WS_CTL) + 4096; b_.x = xb_xcc_id(); b_.st = (volatile LAS unsigned*)(lds + LDS_SLOT + 16); xcd_barrier(b_, tid); } while (0)
    { IDS; phase_a(p, 0, lds, tid, lane, wid); }
    if (gridDim.x == 0x7fffffffu) grid.sync();
    GSYNC();
    {
        WSV; pg8::SchedOne S; S.have = bid < 128; const int ll = bid >> 5, r = bid & 31;
        S.u0.pm = r >> 3; S.u0.pn = r & 7; S.u0.kind = 0; S.u0.aux = ll;
        S.u0.a = (const char*)(ws + WS_MEMN) + ((size_t)ll * NMEM + S.u0.pm * 256) * DM * 2;
        S.u0.b = (const char*)(ws + WS_WCKV) + ((size_t)ll * 2048 + S.u0.pn * 256) * DM * 2;
        pg8::EpiKV E{(bf16_t*)(ws + WS_KN), (bf16_t*)(ws + WS_VT), pin(p, I_XKG)};
        { IDS; pg8::gemm_phase<pg8::EpiKV, pg8::SchedOne, false, true>(lds, pg8::Gemm{DM, DM, DM}, S, E, tid); }
        __syncthreads();
    }
#pragma unroll 1
    for (int l = 0; l < MK_LAYERS; ++l) {
        {
            WSV; pg8::SchedDense S; S.init(H, ws + woff(0, l & 1), DM, DM, MTOK / 256, PN / 256 + 1);
            pg8::EpiInProj E{PROJ, pin(p, I_QG) + l * 64, pin(p, I_KG) + l * 64, (const float*)(ws + WS_SSP), (float*)(ws + WS_SM)};
            for (int rep = 0; rep < PROBE_REP_EPIINPROJ; ++rep) { IDS; pg8::gemm_phase<pg8::EpiInProj, pg8::SchedDense, true, true>(lds, pg8::Gemm{DM, DM, DM}, S, E, tid); }
        }
        GSYNC();
        {
            IDS;
#pragma unroll 1
            for (int u = bid; u < 1024; u += gridDim.x) gdn_prep_unit(p, l, u, lds, tid, lane, wid);
#pragma unroll 1
            for (int u = bid; u < 512; u += gridDim.x) ssd_prep_unit(p, l, u, lds, tid, lane, wid);
            if (l > 0) for (int u = bid; u < (CI_DN + 7) / 8; u += gridDim.x) conv_unit(p, l, u, true, lds, lane, wid);
        }
        GSYNC();
        for (int rep = 0; rep < PROBE_REP_D2; ++rep) {
            IDS; WSV; unsigned* ctr = ctl + ((l * 2 + 1) * 4 + rep) * 64;
            const int nq2 = 32 + 1024 + (l + 1 < MK_LAYERS ? (CI_MAIN + 7) / 8 : 0);
            for (;;) { const int idx = q_next(ctr, lds, tid); if (idx >= nq2) break;
                if (idx >= 32 + 1024) { conv_unit(p, l + 1, idx - (32 + 1024), false, lds, lane, wid); continue; }
#ifndef SKIP_GCHAIN
                if (idx < 16) { for (int r2 = 0; r2 < PROBE_REP_CH; ++r2) gdn_chain_unit(p, idx, lds, tid, lane, wid); }
#endif
                if (idx >= 16 && idx < 32) ssd_scan_unit(p, idx - 16, tid);
#ifndef SKIP_ATTN
                if (idx >= 32) { const int a = idx - 32, qb = 15 - (a >> 6), bh = a & 63;
                    for (int r2 = 0; r2 < PROBE_REP_ATT; ++r2) attn_body::attn_unit<8>(bh >> 4, bh & 15, qb, (const attn_body::bf16*)PROJ, (const attn_body::bf16*)PROJ, (const attn_body::bf16*)PROJ, (attn_body::bf16*)AO, (char*)lds_raw, tid); }
#endif
            }
        }
        GSYNC();
#ifndef SKIP_E
        { IDS; for (int tile = bid; tile < MTOK / 64; tile += gridDim.x) for (int r2 = 0; r2 < PROBE_REP_E; ++r2) phase_e_unit(p, l, tile, lds, tid, lane, wid); }
#endif
        GSYNC();
        {
            WSV; pg8::SchedDense S; S.init(CAT, ws + woff(1, l & 1), DM, DM, MTOK / 256, 4);
            pg8::EpiResid E{H, (float*)(ws + WS_SSP + 1 * MiB), nullptr};
#ifdef PROBE_NULL_RESID
            { pg8::EpiNull EN{(float*)(ws + WS_SM)}; IDS; pg8::gemm_phase<pg8::EpiNull, pg8::SchedDense, true, true>(lds, pg8::Gemm{DM, DM, DM}, S, EN, tid); }
#endif
            { IDS; pg8::gemm_phase<pg8::EpiResid, pg8::SchedDense, true, true>(lds, pg8::Gemm{DM, DM, DM}, S, E, tid); }
        }
        GSYNC();
        {
            WSV; pg8::SchedDense S; S.init(H, ws + woff(2, l & 1), DM, DM, MTOK / 256, 4);
            pg8::EpiQProj E{QX, pin(p, I_XQG) + l * 256, (const float*)(ws + WS_SSP + 1 * MiB)};
            for (int rep = 0; rep < PROBE_REP_EPIQPROJ; ++rep) { IDS; pg8::gemm_phase<pg8::EpiQProj, pg8::SchedDense, false, true>(lds, pg8::Gemm{DM, DM, DM}, S, E, tid); }
        }
        asm volatile("s_waitcnt vmcnt(0)" ::: "memory"); __syncthreads();
        {
            WSV; pg8::SchedX<0> S; S.init(QX, ws + WS_KN + (size_t)l * NMEM * DM * 2);
            pg8::EpiSoftmax E{PB};
            for (int rep = 0; rep < PROBE_REP_EPISOFTMAX; ++rep) { IDS; pg8::gemm_phase<pg8::EpiSoftmax, pg8::SchedX<0>, false, true>(lds, pg8::Gemm{DM, DM, 256}, S, E, tid); }
        }
        asm volatile("s_waitcnt vmcnt(0)" ::: "memory"); __syncthreads();
        {
            WSV; pg8::SchedX<1> S; S.init(PB, ws + WS_VT + (size_t)l * 16 * 65536 * 2);
            pg8::EpiBf16 E{OX};
            for (int rep = 0; rep < PROBE_REP_EPIBF16; ++rep) { IDS; pg8::gemm_phase<pg8::EpiBf16, pg8::SchedX<1>, false, true>(lds, pg8::Gemm{DM, 256, 256}, S, E, tid); }
        }
        GSYNC();
        {
            WSV; pg8::SchedDense S; S.init(OX, ws + woff(3, l & 1), DM, DM, MTOK / 256, 4);
            pg8::EpiResid E{H, (float*)(ws + WS_SSP + 2 * MiB), nullptr};
#ifdef PROBE_NULL_RESID
            { pg8::EpiNull EN{(float*)(ws + WS_SM)}; IDS; pg8::gemm_phase<pg8::EpiNull, pg8::SchedDense, true, true>(lds, pg8::Gemm{DM, DM, DM}, S, EN, tid); }
#endif
            { IDS; pg8::gemm_phase<pg8::EpiResid, pg8::SchedDense, true, true>(lds, pg8::Gemm{DM, DM, DM}, S, E, tid); }
        }
        GSYNC();
        {
            WSV; pg8::SchedDense S; S.init(H, ws + woff(4, l & 1), DM, DM, MTOK / 256, 2 * D_FF / 256);
            pg8::EpiSwiGLU E{HID, (const float*)(ws + WS_SSP + 2 * MiB)};
            for (int rep = 0; rep < PROBE_REP_EPISWIGLU; ++rep) { IDS; pg8::gemm_phase<pg8::EpiSwiGLU, pg8::SchedDense, true, true>(lds, pg8::Gemm{DM, DM, DM}, S, E, tid); }
        }
        GSYNC();
        {
            WSV; pg8::SchedDense S; S.init(HID, ws + WS_WDN, D_FF, D_FF, MTOK / 256, 4);
            pg8::EpiResid E{H, (float*)(ws + WS_SSP), l + 1 < MK_LAYERS ? nullptr : outp(p)};
#ifdef PROBE_NULL_RESID
            { pg8::EpiNull EN{(float*)(ws + WS_SM)}; IDS; pg8::gemm_phase<pg8::EpiNull, pg8::SchedDense, true, true>(lds, pg8::Gemm{D_FF, D_FF, D_FF}, S, EN, tid); }
#endif
            { IDS; pg8::gemm_phase<pg8::EpiResid, pg8::SchedDense, true, true>(lds, pg8::Gemm{D_FF, D_FF, D_FF}, S, E, tid); }
        }
        GSYNC();
        for (int xs = 0; xs < PROBE_XSYNC; ++xs) GSYNC();

    }
}

extern "C" void kernel_launch(void* const* d_in, const int* in_sizes, int n_in, void* d_out, int out_size, void* d_ws, size_t ws_size, hipStream_t stream) {
    static int grid = 0;
    if (grid == 0) {
        if (n_in != 32 || out_size != MTOK * DM || ws_size < mk::WS_END) { fprintf(stderr, "kernel_launch: unexpected shapes: n_in %d out %d ws %zu (need %zu)\n", n_in, out_size, ws_size, (size_t)mk::WS_END); grid = -1; return; }
        int dev = 0, cus = 0, per_cu = 0;
        hipGetDevice(&dev); hipDeviceGetAttribute(&cus, hipDeviceAttributeMultiprocessorCount, dev);
        if (hipFuncSetAttribute((const void*)mega_fwd, hipFuncAttributeMaxDynamicSharedMemorySize, mk::LDS_BYTES) != hipSuccess) { fprintf(stderr, "kernel_launch: hipFuncSetAttribute failed\n"); grid = -1; return; }
        hipOccupancyMaxActiveBlocksPerMultiprocessor(&per_cu, (const void*)mega_fwd, 512, mk::LDS_BYTES);
        (void)hipGetLastError();
        if (per_cu < 1) fprintf(stderr, "kernel_launch: occupancy query says %d blocks/CU\n", per_cu);
        grid = cus;
        if (grid != 256) fprintf(stderr, "kernel_launch: %d CUs; this kernel is built for 256\n", grid);
    }
    if (grid < 0) return;
    (void)hipMemsetAsync((char*)d_ws + mk::WS_CTL, 0, mk::CTL_BYTES, stream);
    mk::Params p{};
    for (int i = 0; i < 32; ++i) p.in[i] = (const float*)d_in[i];
    p.out = (float*)d_out; p.ws = (unsigned char*)d_ws;
    void* args[] = {&p};
    hipError_t e = hipLaunchCooperativeKernel((const void*)mega_fwd, dim3(grid), dim3(512), args, mk::LDS_BYTES, stream);
    if (e != hipSuccess) fprintf(stderr, "cooperative launch failed: %s (grid %d)\n", hipGetErrorString(e), grid);
}
```

```cpp
#include <hip/hip_runtime.h>
#include <hip/hip_cooperative_groups.h>
#include <hip/hip_bf16.h>
#include <cstdio>
#include <cstdint>
#include <cmath>
namespace cg = cooperative_groups;

#define LAS __attribute__((address_space(3)))
typedef unsigned short bf16_t;
typedef short bf16x8 __attribute__((ext_vector_type(8)));
typedef float f32x4 __attribute__((ext_vector_type(4)));
typedef float f32x2 __attribute__((ext_vector_type(2)));
typedef unsigned u32x4 __attribute__((ext_vector_type(4)));
typedef unsigned u32x2 __attribute__((ext_vector_type(2)));

constexpr int BATCH = 4, SEQ = 4096, DM = 1024, DEPTH = 4, MTOK = BATCH * SEQ;
constexpr int MEM_LEN = 256, NMEM = BATCH * MEM_LEN;
constexpr int P_IN = 3596, PN = 3584;
constexpr int D_FF = 2816;
constexpr float NORM_EPS = 1e-6f;
constexpr float LOG2E = 1.4426950408889634f;

typedef __bf16 hw_bf16x2 __attribute__((ext_vector_type(2)));
__device__ __forceinline__ unsigned pk2(float lo, float hi) { const f32x2 v = {lo, hi}; return __builtin_bit_cast(unsigned, __builtin_convertvector(v, hw_bf16x2)); }
__device__ __forceinline__ unsigned f2bf(float f) { return pk2(f, 0.f) & 0xffffu; }
__device__ __forceinline__ float bf2f(bf16_t b) { return __builtin_bit_cast(float, (unsigned)b << 16); }
__device__ __forceinline__ float lane_xor(float v, int o, int lane) { return __builtin_bit_cast(float, __builtin_amdgcn_ds_bpermute((lane ^ o) << 2, __builtin_bit_cast(int, v))); }
template <int CTRL> __device__ __forceinline__ float dpp_f(float v) { return __builtin_bit_cast(float, __builtin_amdgcn_update_dpp(0, __builtin_bit_cast(int, v), CTRL, 0xF, 0xF, true)); }
__device__ __forceinline__ float wave_sum(float v, int lane) {
    v += dpp_f<0xB1>(v);
    v += dpp_f<0x4E>(v);
    v += dpp_f<0x141>(v);
    v += dpp_f<0x140>(v);
    v += lane_xor(v, 16, lane);
    v += lane_xor(v, 32, lane);
    return v;
}
__device__ __forceinline__ float wave_incl_scan(float v, int lane) {
#pragma unroll
    for (int o = 1; o < 64; o <<= 1) { const float n = __builtin_bit_cast(float, __builtin_amdgcn_ds_bpermute((lane - o) << 2, __builtin_bit_cast(int, v))); if (lane >= o) v += n; }
    return v;
}
__device__ __forceinline__ float dot4v(f32x4 a) { return (a[0] * a[0] + a[1] * a[1]) + (a[2] * a[2] + a[3] * a[3]); }
__device__ __forceinline__ float silu_f(float x) { return x * __builtin_amdgcn_rcpf(1.f + __expf(-x)); }
__device__ __forceinline__ float sigmoid_f(float x) { return __builtin_amdgcn_rcpf(1.f + __expf(-x)); }
__device__ __forceinline__ float softplus_f(float x) { return fmaxf(x, 0.f) + __logf(1.f + __expf(-fabsf(x))); }

namespace pg8 {
#define PG8_LAS __attribute__((address_space(3)))
constexpr int BM = 256, BK = 64, HALF = 128, HTB = HALF * BK * 2  , STAGE_BYTES = 8 * HTB, NXCD = 8, WGM = 8;

__host__ __device__ __forceinline__ int lds_byte(int r, int c) { const int st = (r >> 4) * 2 + (c >> 5), rr = r & 15, cc = c & 31, ob = rr * 64 + cc * 2; return st * 1024 + (ob ^ (((ob >> 9) & 1) << 5)); }
__host__ __device__ __forceinline__ void stage_rc(int b, int& R, int& C) { const int st = b / 1024, sb = b % 1024, swz = sb ^ (((sb >> 9) & 1) << 5); R = (st >> 1) * 16 + swz / 64; C = (st & 1) * 32 + (swz % 64) / 2; }
__host__ __device__ __forceinline__ int perm32(int rho) { const int n = rho >> 4, i = rho & 15; return 8 * (i >> 2) + 4 * n + (i & 3); }

struct Unit { int pm, pn, kind, aux; const char* a; const char* b; };
struct Gemm { int lda, ldb, K; };

struct GridOrder {
    int nM, nN, nwg, G, c;
    __device__ void init(int nM_, int nN_, int G_, int c_) { nM = nM_; nN = nN_; nwg = nM * nN; G = G_; c = c_; }
    __device__ bool tile(int i, int& pm, int& pn) const {
        const long L = (long)i * G + c; if (L >= nwg) return false;
        int wgid = (int)L; { const int q = nwg / NXCD, r = nwg % NXCD, xcd = wgid % NXCD, off = wgid / NXCD; wgid = (xcd < r ? xcd * (q + 1) : r * (q + 1) + (xcd - r) * q) + off; }
        const int nig = WGM * nN, gid = wgid / nig, fm = gid * WGM, gsz = (nM - fm) < WGM ? (nM - fm) : WGM;
        pm = fm + ((wgid % nig) % gsz); pn = (wgid % nig) / gsz; return true;
    }
};
__device__ __forceinline__ unsigned cvt_pk_bf16(float lo, float hi) { unsigned r; asm volatile("v_cvt_pk_bf16_f32 %0, %1, %2" : "=v"(r) : "v"(lo), "v"(hi)); return r; }
template <class Epi, class Sched, bool ALIGN_EPI = false, bool SP2 = false>
__device__ __forceinline__ void gemm_phase(PG8_LAS unsigned char* lds, const Gemm g, const Sched& S, const Epi& E, int tid_in) {
    int tid_l = tid_in; asm volatile("" : "+v"(tid_l));
    const int tid = tid_l, wid = __builtin_amdgcn_readfirstlane(tid >> 6), lane = tid & 63, wr = wid >> 2, wc = wid & 3, fr = lane & 15, fq = lane >> 4;
    const int K = g.K, nt = K / BK;
    unsigned voffA[2], voffB[2];
#pragma unroll
    for (int i = 0; i < 2; ++i) { int R, C; stage_rc(tid * 16 + i * 8192, R, C); const int Rb = Epi::PERM ? ((R & ~31) + perm32(R & 31)) : R;
        voffA[i] = (unsigned)(R * g.lda + C) * 2u; voffB[i] = (unsigned)(Rb * g.ldb + C) * 2u; }
    const size_t kstep = (size_t)(BK * 2);
    const size_t hstepA = (size_t)HALF * g.lda * 2, hstepB = (size_t)HALF * g.ldb * 2;
    const unsigned ldsw = (unsigned)wid * 1024u;
    const int aoff = lds_byte(wr * 64 + fr, fq * 8), boff = lds_byte(wc * 32 + fr, fq * 8);
#define PG8_SA(b, h) (((b) * 2 + (h)) * HTB)
#define PG8_SB(b, h) ((4 + (b) * 2 + (h)) * HTB)
#define PG8_STAGE(bufoff, gbase, voff) do { _Pragma("unroll") for (int _i = 0; _i < 2; ++_i) \
        __builtin_amdgcn_global_load_lds((const unsigned*)((const char*)(gbase) + (voff)[_i]), (PG8_LAS unsigned*)(lds + (bufoff) + ldsw + _i * 8192), 16, 0, 0); } while (0)
#define PG8_LDA(dst, b, h) do { _Pragma("unroll") for (int m = 0; m < 4; ++m) _Pragma("unroll") for (int k = 0; k < 2; ++k) dst[m][k] = *(const PG8_LAS bf16x8*)(lds + PG8_SA(b, h) + aoff + m * 2048 + k * 1024); } while (0)
#define PG8_LDB(dst, b, h) do { _Pragma("unroll") for (int n = 0; n < 2; ++n) _Pragma("unroll") for (int k = 0; k < 2; ++k) dst[n][k] = *(const PG8_LAS bf16x8*)(lds + PG8_SB(b, h) + boff + n * 2048 + k * 1024); } while (0)
#define PG8_MMA(ai, bj, At, Bt) do { __builtin_amdgcn_s_setprio(1); _Pragma("unroll") for (int m = 0; m < 4; ++m) _Pragma("unroll") for (int n = 0; n < 2; ++n) _Pragma("unroll") for (int k = 0; k < 2; ++k) \
        acc[ai][bj][m][n] = __builtin_amdgcn_mfma_f32_16x16x32_bf16(Bt[n][k], At[m][k], acc[ai][bj][m][n], 0, 0, 0); __builtin_amdgcn_s_setprio(0); } while (0)
#define PG8_WAIT_V(n) asm volatile("s_waitcnt vmcnt(" #n ")" ::: "memory")
#define PG8_WAIT_L(n) asm volatile("s_waitcnt lgkmcnt(" #n ")" ::: "memory")
#define PG8_BAR __builtin_amdgcn_s_barrier()
#define PG8_SCHED __builtin_amdgcn_sched_barrier(0)
    Unit cur, nxt; int ui = 0;
    if (!S.next(0, cur)) return;
    f32x4 acc[2][2][4][2];
#pragma unroll
    for (int a = 0; a < 2; ++a)
#pragma unroll
        for (int b = 0; b < 2; ++b)
#pragma unroll
            for (int m = 0; m < 4; ++m)
#pragma unroll
                for (int n = 0; n < 2; ++n) acc[a][b][m][n] = (f32x4){0.f, 0.f, 0.f, 0.f};
    bf16x8 At[4][2], B0[2][2], B1[2][2];
    const char* cA = cur.a; const char* cB = cur.b;
    S.a_ready(cur);
    if constexpr (SP2) {
        PG8_STAGE(PG8_SB(0, 0), cB, voffB); PG8_STAGE(PG8_SB(0, 1), cB + hstepB, voffB); PG8_STAGE(PG8_SA(0, 0), cA, voffA); PG8_STAGE(PG8_SA(0, 1), cA + hstepA, voffA);
        if (wr == 1) PG8_BAR;
        PG8_WAIT_V(2); PG8_BAR;
        PG8_STAGE(PG8_SB(1, 0), cB + kstep, voffB); PG8_STAGE(PG8_SA(1, 0), cA + kstep, voffA); PG8_STAGE(PG8_SB(1, 1), cB + hstepB + kstep, voffB);
        PG8_WAIT_V(6); PG8_BAR;
    } else {
        PG8_STAGE(PG8_SB(0, 0), cB, voffB); PG8_STAGE(PG8_SA(0, 0), cA, voffA); PG8_STAGE(PG8_SB(0, 1), cB + hstepB, voffB); PG8_STAGE(PG8_SA(0, 1), cA + hstepA, voffA);
        if (wr == 1) PG8_BAR;
        PG8_WAIT_V(4); PG8_BAR;
        PG8_STAGE(PG8_SB(1, 0), cB + kstep, voffB); PG8_STAGE(PG8_SA(1, 0), cA + kstep, voffA); PG8_STAGE(PG8_SB(1, 1), cB + hstepB + kstep, voffB);
        PG8_WAIT_V(6); PG8_BAR;
    }
    for (;;) {
        const bool has_next = S.next(ui + 1, nxt);
        const char* nA = has_next ? nxt.a : cA; const char* nB = has_next ? nxt.b : cB;
        for (int t = 0; t < nt; t += 2) {
            const bool last = (t == nt - 2);
            const char* a1 = cA + (size_t)(t + 1) * kstep;
            const char* a2 = last ? nA : cA + (size_t)(t + 2) * kstep; const char* b2 = last ? nB : cB + (size_t)(t + 2) * kstep;
            const char* a3 = a2 + kstep; const char* b3 = b2 + kstep;
            if (last && has_next) S.a_ready(nxt);
            if constexpr (SP2) {
            PG8_LDB(B0, 0, 0); PG8_LDB(B1, 0, 1); PG8_SCHED; PG8_LDA(At, 0, 0); PG8_STAGE(PG8_SA(1, 1), a1 + hstepA, voffA);
            PG8_WAIT_V(8); PG8_WAIT_L(0); PG8_BAR; PG8_MMA(0, 0, At, B0); PG8_MMA(0, 1, At, B1); PG8_BAR; PG8_SCHED;
            PG8_LDA(At, 0, 1); PG8_STAGE(PG8_SB(0, 0), b2, voffB); PG8_STAGE(PG8_SB(0, 1), b2 + hstepB, voffB); PG8_STAGE(PG8_SA(0, 0), a2, voffA);
            PG8_WAIT_V(8); PG8_WAIT_L(0); PG8_BAR; PG8_MMA(1, 0, At, B0); PG8_MMA(1, 1, At, B1); PG8_BAR; PG8_SCHED;
            PG8_LDB(B0, 1, 0); PG8_LDB(B1, 1, 1); PG8_SCHED; PG8_LDA(At, 1, 0); PG8_STAGE(PG8_SA(0, 1), a2 + hstepA, voffA);
            PG8_WAIT_V(8); PG8_WAIT_L(0); PG8_BAR; PG8_MMA(0, 0, At, B0); PG8_MMA(0, 1, At, B1); PG8_BAR; PG8_SCHED;
            PG8_LDA(At, 1, 1); PG8_STAGE(PG8_SB(1, 0), b3, voffB); PG8_STAGE(PG8_SB(1, 1), b3 + hstepB, voffB); PG8_STAGE(PG8_SA(1, 0), a3, voffA);
            PG8_WAIT_V(8); PG8_WAIT_L(0); PG8_BAR; PG8_MMA(1, 0, At, B0); PG8_MMA(1, 1, At, B1); PG8_BAR; PG8_SCHED;
            } else {
            PG8_LDB(B0, 0, 0); PG8_SCHED; PG8_LDA(At, 0, 0); PG8_STAGE(PG8_SA(1, 1), a1 + hstepA, voffA);
            PG8_WAIT_L(8); PG8_BAR; PG8_WAIT_L(0); PG8_MMA(0, 0, At, B0); PG8_BAR; PG8_SCHED;
            PG8_LDB(B1, 0, 1); PG8_STAGE(PG8_SB(0, 0), b2, voffB);
            PG8_BAR; PG8_WAIT_L(0); PG8_MMA(0, 1, At, B1); PG8_BAR;
            PG8_LDA(At, 0, 1); PG8_STAGE(PG8_SA(0, 0), a2, voffA);
            PG8_BAR; PG8_WAIT_L(0); PG8_MMA(1, 0, At, B0); PG8_BAR; PG8_SCHED;
            PG8_STAGE(PG8_SB(0, 1), b2 + hstepB, voffB);
            PG8_WAIT_V(6); PG8_BAR; PG8_MMA(1, 1, At, B1); PG8_BAR;
            PG8_LDB(B0, 1, 0); PG8_SCHED; PG8_LDA(At, 1, 0); PG8_STAGE(PG8_SA(0, 1), a2 + hstepA, voffA);
            PG8_WAIT_L(8); PG8_BAR; PG8_WAIT_L(0); PG8_MMA(0, 0, At, B0); PG8_BAR; PG8_SCHED;
            PG8_LDB(B1, 1, 1); PG8_STAGE(PG8_SB(1, 0), b3, voffB);
            PG8_BAR; PG8_WAIT_L(0); PG8_MMA(0, 1, At, B1); PG8_BAR;
            PG8_LDA(At, 1, 1); PG8_STAGE(PG8_SA(1, 0), a3, voffA);
            PG8_BAR; PG8_WAIT_L(0); PG8_MMA(1, 0, At, B0); PG8_BAR; PG8_SCHED;
            PG8_STAGE(PG8_SB(1, 1), b3 + hstepB, voffB);
            PG8_WAIT_V(6); PG8_BAR; PG8_MMA(1, 1, At, B1); PG8_BAR;
            }
        }
        if constexpr (ALIGN_EPI) { if (wr == 0) PG8_BAR; }
        if constexpr (!Epi::AFTER_DRAIN) { E(acc, cur, wr, wc, fr, fq); S.done(cur); }
        if (!has_next) break;
#pragma unroll
        for (int a = 0; a < 2; ++a)
#pragma unroll
            for (int b = 0; b < 2; ++b)
#pragma unroll
                for (int m = 0; m < 4; ++m)
#pragma unroll
                    for (int n = 0; n < 2; ++n) acc[a][b][m][n] = (f32x4){0.f, 0.f, 0.f, 0.f};
        cur = nxt; cA = nA; cB = nB; ++ui;
        if constexpr (ALIGN_EPI) { if (wr == 1) PG8_BAR; }
    }
    PG8_WAIT_V(0);
    if constexpr (!ALIGN_EPI) { if (wr == 0) PG8_BAR; }
    PG8_BAR;
    if constexpr (Epi::AFTER_DRAIN) { E.fused(acc, cur, wr, wc, fr, fq, lds, wid, lane); S.done(cur); }
#undef PG8_SA
#undef PG8_SB
#undef PG8_STAGE
#undef PG8_LDA
#undef PG8_LDB
#undef PG8_MMA
#undef PG8_WAIT_V
#undef PG8_WAIT_L
#undef PG8_BAR
#undef PG8_SCHED
}
}

namespace pg8 {
typedef f32x4 Acc[2][2][4][2];
constexpr float ATT_C2 = 0.125f * 1.4426950408889634f;
__device__ __forceinline__ float dot4(f32x4 a) { return (a[0] * a[0] + a[1] * a[1]) + (a[2] * a[2] + a[3] * a[3]); }
__device__ __forceinline__ void st_bf16x4(bf16_t* p, f32x4 v) { u32x2 w; w.x = cvt_pk_bf16(v[0], v[1]); w.y = cvt_pk_bf16(v[2], v[3]); *(u32x2*)p = w; }

__device__ __forceinline__ float row_rstd(const float* ssp, int row, int fr, int fq) {
    const f32x4 v = *(const f32x4*)(ssp + (size_t)row * 16 + 4 * fq); float s = (v[0] + v[1]) + (v[2] + v[3]);
    s += lane_xor(s, 16, fq * 16 + fr); s += lane_xor(s, 32, fq * 16 + fr);
    return rsqrtf(s * (1.f / DM) + NORM_EPS);
}
__device__ __forceinline__ void st_bf16x8(bf16_t* p, f32x4 a, f32x4 b) { u32x4 w; w.x = cvt_pk_bf16(a[0], a[1]); w.y = cvt_pk_bf16(a[2], a[3]); w.z = cvt_pk_bf16(b[0], b[1]); w.w = cvt_pk_bf16(b[2], b[3]); *(u32x4*)p = w; }
__device__ __forceinline__ void rstd8(const float* ssp, int row0, int fr, int fq, float (&rs)[2][4]) {
    f32x4 v[2][4];
#pragma unroll
    for (int ai = 0; ai < 2; ++ai)
#pragma unroll
        for (int m = 0; m < 4; ++m) v[ai][m] = *(const f32x4*)(ssp + (size_t)(row0 + ai * 128 + m * 16) * 16 + 4 * fq);
#pragma unroll
    for (int ai = 0; ai < 2; ++ai)
#pragma unroll
        for (int m = 0; m < 4; ++m) { float s = (v[ai][m][0] + v[ai][m][1]) + (v[ai][m][2] + v[ai][m][3]);
            s += lane_xor(s, 16, fq * 16 + fr); s += lane_xor(s, 32, fq * 16 + fr); rs[ai][m] = rsqrtf(s * (1.f / DM) + NORM_EPS); }
}
struct SchedDense {
    GridOrder go; const char* A; const char* Bt; size_t ta, tb;
    __device__ void init(const void* A_, const void* Bt_, int lda, int ldb, int nM, int nN) { go.init(nM, nN, gridDim.x, blockIdx.x); A = (const char*)A_; Bt = (const char*)Bt_; ta = (size_t)256 * lda * 2; tb = (size_t)256 * ldb * 2; }
    __device__ bool next(int i, Unit& u) const { int pm, pn; if (!go.tile(i, pm, pn)) return false; u.pm = pm; u.pn = pn; u.kind = 0; u.aux = 0; u.a = A + pm * ta; u.b = Bt + pn * tb; return true; }
    __device__ __forceinline__ void a_ready(const Unit&) const {}
    __device__ __forceinline__ void done(const Unit&) const {}
};
template <int MODE> struct SchedX {
    GridOrder go; const char* A; const char* B;
    __device__ void init(const void* A_, const void* B_) { go.init(MTOK / 256, 4, gridDim.x, blockIdx.x); A = (const char*)A_; B = (const char*)B_; }
    __device__ bool next(int i, Unit& u) const { int pm, pn; if (!go.tile(i, pm, pn)) return false; u.pm = pm; u.pn = pn; u.kind = 0; u.aux = 0;
        u.a = A + ((size_t)pm * 256 * DM + pn * 256) * 2;
        u.b = MODE == 0 ? B + ((size_t)(pm >> 4) * 256 * DM + pn * 256) * 2 : B + ((size_t)((pm >> 4) * 4 + pn) * 65536) * 2; return true; }
    __device__ __forceinline__ void a_ready(const Unit&) const {}
    __device__ __forceinline__ void done(const Unit&) const {}
};
struct SchedOne {
    Unit u0; bool have;
    __device__ bool next(int i, Unit& u) const { if (i != 0 || !have) return false; u = u0; return true; }
    __device__ __forceinline__ void a_ready(const Unit&) const {}
    __device__ __forceinline__ void done(const Unit&) const {}
};

struct EpiInProj {
    static constexpr bool PERM = true, AFTER_DRAIN = false;
    bf16_t* O; const float* qg; const float* kg; const float* ss; float* SM;
    __device__ __forceinline__ void operator()(const Acc& acc, const Unit& u, int wr, int wc, int fr, int fq) const {
        const int row0 = u.pm * 256 + wr * 64 + fr, colb = u.pn * 256 + 64 * wc + 8 * fq;
        float rs8[2][4]; rstd8(ss, row0, fr, fq, rs8);
        if (u.pn < 4) {
            const float* g = u.pn < 2 ? qg : kg; const float sc = u.pn < 2 ? ATT_C2 : 1.f;
            f32x4 gv[2][2];
#pragma unroll
            for (int bj = 0; bj < 2; ++bj)
#pragma unroll
                for (int n = 0; n < 2; ++n) gv[bj][n] = *(const f32x4*)(g + 32 * bj + 8 * fq + 4 * n);
#pragma unroll
            for (int ai = 0; ai < 2; ++ai)
#pragma unroll
                for (int m = 0; m < 4; ++m) {
                    const int row = row0 + ai * 128 + m * 16;
                    const float rstd = rs8[ai][m];
                    float s2 = (dot4(acc[ai][0][m][0]) + dot4(acc[ai][0][m][1])) + (dot4(acc[ai][1][m][0]) + dot4(acc[ai][1][m][1]));
                    s2 += lane_xor(s2, 16, fq * 16 + fr); s2 += lane_xor(s2, 32, fq * 16 + fr);
                    const float r = rstd * rsqrtf(rstd * rstd * s2 * (1.f / 64.f) + NORM_EPS) * sc;
                    bf16_t* rowp = O + (size_t)row * PN + colb;
#pragma unroll
                    for (int bj = 0; bj < 2; ++bj) { const f32x4 v0 = acc[ai][bj][m][0] * r * gv[bj][0], v1 = acc[ai][bj][m][1] * r * gv[bj][1];
                        u32x4 w; w.x = cvt_pk_bf16(v0[0], v0[1]); w.y = cvt_pk_bf16(v0[2], v0[3]); w.z = cvt_pk_bf16(v1[0], v1[1]); w.w = cvt_pk_bf16(v1[2], v1[3]); *(u32x4*)(rowp + 32 * bj) = w; }
                }
        } else if (u.pn < 14) {
#pragma unroll
            for (int ai = 0; ai < 2; ++ai)
#pragma unroll
                for (int m = 0; m < 4; ++m) {
                    const int row = row0 + ai * 128 + m * 16;
                    const float rstd = rs8[ai][m];
                    bf16_t* rowp = O + (size_t)row * PN + colb;
#pragma unroll
                    for (int bj = 0; bj < 2; ++bj) { const f32x4 v0 = acc[ai][bj][m][0] * rstd, v1 = acc[ai][bj][m][1] * rstd;
                        u32x4 w; w.x = cvt_pk_bf16(v0[0], v0[1]); w.y = cvt_pk_bf16(v0[2], v0[3]); w.z = cvt_pk_bf16(v1[0], v1[1]); w.w = cvt_pk_bf16(v1[2], v1[3]); *(u32x4*)(rowp + 32 * bj) = w; }
                }
        } else {
#pragma unroll
            for (int ai = 0; ai < 2; ++ai)
#pragma unroll
                for (int m = 0; m < 4; ++m) {
                    const int row = row0 + ai * 128 + m * 16;
                    const float rstd = rs8[ai][m];
                    if (wc == 0 && fq < 2) { *(f32x4*)(SM + (size_t)row * 12 + 8 * fq) = acc[ai][0][m][0] * rstd; if (fq == 0) *(f32x4*)(SM + (size_t)row * 12 + 4) = acc[ai][0][m][1] * rstd; }
                }
        }
    }
};
struct EpiResid {
    static constexpr bool PERM = true, AFTER_DRAIN = false;
    bf16_t* xb; float* ss; float* outf;
    __device__ __forceinline__ void operator()(const Acc& acc, const Unit& u, int wr, int wc, int fr, int fq) const {
        const int row0 = u.pm * 256 + wr * 64 + fr, col0 = u.pn * 256 + wc * 32 + 8 * fq;
        u32x4 b[2][4][2];
#pragma unroll
        for (int ai = 0; ai < 2; ++ai)
#pragma unroll
            for (int m = 0; m < 4; ++m)
#pragma unroll
                for (int bj = 0; bj < 2; ++bj) b[ai][m][bj] = *(const u32x4*)(xb + (size_t)(row0 + ai * 128 + m * 16) * DM + col0 + bj * 128);
#pragma unroll
        for (int ai = 0; ai < 2; ++ai) {
#pragma unroll
            for (int m = 0; m < 4; ++m) { const int row = row0 + ai * 128 + m * 16; const size_t off = (size_t)row * DM + col0; float sq = 0.f;
#pragma unroll
                for (int bj = 0; bj < 2; ++bj) { const u32x4 bb = b[ai][m][bj];
                    f32x4 v0, v1; v0[0] = __builtin_bit_cast(float, bb.x << 16); v0[1] = __builtin_bit_cast(float, bb.x & 0xffff0000u); v0[2] = __builtin_bit_cast(float, bb.y << 16); v0[3] = __builtin_bit_cast(float, bb.y & 0xffff0000u);
                    v1[0] = __builtin_bit_cast(float, bb.z << 16); v1[1] = __builtin_bit_cast(float, bb.z & 0xffff0000u); v1[2] = __builtin_bit_cast(float, bb.w << 16); v1[3] = __builtin_bit_cast(float, bb.w & 0xffff0000u);
                    v0 = v0 + acc[ai][bj][m][0]; v1 = v1 + acc[ai][bj][m][1]; st_bf16x8(xb + off + bj * 128, v0, v1);
                    if (outf) { *(f32x4*)(outf + off + bj * 128) = v0; *(f32x4*)(outf + off + bj * 128 + 4) = v1; } sq += dot4(v0) + dot4(v1); }
                sq += lane_xor(sq, 16, fq * 16 + fr); sq += lane_xor(sq, 32, fq * 16 + fr);
                if (fq == 0) ss[(size_t)row * 16 + u.pn * 4 + wc] = sq;
            }
        }
    }
};
struct EpiNull { static constexpr bool PERM = false, AFTER_DRAIN = false; float* sink; __device__ __forceinline__ void operator()(const Acc& acc, const Unit& u, int wr, int wc, int fr, int fq) const { if (acc[0][0][0][0][0] == 123456.789f) sink[0] = 1.f; } };
struct EpiSwiGLU {
    static constexpr bool PERM = true, AFTER_DRAIN = false;
    bf16_t* O; const float* ss;
    __device__ __forceinline__ void operator()(const Acc& acc, const Unit& u, int wr, int wc, int fr, int fq) const {
        const int row0 = u.pm * 256 + wr * 64 + fr, col0 = u.pn * 128 + wc * 32 + 8 * fq;
        float rs8[2][4]; rstd8(ss, row0, fr, fq, rs8);
#pragma unroll
        for (int ai = 0; ai < 2; ++ai)
#pragma unroll
            for (int m = 0; m < 4; ++m) { const int row = row0 + ai * 128 + m * 16; bf16_t* rowp = O + (size_t)row * D_FF + col0; const float rstd = rs8[ai][m];
                u32x4 w;
#pragma unroll
                for (int n = 0; n < 2; ++n) { const f32x4 g = acc[ai][0][m][n] * rstd, up = acc[ai][1][m][n] * rstd; f32x4 v;
#pragma unroll
                    for (int i = 0; i < 4; ++i) v[i] = g[i] * __builtin_amdgcn_rcpf(1.f + __expf(-g[i])) * up[i];
                    w[2 * n] = cvt_pk_bf16(v[0], v[1]); w[2 * n + 1] = cvt_pk_bf16(v[2], v[3]); }
                *(u32x4*)rowp = w; }
    }
};
struct EpiBf16 {
    static constexpr bool PERM = true, AFTER_DRAIN = false;
    bf16_t* O;
    __device__ __forceinline__ void operator()(const Acc& acc, const Unit& u, int wr, int wc, int fr, int fq) const {
        const int row0 = u.pm * 256 + wr * 64 + fr, col0 = u.pn * 256 + wc * 32 + 8 * fq;
#pragma unroll
        for (int ai = 0; ai < 2; ++ai)
#pragma unroll
            for (int m = 0; m < 4; ++m) { bf16_t* rowp = O + (size_t)(row0 + ai * 128 + m * 16) * DM + col0;
#pragma unroll
                for (int bj = 0; bj < 2; ++bj) st_bf16x8(rowp + bj * 128, acc[ai][bj][m][0], acc[ai][bj][m][1]); }
    }
};
#define PG8_BARRIER() do { asm volatile("s_waitcnt lgkmcnt(0)" ::: "memory"); __builtin_amdgcn_s_barrier(); asm volatile("" ::: "memory"); } while (0)
__device__ __forceinline__ void tile_row_rstd(const Acc& acc, float (&rs)[2][4], int wr, int wc, int fr, int fq, PG8_LAS unsigned char* lds) {
    PG8_LAS float* P = (PG8_LAS float*)lds;
#pragma unroll
    for (int ai = 0; ai < 2; ++ai)
#pragma unroll
        for (int m = 0; m < 4; ++m) {
            float ss = (dot4(acc[ai][0][m][0]) + dot4(acc[ai][0][m][1])) + (dot4(acc[ai][1][m][0]) + dot4(acc[ai][1][m][1]));
            ss += lane_xor(ss, 16, fq * 16 + fr); ss += lane_xor(ss, 32, fq * 16 + fr);
            if (fq == 0) P[(ai * 128 + wr * 64 + m * 16 + fr) * 4 + wc] = ss;
        }
    PG8_BARRIER();
#pragma unroll
    for (int ai = 0; ai < 2; ++ai)
#pragma unroll
        for (int m = 0; m < 4; ++m) { const f32x4 p = *(const PG8_LAS f32x4*)(P + (ai * 128 + wr * 64 + m * 16 + fr) * 4); rs[ai][m] = rsqrtf(((p[0] + p[1]) + (p[2] + p[3])) * (1.f / 256.f) + NORM_EPS); }
}
struct EpiQProj {
    static constexpr bool PERM = true, AFTER_DRAIN = true;
    bf16_t* O; const float* g; const float* ss;
    __device__ __forceinline__ void fused(Acc& acc, const Unit& u, int wr, int wc, int fr, int fq, PG8_LAS unsigned char* lds, int wid, int lane) const {
        const int row0 = u.pm * 256 + wr * 64 + fr, cl = wc * 32 + 8 * fq;
        float rs8[2][4]; rstd8(ss, row0, fr, fq, rs8);
#pragma unroll
        for (int ai = 0; ai < 2; ++ai)
#pragma unroll
            for (int m = 0; m < 4; ++m) { const float rstd = rs8[ai][m];
#pragma unroll
                for (int bj = 0; bj < 2; ++bj)
#pragma unroll
                    for (int n = 0; n < 2; ++n) acc[ai][bj][m][n] = acc[ai][bj][m][n] * rstd; }
        float rs[2][4]; tile_row_rstd(acc, rs, wr, wc, fr, fq, lds);
#pragma unroll
        for (int bj = 0; bj < 2; ++bj) { const f32x4 g0 = *(const f32x4*)(g + cl + bj * 128), g1 = *(const f32x4*)(g + cl + bj * 128 + 4);
#pragma unroll
            for (int ai = 0; ai < 2; ++ai)
#pragma unroll
                for (int m = 0; m < 4; ++m) st_bf16x8(O + (size_t)(row0 + ai * 128 + m * 16) * DM + u.pn * 256 + cl + bj * 128, acc[ai][bj][m][0] * rs[ai][m] * g0, acc[ai][bj][m][1] * rs[ai][m] * g1); }
    }
};
struct EpiKV {
    static constexpr bool PERM = false, AFTER_DRAIN = true;
    bf16_t* KN; bf16_t* VT; const float* g;
    __device__ __forceinline__ void fused(Acc& acc, const Unit& u, int wr, int wc, int fr, int fq, PG8_LAS unsigned char* lds, int wid, int lane) const {
        const int l = u.aux;
        if (u.pn < 4) {
            float rs[2][4]; tile_row_rstd(acc, rs, wr, wc, fr, fq, lds);
            bf16_t* Ob = KN + (size_t)l * NMEM * DM; const float* gl = g + l * 256;
            const int row0 = u.pm * 256 + wr * 64 + fr, cl = wc * 32 + 4 * fq;
#pragma unroll
            for (int bj = 0; bj < 2; ++bj)
#pragma unroll
                for (int n = 0; n < 2; ++n) { const f32x4 gv = *(const f32x4*)(gl + cl + bj * 128 + n * 16);
#pragma unroll
                    for (int ai = 0; ai < 2; ++ai)
#pragma unroll
                        for (int m = 0; m < 4; ++m) st_bf16x4(Ob + (size_t)(row0 + ai * 128 + m * 16) * DM + u.pn * 256 + cl + bj * 128 + n * 16, acc[ai][bj][m][n] * rs[ai][m] * gv); }
        } else {
            bf16_t* Ob = VT + ((size_t)(l * 4 + u.pm) * 4 + (u.pn - 4)) * 65536;
            const int r0 = wr * 64 + fr, c0 = wc * 32 + 4 * fq;
#pragma unroll
            for (int ai = 0; ai < 2; ++ai)
#pragma unroll
                for (int m = 0; m < 4; ++m)
#pragma unroll
                    for (int bj = 0; bj < 2; ++bj)
#pragma unroll
                        for (int n = 0; n < 2; ++n)
#pragma unroll
                            for (int i = 0; i < 4; ++i) Ob[(size_t)(c0 + bj * 128 + n * 16 + i) * 256 + r0 + ai * 128 + m * 16] = (bf16_t)f2bf(acc[ai][bj][m][n][i]);
        }
    }
};
struct EpiSoftmax {
    static constexpr bool PERM = true, AFTER_DRAIN = true;
    bf16_t* O;
    __device__ __forceinline__ void fused(Acc& acc, const Unit& u, int wr, int wc, int fr, int fq, PG8_LAS unsigned char* lds, int wid, int lane) const {
        PG8_LAS float* P = (PG8_LAS float*)lds; PG8_LAS float* P2 = (PG8_LAS float*)(lds + 4096);
        const float sc = 0.0625f * LOG2E;
#pragma unroll
        for (int ai = 0; ai < 2; ++ai)
#pragma unroll
            for (int m = 0; m < 4; ++m) {
                float mx = -INFINITY;
#pragma unroll
                for (int bj = 0; bj < 2; ++bj)
#pragma unroll
                    for (int n = 0; n < 2; ++n) { const f32x4 a = acc[ai][bj][m][n]; mx = fmaxf(mx, fmaxf(fmaxf(a[0], a[1]), fmaxf(a[2], a[3]))); }
                mx = fmaxf(mx, lane_xor(mx, 16, fq * 16 + fr)); mx = fmaxf(mx, lane_xor(mx, 32, fq * 16 + fr));
                if (fq == 0) P[(ai * 128 + wr * 64 + m * 16 + fr) * 4 + wc] = mx;
            }
        PG8_BARRIER();
#pragma unroll
        for (int ai = 0; ai < 2; ++ai)
#pragma unroll
            for (int m = 0; m < 4; ++m) {
                const int row = ai * 128 + wr * 64 + m * 16 + fr;
                const f32x4 p = *(const PG8_LAS f32x4*)(P + row * 4); const float mx = fmaxf(fmaxf(p[0], p[1]), fmaxf(p[2], p[3])) * sc;
                float s = 0.f;
#pragma unroll
                for (int bj = 0; bj < 2; ++bj)
#pragma unroll
                    for (int n = 0; n < 2; ++n) { f32x4 a = acc[ai][bj][m][n];
#pragma unroll
                        for (int i = 0; i < 4; ++i) { a[i] = __builtin_amdgcn_exp2f(a[i] * sc - mx); s += a[i]; }
                        acc[ai][bj][m][n] = a; }
                s += lane_xor(s, 16, fq * 16 + fr); s += lane_xor(s, 32, fq * 16 + fr);
                if (fq == 0) P2[row * 4 + wc] = s;
            }
        PG8_BARRIER();
        const int row0 = u.pm * 256 + wr * 64 + fr, col0 = u.pn * 256 + wc * 32 + 8 * fq;
#pragma unroll
        for (int ai = 0; ai < 2; ++ai)
#pragma unroll
            for (int m = 0; m < 4; ++m) {
                const int row = ai * 128 + wr * 64 + m * 16 + fr;
                const f32x4 p = *(const PG8_LAS f32x4*)(P2 + row * 4); const float inv = __builtin_amdgcn_rcpf((p[0] + p[1]) + (p[2] + p[3]));
                bf16_t* rowp = O + (size_t)(row0 + ai * 128 + m * 16) * DM + col0;
#pragma unroll
                for (int bj = 0; bj < 2; ++bj) st_bf16x8(rowp + bj * 128, acc[ai][bj][m][0] * inv, acc[ai][bj][m][1] * inv);
            }
    }
};
}
namespace attn_body {
using bf16=__hip_bfloat16;
using bf16x8=__attribute__((ext_vector_type(8)))short;
using s16x4=__attribute__((ext_vector_type(4)))short;
using f32x16=__attribute__((ext_vector_type(16)))float;
using u32x4=__attribute__((ext_vector_type(4)))unsigned;
constexpr int BATCH=4,NHEAD=16,SEQ=4096,D=64,PQ=3584,PO=1024;
constexpr int NW=8,QBLK=32,QB=QBLK*NW,KVBLK=64,NQB=SEQ/QB;
constexpr int ATTN_UNIT_ROWS=QB;
__device__ __forceinline__ int crow(int r,int hi){return (r&3)+8*(r>>2)+4*hi;}
#define SBAR() __builtin_amdgcn_sched_barrier(0)
__device__ __forceinline__ void cmask(f32x16&p0,f32x16&p1,int jb,int qrel,int hi){
  const float NEG=-INFINITY; int kb=64*jb+4*hi;
  #pragma unroll
  for(int r=0;r<16;++r){int kv=kb+(r&3)+8*(r>>2); if(kv>qrel)p0[r]=NEG; if(kv+32>qrel)p1[r]=NEG;}
}

constexpr int NSLOT=3, SLOTB=8192;
constexpr int LDS_K=0, LDS_V=NSLOT*SLOTB, LDS_WS=2*NSLOT*SLOTB, LDS_OST=LDS_WS+NW*64*4, LDS_BYTES=LDS_OST+NW*4096;
constexpr float C2=0.125f*1.4426950408889634f;
__device__ __forceinline__ void glds16(const void*gsrc,unsigned lds_dst){unsigned keep;
  asm volatile("s_mov_b32 %0, m0\n\ts_mov_b32 m0, %2\n\ts_nop 0\n\tglobal_load_lds_dwordx4 %1, off\n\ts_mov_b32 m0, %0":"=&s"(keep):"v"(gsrc),"s"(lds_dst):"memory");}
__device__ __forceinline__ float max3f(float a,float b,float c){float r;asm("v_max3_f32 %0, %1, %2, %3":"=v"(r):"v"(a),"v"(b),"v"(c));return r;}
__device__ __forceinline__ float max2f(float a,float b){float r;asm("v_max_f32_e32 %0, %1, %2":"=v"(r):"v"(a),"v"(b));return r;}
__device__ __forceinline__ float fadd_s(float a,float b){float r;asm("v_add_f32_e32 %0, %1, %2":"=v"(r):"v"(a),"v"(b));return r;}
__device__ __forceinline__ float fsub_s(float a,float b){float r;asm("v_sub_f32_e32 %0, %1, %2":"=v"(r):"v"(a),"v"(b));return r;}
typedef float f32x2_t __attribute__((ext_vector_type(2))); typedef __bf16 bf16x2_t __attribute__((ext_vector_type(2)));
__device__ __forceinline__ unsigned cvtpk_s(float lo,float hi){f32x2_t v={lo,hi};bf16x2_t b=__builtin_convertvector(v,bf16x2_t);return __builtin_bit_cast(unsigned,b);}
#define WAIT_BAR(N) asm volatile("s_waitcnt vmcnt(" #N ") lgkmcnt(0)\n\ts_barrier":::"memory")

__device__ __forceinline__ void qkt(f32x16&p0,f32x16&p1,const char*Kslot,const bf16x8*qr,const f32x16&negm,int r32,int hi){
  const char*kb=Kslot+hi*1024+r32*16;
  #pragma unroll
  for(int d0=0;d0<4;++d0){
    const bf16x8 b0=*reinterpret_cast<const bf16x8*>(kb+d0*2048);
    const bf16x8 b1=*reinterpret_cast<const bf16x8*>(kb+d0*2048+512);
    if(d0==0){p0=__builtin_amdgcn_mfma_f32_32x32x16_bf16(b0,qr[0],negm,0,0,0);p1=__builtin_amdgcn_mfma_f32_32x32x16_bf16(b1,qr[0],negm,0,0,0);}
    else{p0=__builtin_amdgcn_mfma_f32_32x32x16_bf16(b0,qr[d0],p0,0,0,0);p1=__builtin_amdgcn_mfma_f32_32x32x16_bf16(b1,qr[d0],p1,0,0,0);}}
}
typedef __attribute__((address_space(3))) const char* lds_cptr;
typedef short v4i16_t __attribute__((ext_vector_type(4)));
__device__ __forceinline__ void kload8(bf16x8*kf,lds_cptr kp){
  kf[0]=*(const __attribute__((address_space(3))) bf16x8*)(kp);      kf[1]=*(const __attribute__((address_space(3))) bf16x8*)(kp+512);
  kf[2]=*(const __attribute__((address_space(3))) bf16x8*)(kp+2048); kf[3]=*(const __attribute__((address_space(3))) bf16x8*)(kp+2560);
  kf[4]=*(const __attribute__((address_space(3))) bf16x8*)(kp+4096); kf[5]=*(const __attribute__((address_space(3))) bf16x8*)(kp+4608);
  kf[6]=*(const __attribute__((address_space(3))) bf16x8*)(kp+6144); kf[7]=*(const __attribute__((address_space(3))) bf16x8*)(kp+6656);
}
__device__ __forceinline__ void kload2(bf16x8*kf,lds_cptr kp,int j){ kf[2*j]=*(const __attribute__((address_space(3))) bf16x8*)(kp+j*2048); kf[2*j+1]=*(const __attribute__((address_space(3))) bf16x8*)(kp+j*2048+512); }
__device__ __forceinline__ s16x4 vtr(lds_cptr p){ return __builtin_bit_cast(s16x4,__builtin_amdgcn_ds_read_tr16_b64_v4i16((__attribute__((address_space(3))) v4i16_t*)p)); }
__device__ __forceinline__ float rowmax(const f32x16&p0,const f32x16&p1){
  float a=max3f(p0[0],p0[1],p1[0]),b=max3f(p0[2],p0[3],p1[1]);a=max3f(a,p1[2],p1[3]);
  #pragma unroll
  for(int r=4;r<16;r+=4){a=max3f(a,p0[r],p0[r+1]);b=max3f(b,p0[r+2],p0[r+3]);a=max3f(a,p1[r],p1[r+1]);b=max3f(b,p1[r+2],p1[r+3]);}
  const float m=max2f(a,b);
  auto rr=__builtin_amdgcn_permlane32_swap(__float_as_uint(m),__float_as_uint(m),false,false);
  return max2f(__uint_as_float(rr[0]),__uint_as_float(rr[1]));
}
__device__ __forceinline__ void pv(f32x16*o,int vb,bf16x8 pa0,bf16x8 pa1,bf16x8 pa2,bf16x8 pa3){
  #pragma unroll
  for(int d0=0;d0<2;++d0){s16x4 lo[4],hi[4];
    #pragma unroll
    for(int ks=0;ks<4;++ks){
      asm volatile("ds_read_b64_tr_b16 %0,%1 offset:%c2":"=&v"(lo[ks]):"v"(vb),"i"(d0*4096+ks*1024):"memory");
      asm volatile("ds_read_b64_tr_b16 %0,%1 offset:%c2":"=&v"(hi[ks]):"v"(vb),"i"(d0*4096+ks*1024+512):"memory");}
    asm volatile("s_waitcnt lgkmcnt(0)":::"memory");SBAR();
    #define PK(k) (bf16x8){lo[k][0],lo[k][1],lo[k][2],lo[k][3],hi[k][0],hi[k][1],hi[k][2],hi[k][3]}
    o[d0]=__builtin_amdgcn_mfma_f32_32x32x16_bf16(pa0,PK(0),o[d0],0,0,0);
    o[d0]=__builtin_amdgcn_mfma_f32_32x32x16_bf16(pa1,PK(1),o[d0],0,0,0);
    o[d0]=__builtin_amdgcn_mfma_f32_32x32x16_bf16(pa2,PK(2),o[d0],0,0,0);
    o[d0]=__builtin_amdgcn_mfma_f32_32x32x16_bf16(pa3,PK(3),o[d0],0,0,0);
    #undef PK
  }
}

#ifndef ATTN_STORE16
#define ATTN_STORE16(p,v) (*(u32x4*)(p)=(v))
#endif
template<int THRL> __device__ __forceinline__ void attn_unit(int b,int h,int qb,const bf16*Q,const bf16*__restrict__ K,const bf16*__restrict__ V,bf16*O,char*shm,int tid_in){
  int tid_l=tid_in; asm volatile("":"+v"(tid_l)); const int tid=tid_l,lane=tid&63,r32=lane&31,hi=lane>>5; const int wid=__builtin_amdgcn_readfirstlane(tid>>6);
  const long rowbase=(long)b*SEQ; const int q0=qb*QB;
  const bf16*Qw=Q+(rowbase+q0+wid*QBLK)*PQ+(h>>1)*D;
  const bf16*Kh=K+rowbase*PQ+512+(h>>1)*D,*Vh=V+rowbase*PQ+1024+(h>>2)*128+(h&1)*D;
  const unsigned lds0=(unsigned)(uintptr_t)shm;
  float*wsf=(float*)(shm+LDS_WS)+wid*64;
  const bf16*ksrc=Kh+(long)lane*PQ+wid*8;
  const bf16*vsrc=Vh+(long)(16*(wid&3)+(lane>>2))*PQ+(wid>>2)*32+(lane&3)*8;
  const unsigned kdst=lds0+LDS_K+wid*1024, vdst=lds0+LDS_V+wid*1024;
  #define DMA_K(t,slot) glds16(ksrc+(long)(t)*KVBLK*PQ,(unsigned)__builtin_amdgcn_readfirstlane(kdst+(slot)))
  #define DMA_V(t,slot) glds16(vsrc+(long)(t)*KVBLK*PQ,(unsigned)__builtin_amdgcn_readfirstlane(vdst+(slot)))
  const int vb0=(int)(lds0+LDS_V)+((lane>>4)&1)*32+(lane&3)*8+(4*hi+((lane&15)>>2))*64;
  const char*Kbase=shm+LDS_K; bf16x8 kf[8];
  const lds_cptr shm3=(lds_cptr)shm; const lds_cptr kp0=shm3+LDS_K+hi*1024+r32*16; const lds_cptr vp0=shm3+LDS_V+((lane>>4)&1)*32+(lane&3)*8+(4*hi+((lane&15)>>2))*64;
  const int NT=(q0+QB)/KVBLK;
  DMA_K(0,0);DMA_V(0,0);DMA_K(1,SLOTB);
  bf16x8 qr[4];
  #pragma unroll
  for(int d0=0;d0<4;++d0)qr[d0]=*reinterpret_cast<const bf16x8*>(&Qw[(long)r32*PQ+d0*16+hi*8]);
  float mhat=0.f,l_reg=0.f;f32x16 o[2];o[0]=f32x16{};o[1]=f32x16{};f32x16 negm=f32x16{};asm volatile("":"+v"(negm));
  const int qrel=wid*QBLK+r32;
  #define CMASK(P0,P1,t) do{int jb_=(t)-(NT-4); if(jb_>=0)cmask(P0,P1,jb_,qrel,hi);}while(0)
  bool resc=false;
  #define START(P0,P1) do{ const float rm=rowmax(P0,P1); resc=false; \
    { const float dl=rm; mhat=fadd_s(mhat,dl); \
      _Pragma("unroll") for(int r=0;r<16;++r){P0[r]=fsub_s(P0[r],dl);P1[r]=fsub_s(P1[r],dl);} \
      _Pragma("unroll") for(int r=0;r<16;++r)negm[r]=-mhat; asm volatile("":"+v"(negm)); } \
    _Pragma("unroll") for(int r=0;r<16;++r)P0[r]=__builtin_amdgcn_exp2f(P0[r]); }while(0)
  #define RESC() do{ if(resc){ asm volatile("s_waitcnt lgkmcnt(0)":::"memory"); \
      _Pragma("unroll") for(int d_=0;d_<2;++d_) _Pragma("unroll") for(int r=0;r<16;++r)o[d_][r]*=wsf[crow(r,hi)]; } }while(0)
  f32x16 pA0,pA1,pB0,pB1;
  int sl_prev=0,sl_cur=0,sl_next=SLOTB;
  #define ROT() do{sl_prev=sl_cur;sl_cur=sl_next;sl_next=(sl_next==(NSLOT-1)*SLOTB)?0:sl_next+SLOTB;}while(0)
  DMA_K(2,2*SLOTB);
  WAIT_BAR(3);
  qkt(pA0,pA1,Kbase,qr,negm,r32,hi);asm volatile("s_nop 15\n\ts_nop 7":"+v"(pA0),"+v"(pA1));CMASK(pA0,pA1,0);
  START(pA0,pA1);
  _Pragma("unroll") for(int r=0;r<16;++r)pA1[r]=__builtin_amdgcn_exp2f(pA1[r]);
  WAIT_BAR(0);
  DMA_K(3,0);DMA_V(1,SLOTB);
  ROT();
  kload8(kf,kp0+sl_cur);
  WAIT_BAR(2);
  s16x4 vlo[8],vhi[8]; u32x4 pw0,pw1,pw2,pw3;
  #define PKW(P,B) cvtpk_s(P[B],P[B+1])
  #define PAF(k) __builtin_bit_cast(bf16x8,pw##k)
  #define VFR(i) (bf16x8){vlo[i][0],vlo[i][1],vlo[i][2],vlo[i][3],vhi[i][0],vhi[i][1],vhi[i][2],vhi[i][3]}
  #define PIN(x) asm volatile("":"+v"(x))
  #define MX3(a,b,c) __builtin_fmaxf(__builtin_fmaxf((a),(b)),(c))
  #define GAPA(MF,A0,A1,A2,A3,W0,W1,PW) do{ MF; sacc+=A0; sacc+=A1; sacc+=A2; sacc+=A3; PIN(sacc); W0; W1; PIN(PW); SBAR(); }while(0)
  #define EX(v) __builtin_amdgcn_exp2f(v)
  #define GAPB(MF,X,B) do{ MF; X[B]=EX(X[B]); X[B+1]=EX(X[B+1]); X[B+2]=EX(X[B+2]); X[B+3]=EX(X[B+3]); PIN(X); SBAR(); }while(0)
  #define VRD(i) do{ vlo[i]=vtr(vp_+(((i)>>2)*4096+((i)&3)*1024)); vhi[i]=vtr(vp_+(((i)>>2)*4096+((i)&3)*1024+512)); }while(0)
  #define KRD(G,j) do{ if(G){ kload2(kf,kp0+sl_next,j); SBAR(); } }while(0)
  #define STEP(C0,C1,P0,P1,t,GK,GV,GL) do{ SBAR(); \
    const lds_cptr vp_=vp0+sl_prev; \
    VRD(0); SBAR(); float sacc=(P0[0]+P0[1]); \
    GAPA(C0=__builtin_amdgcn_mfma_f32_32x32x16_bf16(kf[0],qr[0],negm,0,0,0), P0[2],P0[3],P0[4],P0[5],     pw0[0]=PKW(P0,0), pw0[1]=PKW(P0,2), pw0); \
    VRD(4); SBAR(); GAPA(C1=__builtin_amdgcn_mfma_f32_32x32x16_bf16(kf[1],qr[0],negm,0,0,0), P0[6],P0[7],P0[8],P0[9],     pw0[2]=PKW(P0,4), pw0[3]=PKW(P0,6), pw0); \
    VRD(1); SBAR(); GAPA(C0=__builtin_amdgcn_mfma_f32_32x32x16_bf16(kf[2],qr[1],C0,0,0,0),   P0[10],P0[11],P0[12],P0[13], pw1[0]=PKW(P0,8), pw1[1]=PKW(P0,10), pw1); \
    VRD(5); SBAR(); GAPA(C1=__builtin_amdgcn_mfma_f32_32x32x16_bf16(kf[3],qr[1],C1,0,0,0),   P0[14],P0[15],P1[0],P1[1],   pw1[2]=PKW(P0,12),pw1[3]=PKW(P0,14), pw1); \
    VRD(2); SBAR(); GAPA(C0=__builtin_amdgcn_mfma_f32_32x32x16_bf16(kf[4],qr[2],C0,0,0,0),   P1[2],P1[3],P1[4],P1[5],     pw2[0]=PKW(P1,0), pw2[1]=PKW(P1,2), pw2); \
    VRD(6); SBAR(); GAPA(C1=__builtin_amdgcn_mfma_f32_32x32x16_bf16(kf[5],qr[2],C1,0,0,0),   P1[6],P1[7],P1[8],P1[9],     pw2[2]=PKW(P1,4), pw2[3]=PKW(P1,6), pw2); \
    VRD(3); SBAR(); GAPA(C0=__builtin_amdgcn_mfma_f32_32x32x16_bf16(kf[6],qr[3],C0,0,0,0),   P1[10],P1[11],P1[12],P1[13], pw3[0]=PKW(P1,8), pw3[1]=PKW(P1,10), pw3); \
    VRD(7); SBAR(); GAPA(C1=__builtin_amdgcn_mfma_f32_32x32x16_bf16(kf[7],qr[3],C1,0,0,0),   P1[14],P1[15],0.f,0.f,       pw3[2]=PKW(P1,12),pw3[3]=PKW(P1,14), pw3); \
    l_reg+=sacc; \
    if(GK){DMA_K((t)+3,sl_cur);} if(GV){DMA_V((t)+1,sl_next);} \
    CMASK(C0,C1,t); \
    { float a=MX3(C0[0],C0[1],C1[0]),b=MX3(C0[2],C0[3],C1[1]); a=MX3(a,C1[2],C1[3]); \
      _Pragma("unroll") for(int r=4;r<16;r+=4){a=MX3(a,C0[r],C0[r+1]);b=MX3(b,C0[r+2],C0[r+3]);a=MX3(a,C1[r],C1[r+1]);b=MX3(b,C1[r+2],C1[r+3]);} \
      float rm=__builtin_fmaxf(a,b); { auto rr=__builtin_amdgcn_permlane32_swap(__float_as_uint(rm),__float_as_uint(rm),false,false); rm=__builtin_fmaxf(__uint_as_float(rr[0]),__uint_as_float(rr[1])); } \
      resc=false; \
      if(__builtin_expect(__any(rm>(float)THRL),0)){ const float dl=__builtin_fmaxf(rm,0.f); mhat+=dl; \
        _Pragma("unroll") for(int r=0;r<16;++r){C0[r]-=dl;C1[r]-=dl;} \
        _Pragma("unroll") for(int r=0;r<16;++r)negm[r]=-mhat; asm volatile("":"+v"(negm)); \
        const float f=__builtin_amdgcn_exp2f(-dl); l_reg*=f; if(hi==0)wsf[r32]=f; resc=true; } } \
    SBAR(); \
    GAPB(o[0]=__builtin_amdgcn_mfma_f32_32x32x16_bf16(PAF(0),VFR(0),o[0],0,0,0), C0,0); \
    GAPB(o[1]=__builtin_amdgcn_mfma_f32_32x32x16_bf16(PAF(0),VFR(4),o[1],0,0,0), C0,4); \
    KRD(GL,0); GAPB(o[0]=__builtin_amdgcn_mfma_f32_32x32x16_bf16(PAF(1),VFR(1),o[0],0,0,0), C0,8); \
    KRD(GL,1); GAPB(o[1]=__builtin_amdgcn_mfma_f32_32x32x16_bf16(PAF(1),VFR(5),o[1],0,0,0), C0,12); \
    KRD(GL,2); GAPB(o[0]=__builtin_amdgcn_mfma_f32_32x32x16_bf16(PAF(2),VFR(2),o[0],0,0,0), C1,0); \
    KRD(GL,3); GAPB(o[1]=__builtin_amdgcn_mfma_f32_32x32x16_bf16(PAF(2),VFR(6),o[1],0,0,0), C1,4); \
    GAPB(o[0]=__builtin_amdgcn_mfma_f32_32x32x16_bf16(PAF(3),VFR(3),o[0],0,0,0), C1,8); \
    GAPB(o[1]=__builtin_amdgcn_mfma_f32_32x32x16_bf16(PAF(3),VFR(7),o[1],0,0,0), C1,12); \
    }while(0)
  int t=1;
  #undef CMASK
  #define CMASK(P0,P1,t) do{}while(0)
  for(;t+5<NT;t+=2){
    STEP(pB0,pB1,pA0,pA1,t,true,true,true);     WAIT_BAR(2); RESC(); ROT();
    STEP(pA0,pA1,pB0,pB1,t+1,true,true,true);   WAIT_BAR(2); RESC(); ROT();
  }
  #undef CMASK
  #define CMASK(P0,P1,t) do{int jb_=(t)-(NT-4); if(jb_>=0)cmask(P0,P1,jb_,qrel,hi);}while(0)
  #define ENDW(tt) do{ if((tt)+3<NT){WAIT_BAR(2);} else if((tt)+2<NT){WAIT_BAR(1);} else {WAIT_BAR(0);} }while(0)
  for(;t+1<NT;t+=2){
    STEP(pB0,pB1,pA0,pA1,t,(t+3<NT),(t+1<NT),(t+1<NT));       ENDW(t);   RESC(); ROT();
    STEP(pA0,pA1,pB0,pB1,t+1,(t+4<NT),(t+2<NT),(t+2<NT));     ENDW(t+1); RESC(); ROT();
  }
  STEP(pB0,pB1,pA0,pA1,NT-1,false,false,false); RESC();
  { float sacc=pB0[0]+pB0[1]; _Pragma("unroll") for(int r=2;r<16;++r)sacc+=pB0[r]; _Pragma("unroll") for(int r=0;r<16;++r)sacc+=pB1[r]; l_reg+=sacc;
    pw0=(u32x4){PKW(pB0,0),PKW(pB0,2),PKW(pB0,4),PKW(pB0,6)};pw1=(u32x4){PKW(pB0,8),PKW(pB0,10),PKW(pB0,12),PKW(pB0,14)};pw2=(u32x4){PKW(pB1,0),PKW(pB1,2),PKW(pB1,4),PKW(pB1,6)};pw3=(u32x4){PKW(pB1,8),PKW(pB1,10),PKW(pB1,12),PKW(pB1,14)};
    SBAR(); pv(o,vb0+sl_cur,PAF(0),PAF(1),PAF(2),PAF(3)); }
  #undef PKW
  #undef PAF
  #undef VFR
  #undef PIN
  #undef MX3
  #undef GAPA
  #undef GAPB
  #undef EX
  #undef VRD
  #undef KRD
  #undef STEP
  #undef ENDW
  {auto rr=__builtin_amdgcn_permlane32_swap(__float_as_uint(l_reg),__float_as_uint(l_reg),false,false);l_reg=__uint_as_float(rr[0])+__uint_as_float(rr[1]);}
  if(hi==0)wsf[32+r32]=l_reg;asm volatile("s_waitcnt lgkmcnt(0)":::"memory");
  float rli[16];
  #pragma unroll
  for(int r=0;r<16;++r)rli[r]=__builtin_amdgcn_rcpf(wsf[32+crow(r,hi)]);
  bf16*Ow=O+(rowbase+q0+wid*QBLK)*PO+h*D;
  { bf16*stg=(bf16*)(shm+LDS_OST)+wid*2048;
    #pragma unroll
    for(int r=0;r<16;++r){const int orow=crow(r,hi);
      #pragma unroll
      for(int d0=0;d0<2;++d0)stg[orow*64+d0*32+r32]=__float2bfloat16(o[d0][r]*rli[r]);}
    asm volatile("s_waitcnt lgkmcnt(0)":::"memory");
    #pragma unroll
    for(int i=0;i<4;++i){const int row=i*8+(lane>>3),ch=lane&7; const u32x4 v=*(const u32x4*)(stg+row*64+ch*8); ATTN_STORE16(Ow+(long)row*PO+ch*8,v);} }
  asm volatile("s_waitcnt lgkmcnt(0)\n\ts_barrier":::"memory");
  #undef DMA_K
  #undef DMA_V
  #undef CMASK
  #undef START
  #undef RESC
  #undef ROT
}
constexpr int ATTN_LDS_BYTES=LDS_BYTES;
#undef SBAR
#undef WAIT_BAR
}

#define XB_TMO      128
#define XB_XCNT(j)  (256  + 64 * (j))
#define XB_XSUB(j)  (1280 + 64 * (j))
#define XB_XGEN(j)  (2304 + 64 * (j))
#define XB_TOP      3328
#define XB_TOPGEN   3392
#define XCD_BAR_WORDS 3456
#define XB_SPIN_CAP (1u << 18)

__device__ __forceinline__ unsigned xb_ld(unsigned* p)              { return __hip_atomic_load(p, __ATOMIC_RELAXED, __HIP_MEMORY_SCOPE_AGENT); }
__device__ __forceinline__ unsigned xb_add(unsigned* p, unsigned v) { return __hip_atomic_fetch_add(p, v, __ATOMIC_RELAXED, __HIP_MEMORY_SCOPE_AGENT); }
__device__ __forceinline__ unsigned xb_xcc_id() { unsigned r; asm volatile("s_getreg_b32 %0, hwreg(20, 0, 4)" : "=s"(r)); r &= 0xFu; asm volatile("" : "+v"(r)); return r; }
#define XB_SPIN(cond, bar) do { unsigned _sp = 0; while (cond) { __builtin_amdgcn_s_sleep(1); \
    if ((++_sp & 255u) == 0u) { if (xb_ld(&(bar)[XB_TMO])) break; if (_sp > XB_SPIN_CAP) { atomicAdd(&(bar)[XB_TMO], 1u); break; } } } } while (0)

struct XcdBarrier {
    unsigned* bar; unsigned x;
    volatile LAS unsigned* st;
};

__device__ __forceinline__ XcdBarrier xcd_barrier_post(unsigned* bar, volatile LAS unsigned* st, int tid) {
    XcdBarrier b; b.bar = bar; b.x = xb_xcc_id(); b.st = st;
    if (tid == 0) (void)xb_add(&bar[XB_XCNT(b.x)], 1u);
    return b;
}
__device__ __forceinline__ void xcd_barrier_complete(unsigned* bar, unsigned x, unsigned& nloc, unsigned& nx) {
    const unsigned G = gridDim.x * gridDim.y * gridDim.z;
    unsigned sum, cnt, mine, sp = 0u;
    for (;;) {
        sum = 0u; cnt = 0u; mine = 0u;
#pragma unroll
        for (unsigned j = 0; j < 16; ++j) { const unsigned c = xb_ld(&bar[XB_XCNT(j)]); sum += c; cnt += (c > 0u) ? 1u : 0u; mine = (j == x) ? c : mine; }
        if (sum == G) break;
        __builtin_amdgcn_s_sleep(1);
        if ((++sp & 255u) == 0u) { if (xb_ld(&bar[XB_TMO])) break; if (sp > XB_SPIN_CAP) { atomicAdd(&bar[XB_TMO], 1u); break; } }
    }
    nloc = mine > 0u ? mine : 1u; nx = cnt > 0u ? cnt : 1u;
}

__device__ __forceinline__ void xcd_barrier(const XcdBarrier& b, int tid) {
    asm volatile("s_waitcnt vmcnt(0)" ::: "memory");
    __syncthreads();
    if (tid == 0) {
        unsigned* bar = b.bar;
        __builtin_amdgcn_s_waitcnt(0);
        unsigned nloc = b.st[0], nx = b.st[1];
        if (nloc == 0u) { xcd_barrier_complete(bar, b.x, nloc, nx); b.st[0] = nloc; b.st[1] = nx; }
        const unsigned old = xb_add(&bar[XB_XSUB(b.x)], 1u);
        const unsigned gen = old / nloc;
        if (old + 1u == (gen + 1u) * nloc) {
            __builtin_amdgcn_fence(__ATOMIC_RELEASE, "agent");
            asm volatile("s_waitcnt vmcnt(0)" ::: "memory");
            const unsigned og = xb_add(&bar[XB_TOP], 1u);
            const unsigned tg = og / nx;
            if (og + 1u == (tg + 1u) * nx) xb_add(&bar[XB_TOPGEN], 1u);
            else XB_SPIN(xb_ld(&bar[XB_TOPGEN]) == tg, bar);
            __builtin_amdgcn_fence(__ATOMIC_ACQUIRE, "agent");
            xb_add(&bar[XB_XGEN(b.x)], 1u);
            asm volatile("s_waitcnt vmcnt(0)" ::: "memory");
        } else {
            XB_SPIN(xb_ld(&bar[XB_XGEN(b.x)]) == gen, bar);
            __builtin_amdgcn_fence(__ATOMIC_ACQUIRE, "agent");
            asm volatile("s_waitcnt vmcnt(0)" ::: "memory");
        }
    }
    __syncthreads();
}


namespace mk {
struct Params { const float* in[32]; float* out; unsigned char* ws; };
enum { I_X = 0, I_MEM, I_NMIX, I_WIN, I_WOUT, I_QG, I_KG, I_LQ1, I_LK1, I_LQ2, I_LK2, I_SUBG, I_SCW, I_SCB, I_SDTB, I_SALOG, I_SD, I_SNG,
       I_GCW, I_GALOG, I_GDTB, I_GNG, I_NX, I_NMEM, I_WCQ, I_WCKV, I_XQG, I_XKG, I_WCO, I_NFFN, I_WGU, I_WDN };
#define GAS __attribute__((address_space(1)))
__device__ __forceinline__ const float* pin(const Params& p, int i) { asm volatile("" : "+s"(i)); const GAS float* w = (const GAS float*)p.in[i]; asm volatile("" : "+s"(w)); return (const float*)w; }
__device__ __forceinline__ unsigned char* wsp(const Params& p) { GAS unsigned char* w = (GAS unsigned char*)p.ws; asm volatile("" : "+s"(w)); return (unsigned char*)w; }
__device__ __forceinline__ float* outp(const Params& p) { GAS float* w = (GAS float*)p.out; asm volatile("" : "+s"(w)); return (float*)w; }
constexpr size_t MiB = 1u << 20;
constexpr size_t WS_CTL = 0, CTL_BYTES = 64 * 1024;
constexpr size_t WS_SS = 128 * 1024;
constexpr size_t WS_WIN = 1 * MiB, WS_WOUT = 9 * MiB, WS_WCQ = 11 * MiB, WS_WCO = 13 * MiB, WS_WGU = 15 * MiB, WS_WDN = 26 * MiB;
constexpr size_t WS_WCKV = 32 * MiB;
constexpr size_t WS_MEMN = 48 * MiB;
constexpr size_t WS_KN = 56 * MiB;
constexpr size_t WS_VT = 64 * MiB;
constexpr size_t WS_H = 72 * MiB;
constexpr size_t WS_SM = 104 * MiB;
constexpr size_t WS_PROJ = 106 * MiB;
constexpr size_t WS_AO = 218 * MiB;
constexpr size_t WS_CAT = 250 * MiB;
constexpr size_t WS_YS = 282 * MiB;
constexpr size_t WS_ST = 298 * MiB;
constexpr size_t WS_HP = 314 * MiB;
constexpr size_t WS_CM = 322 * MiB;
constexpr size_t WS_EA = 330 * MiB;
constexpr size_t WS_OG = 331 * MiB;
constexpr size_t WS_SSP = 347 * MiB;
constexpr size_t WS_END = 352 * MiB;
__device__ __forceinline__ size_t woff(int which, int par) {
    if (par == 0) return which == 0 ? WS_WIN : which == 1 ? WS_WOUT : which == 2 ? WS_WCQ : which == 3 ? WS_WCO : WS_WGU;
    return which == 0 ? 32 * MiB : which == 1 ? 39 * MiB + MiB / 2 : which == 2 ? 41 * MiB + MiB / 2 : which == 3 ? 350 * MiB : 43 * MiB + MiB / 2;
}
constexpr size_t GO_W = 0, GO_QG = 8 * MiB, GO_ATT = 16 * MiB, GO_KGT = 24 * MiB;
constexpr size_t WS_GU = WS_CAT;
constexpr int LDS_BYTES = 160 * 1024;
constexpr int LDS_SLOT = LDS_BYTES - 256;

__device__ __forceinline__ void lds_wait() { asm volatile("s_waitcnt lgkmcnt(0)" ::: "memory"); }

#define TSW(n, t) ((n) * 136 + (((((t) >> 3) ^ (((n) >> 3) & 7))) << 3) + ((t) & 7))
template <int M, int N, int K, bool SWA = false, bool SWB = false, class Epi>
__device__ __forceinline__ void mm16(const LAS bf16_t* A, int lda, const LAS bf16_t* Bt, int ldb, int wid, int lane, Epi epi) {
    const int fr = lane & 15, fq = lane >> 4;
    constexpr int NB = N / 16, NBLK = (M / 16) * NB;
    for (int blk = wid; blk < NBLK; blk += 8) {
        const int mb = blk / NB, nb = blk % NB;
        f32x4 acc = {0.f, 0.f, 0.f, 0.f};
        const int ra = mb * 16 + fr, rb = nb * 16 + fr;
        const LAS bf16_t* ap = A + ra * lda; const LAS bf16_t* bp = Bt + rb * ldb;
        const int sa = SWA ? ((ra >> 3) & 7) : 0, sb = SWB ? ((rb >> 3) & 7) : 0;
#pragma unroll
        for (int k0 = 0; k0 < K; k0 += 32) acc = __builtin_amdgcn_mfma_f32_16x16x32_bf16(*(const LAS bf16x8*)(ap + ((((k0 >> 3) + fq) ^ sa) << 3)), *(const LAS bf16x8*)(bp + ((((k0 >> 3) + fq) ^ sb) << 3)), acc, 0, 0, 0);
#pragma unroll
        for (int i = 0; i < 4; ++i) epi(mb * 16 + fq * 4 + i, nb * 16 + fr, acc[i]);
    }
}

template <int M, int N, int K, bool SWA = false, bool SWB = false, class Epi>
__device__ __forceinline__ void mm16v(const LAS bf16_t* A, int lda, const LAS bf16_t* Bt, int ldb, int wid, int lane, Epi epi) {
    const int fr = lane & 15, fq = lane >> 4;
    constexpr int NB = N / 16, NBLK = (M / 16) * NB;
    for (int blk = wid; blk < NBLK; blk += 8) {
        const int mb = blk / NB, nb = blk % NB;
        f32x4 acc = {0.f, 0.f, 0.f, 0.f};
        const int ra = mb * 16 + fr, rb = nb * 16 + fr;
        const LAS bf16_t* ap = A + ra * lda; const LAS bf16_t* bp = Bt + rb * ldb;
        const int sa = SWA ? ((ra >> 3) & 7) : 0, sb = SWB ? ((rb >> 3) & 7) : 0;
#pragma unroll
        for (int k0 = 0; k0 < K; k0 += 32) acc = __builtin_amdgcn_mfma_f32_16x16x32_bf16(*(const LAS bf16x8*)(ap + ((((k0 >> 3) + fq) ^ sa) << 3)), *(const LAS bf16x8*)(bp + ((((k0 >> 3) + fq) ^ sb) << 3)), acc, 0, 0, 0);
        epi(mb * 16 + fq * 4, nb * 16 + fr, acc);
    }
}

__device__ __forceinline__ int maprow(int mode, int n) {
    if (mode == 0) return n;
    if (mode == 1) { if (n >= 2560 && n < 2564) return 3584 + (n - 2560); if (n >= 3588) return 3588 + (n - 3588); const int c = n < 2560 ? n : n - 4; const int cl = c & 255; return (c & ~255) + 128 * ((cl >> 5) & 1) + 32 * (cl >> 6) + (cl & 31); }
    if (n < D_FF) return (n >> 7) * 256 + (n & 127);
    const int n2 = n - D_FF; return (n2 >> 7) * 256 + 128 + (n2 & 127);
}
__device__ __forceinline__ void transpose_item(const float* W, int K, int N, bf16_t* WT, int mode, LAS float* scr, int item, int lane, const float* gk = nullptr) {
    const int nblk = (N + 63) / 64, kb = item / nblk, nb = item % nblk, k0 = 64 * kb, n0 = 64 * nb;
    const int nq = (lane & 15) * 4; const bool okn = n0 + nq < N;
    f32x4 v[16];
#pragma unroll
    for (int i = 0; i < 16; ++i) { const int kk = 4 * i + (lane >> 4); v[i] = okn ? *(const f32x4*)(W + (size_t)(k0 + kk) * N + n0 + nq) : (f32x4){0.f, 0.f, 0.f, 0.f}; if (gk) v[i] = v[i] * gk[k0 + kk]; }
#pragma unroll
    for (int i = 0; i < 16; ++i) { const int kk = 4 * i + (lane >> 4);
#pragma unroll
        for (int q = 0; q < 4; ++q) scr[kk * 65 + nq + q] = v[i][q]; }
    lds_wait(); asm volatile("" ::: "memory");
    const int c = lane & 7;
#pragma unroll
    for (int j = 0; j < 8; ++j) { const int nn = (lane >> 3) + 8 * j; const int n = n0 + nn; const int row = n < N ? maprow(mode, n) : -1; const LAS float* s = scr + (8 * c) * 65 + nn;
        u32x4 o; o.x = pk2(s[0 * 65], s[1 * 65]); o.y = pk2(s[2 * 65], s[3 * 65]); o.z = pk2(s[4 * 65], s[5 * 65]); o.w = pk2(s[6 * 65], s[7 * 65]);
        if (row >= 0) *(u32x4*)(WT + (size_t)row * K + k0 + 8 * c) = o; }
    lds_wait(); asm volatile("" ::: "memory");
}
__device__ __forceinline__ void norm_row(const float* xrow, const float* g, bf16_t* orow, int lane, f32x4 (&y)[4]) {
    const f32x4* xr = (const f32x4*)xrow + lane; const f32x4* gr = (const f32x4*)g + lane;
    float s = 0.f;
#pragma unroll
    for (int j = 0; j < 4; ++j) { y[j] = xr[64 * j]; s += dot4v(y[j]); }
    const float rstd = rsqrtf(wave_sum(s, lane) * (1.f / DM) + NORM_EPS);
    unsigned long long* o8 = (unsigned long long*)orow + lane;
#pragma unroll
    for (int j = 0; j < 4; ++j) { y[j] = y[j] * rstd * gr[64 * j]; o8[64 * j] = (unsigned long long)pk2(y[j][0], y[j][1]) | ((unsigned long long)pk2(y[j][2], y[j][3]) << 32); }
}

constexpr int CI_IN = 16 * 57, CI_SQ = 16 * 16, CI_GU = 16 * 88, CI_DN = 44 * 16, CI_MAIN = CI_IN + 3 * CI_SQ + CI_GU;
__device__ __forceinline__ void conv_item_main(const Params& p, unsigned char* ws, int l, int r, LAS float* scr, int lane) {
    const int par = l & 1;
    if (r < CI_IN) { transpose_item(pin(p, I_WIN) + (size_t)l * DM * P_IN, DM, P_IN, (bf16_t*)(ws + woff(0, par)), 1, scr, r, lane, pin(p, I_NMIX) + l * DM); return; } r -= CI_IN;
    if (r < CI_SQ) { transpose_item(pin(p, I_WOUT) + (size_t)l * DM * DM, DM, DM, (bf16_t*)(ws + woff(1, par)), 0, scr, r, lane); return; } r -= CI_SQ;
    if (r < CI_SQ) { transpose_item(pin(p, I_WCQ) + (size_t)l * DM * DM, DM, DM, (bf16_t*)(ws + woff(2, par)), 0, scr, r, lane, pin(p, I_NX) + l * DM); return; } r -= CI_SQ;
    if (r < CI_SQ) { transpose_item(pin(p, I_WCO) + (size_t)l * DM * DM, DM, DM, (bf16_t*)(ws + woff(3, par)), 0, scr, r, lane); return; } r -= CI_SQ;
    transpose_item(pin(p, I_WGU) + (size_t)l * DM * 2 * D_FF, DM, 2 * D_FF, (bf16_t*)(ws + woff(4, par)), 2, scr, r, lane, pin(p, I_NFFN) + l * DM);
}
__device__ __forceinline__ void conv_item_dn(const Params& p, unsigned char* ws, int l, int r, LAS float* scr, int lane) {
    transpose_item(pin(p, I_WDN) + (size_t)l * D_FF * DM, D_FF, DM, (bf16_t*)(ws + WS_WDN), 0, scr, r, lane);
}
__device__ __forceinline__ void conv_unit(const Params& p, int l, int cu, bool dn, LAS unsigned char* lds, int lane, int wid) {
    asm volatile("" : "+v"(lds)); asm volatile("" : "+v"(lane));
    unsigned char* ws = wsp(p); LAS float* scr = (LAS float*)(lds + wid * 16896); const int item = cu * 8 + wid;
    if (dn) { if (item < CI_DN) conv_item_dn(p, ws, l, item, scr, lane); } else { if (item < CI_MAIN) conv_item_main(p, ws, l, item, scr, lane); }
}
__device__ __forceinline__ void phase_a(const Params& p, int l, LAS unsigned char* lds, int tid, int lane, int wid) {
    asm volatile("" : "+v"(lds));
    unsigned char* ws = p.ws;
    const int gw = blockIdx.x * 8 + wid, NGW = gridDim.x * 8;
    LAS float* scr = (LAS float*)(lds + wid * 16896);
    {
        for (int it = gw; it < CI_MAIN + CI_DN; it += NGW) { if (it < CI_MAIN) conv_item_main(p, ws, l, it, scr, lane); else conv_item_dn(p, ws, l, it - CI_MAIN, scr, lane); }
        if (l == 0) {
            for (int it = gw; it < 4 * 512; it += NGW) { const int ll = it >> 9;
                transpose_item(pin(p, I_WCKV) + (size_t)ll * DM * 2048, DM, 2048, (bf16_t*)(ws + WS_WCKV) + (size_t)ll * 2048 * DM, 0, scr, it & 511, lane); }
            for (int m = gw; m < 4 * NMEM; m += NGW) { const int ll = m >> 10, r = m & 1023; f32x4 y[4];
                norm_row(pin(p, I_MEM) + (size_t)r * DM, pin(p, I_NMEM) + ll * DM, (bf16_t*)(ws + WS_MEMN) + (size_t)m * DM, lane, y); }
        }
    }
    if (l == 0) {
        const float* xin = pin(p, I_X); bf16_t* H = (bf16_t*)(ws + WS_H); float* SS = (float*)(ws + WS_SSP);
        for (int m = gw; m < MTOK; m += NGW) {
            const f32x4* xr = (const f32x4*)(xin + (size_t)m * DM) + lane; unsigned long long* o8 = (unsigned long long*)(H + (size_t)m * DM) + lane;
            float sq = 0.f;
#pragma unroll
            for (int j = 0; j < 4; ++j) { const f32x4 v = xr[64 * j]; sq += dot4v(v); o8[64 * j] = (unsigned long long)pk2(v[0], v[1]) | ((unsigned long long)pk2(v[2], v[3]) << 32); }
            sq = wave_sum(sq, lane);
            if (lane < 16) SS[(size_t)m * 16 + lane] = lane == 0 ? sq : 0.f;
        }
    }
}
__device__ __forceinline__ void phase_norm(const Params& p, const float* g, int lane, int wid) {
    const int gw = blockIdx.x * 8 + wid, NGW = gridDim.x * 8;
    bf16_t* H = (bf16_t*)(wsp(p) + WS_H);
    for (int m = gw; m < MTOK; m += NGW) { f32x4 y[4]; norm_row(outp(p) + (size_t)m * DM, g, H + (size_t)m * DM, lane, y); }
}

__device__ __forceinline__ void unpack8(u32x4 v, float (&f)[8]) {
#pragma unroll
    for (int i = 0; i < 4; ++i) { f[2 * i] = __builtin_bit_cast(float, v[i] << 16); f[2 * i + 1] = __builtin_bit_cast(float, v[i] & 0xffff0000u); }
}

__device__ __forceinline__ void ssd_prep_unit(const Params& p, int l, int unit, LAS unsigned char* lds, int tid, int lane, int wid) {
    asm volatile("" : "+v"(lds));
    unsigned char* ws = wsp(p);
    const int h = unit & 3, c = (unit >> 2) & 31, b = unit >> 7, g = h >> 1;
    const int tok0 = b * SEQ + c * 128;
    const bf16_t* PROJ = (const bf16_t*)(ws + WS_PROJ); const float* SM = (const float*)(ws + WS_SM);
    LAS bf16_t* Cm = (LAS bf16_t*)(lds); LAS bf16_t* Bm = (LAS bf16_t*)(lds + 34816); LAS bf16_t* BmT = (LAS bf16_t*)(lds + 69632);
    LAS bf16_t* XSt = (LAS bf16_t*)(lds + 104448); LAS bf16_t* XDt = (LAS bf16_t*)(lds + 121856);
    LAS float* dtv = (LAS float*)(lds + 139264); LAS float* acum = (LAS float*)(lds + 139264 + 512);
    const float a_neg = -__expf(pin(p, I_SALOG)[l * 4 + h]);
    if (tid < 128) dtv[tid] = softplus_f(SM[(size_t)(tok0 + tid) * 12 + h] + pin(p, I_SDTB)[l * 4 + h]);
    __syncthreads();
    if (wid == 0) { const float s0 = wave_incl_scan(dtv[lane] * a_neg, lane); const float tot = __builtin_bit_cast(float, __builtin_amdgcn_readlane(__builtin_bit_cast(int, s0), 63)); const float s1 = wave_incl_scan(dtv[lane + 64] * a_neg, lane) + tot; acum[lane] = s0; acum[lane + 64] = s1; }
    __syncthreads();
    if (tid < 320) {
        const int o = tid % 40, tg = tid / 40;
        int ch; if (o < 8) ch = h * 64 + o * 8; else if (o < 24) ch = 256 + g * 128 + (o - 8) * 8; else ch = 512 + g * 128 + (o - 24) * 8;
        const float* cw = pin(p, I_SCW) + (size_t)l * 4 * 768 + ch; const float* cb = pin(p, I_SCB) + (size_t)l * 768 + ch;
        float w0[8], w1[8], w2[8], w3[8], bs[8];
#pragma unroll
        for (int j = 0; j < 8; ++j) { w0[j] = cw[j]; w1[j] = cw[768 + j]; w2[j] = cw[2 * 768 + j]; w3[j] = cw[3 * 768 + j]; bs[j] = cb[j]; }
        const bf16_t* src = PROJ + (size_t)tok0 * PN + 1792 + ch;
        int t0 = tg * 16; asm volatile("" : "+v"(t0));
        const int sp = c * 128 + t0;
        const bf16_t* rp = src + (ptrdiff_t)(t0 - 3) * PN;
        u32x4 raw[19];
#pragma unroll
        for (int r = 0; r < 19; ++r) { const bool ok = (r >= 3) || (sp + r - 3 >= 0); raw[r] = *(const u32x4*)(ok ? rp + (size_t)r * PN : src); if (!ok) raw[r] = (u32x4){0u, 0u, 0u, 0u}; }
        float x0[8], x1[8], x2[8], cur[8];
        unpack8(raw[0], x0); unpack8(raw[1], x1); unpack8(raw[2], x2);
        const float alast = acum[127];
#pragma unroll
        for (int tt = 0; tt < 16; ++tt) {
            const int t = t0 + tt;
            unpack8(raw[tt + 3], cur);
            float v[8];
#pragma unroll
            for (int j = 0; j < 8; ++j) { const float a = bs[j] + ((w0[j] * x0[j] + w1[j] * x1[j]) + (w2[j] * x2[j] + w3[j] * cur[j])); v[j] = silu_f(a); x0[j] = x1[j]; x1[j] = x2[j]; x2[j] = cur[j]; }
            if (o < 8) {
                const float sc = dtv[t] * __expf(alast - acum[t]);
#pragma unroll
                for (int j = 0; j < 8; ++j) { XSt[TSW(o * 8 + j, t)] = (bf16_t)f2bf(v[j]); XDt[TSW(o * 8 + j, t)] = (bf16_t)f2bf(v[j] * sc); }
            } else {
                u32x4 pk; pk.x = pk2(v[0], v[1]); pk.y = pk2(v[2], v[3]); pk.z = pk2(v[4], v[5]); pk.w = pk2(v[6], v[7]);
                if (o < 24) { const int n0 = (o - 8) * 8; *(LAS u32x4*)(Bm + t * 136 + n0) = pk;
#pragma unroll
                    for (int j = 0; j < 8; ++j) BmT[TSW(n0 + j, t)] = (bf16_t)f2bf(v[j]);
                } else { const int n0 = (o - 24) * 8; *(LAS u32x4*)(Cm + t * 136 + n0) = pk;
                    if ((h & 1) == 0) *(u32x4*)((bf16_t*)(ws + WS_CM) + (size_t)(tok0 + t) * 256 + g * 128 + n0) = pk; }
            }
        }
    }
    __syncthreads();
    {
        float* ST = (float*)(ws + WS_ST) + (size_t)unit * 8192;
        mm16v<128, 64, 128, true, true>(BmT, 136, XDt, 136, wid, lane, [&](int n0, int pp, f32x4 v) { *(f32x4*)(ST + pp * 128 + n0) = v; });
    }
    __syncthreads();
    {
        LAS bf16_t* Sc = BmT;
        mm16<128, 128, 128>(Cm, 136, Bm, 136, wid, lane, [&](int li, int s, float v) { Sc[li * 136 + s] = (li >= s) ? (bf16_t)f2bf(v * __expf(acum[li] - acum[s]) * dtv[s]) : (bf16_t)0; });
    }
    __syncthreads();
    {
        const float Dh = pin(p, I_SD)[l * 4 + h];
        float* Y = (float*)(ws + WS_YS);
        mm16v<64, 128, 128, true, false>(XSt, 136, BmT, 136, wid, lane, [&](int p0, int li, f32x4 v) {
#pragma unroll
            for (int i = 0; i < 4; ++i) v[i] += Dh * bf2f(XSt[TSW(p0 + i, li)]);
            *(f32x4*)(Y + (size_t)(tok0 + li) * 256 + h * 64 + p0) = v; });
        if (tid < 128) ((float*)(ws + WS_EA))[(size_t)(tok0 + tid) * 4 + h] = __expf(acum[tid]);
        if (tid == 0) ((float*)(ws + WS_EA + 512 * 1024))[unit] = __expf(acum[127]);
    }
    __syncthreads();
}
__device__ __forceinline__ void ssd_scan_unit(const Params& p, int su, int tid) {
    asm volatile("" : "+v"(tid));
    unsigned char* ws = wsp(p); const int b = su >> 2, h = su & 3;
    f32x4 hs[4];
#pragma unroll
    for (int j = 0; j < 4; ++j) hs[j] = (f32x4){0.f, 0.f, 0.f, 0.f};
    const float* DEC = (const float*)(ws + WS_EA + 512 * 1024);
    for (int c = 0; c < 32; ++c) {
        const int unit = (b * 32 + c) * 4 + h;
        const float* src = (const float*)(ws + WS_ST) + (size_t)unit * 8192; bf16_t* dst = (bf16_t*)(ws + WS_HP) + (size_t)unit * 8192;
        const float dec = DEC[unit];
#pragma unroll
        for (int j = 0; j < 4; ++j) { const int e = (tid + 512 * j) * 4; u32x2 w; w.x = pk2(hs[j][0], hs[j][1]); w.y = pk2(hs[j][2], hs[j][3]); *(u32x2*)(dst + e) = w; hs[j] = hs[j] * dec + *(const f32x4*)(src + e); }
    }
}

__device__ __forceinline__ void gdn_prep_unit(const Params& p, int l, int gu, LAS unsigned char* lds, int tid, int lane, int wid) {
    asm volatile("" : "+v"(lds));
    unsigned char* ws = wsp(p);
    const int c = gu & 63, h = (gu >> 6) & 3, b = gu >> 8;
    unsigned char* gob = (unsigned char*)outp(p);
    const int tok0 = b * SEQ + c * 64;
    const bf16_t* PROJ = (const bf16_t*)(ws + WS_PROJ); const float* SM = (const float*)(ws + WS_SM);
    LAS float* QKVf = (LAS float*)lds;
    LAS bf16_t* Qs = (LAS bf16_t*)(lds + 49408); LAS bf16_t* Ks = (LAS bf16_t*)(lds + 58624);
    LAS float* Tm = (LAS float*)(lds + 67840);
    LAS float* RHS = (LAS float*)(lds + 85248);
    LAS float* betas = (LAS float*)(lds + 119040); LAS float* gcs = (LAS float*)(lds + 119296);
    if (tid < 64) {
        const float braw = SM[(size_t)(tok0 + tid) * 12 + 4 + h], araw = SM[(size_t)(tok0 + tid) * 12 + 8 + h];
        betas[tid] = sigmoid_f(braw);
        const float gl = -__expf(pin(p, I_GALOG)[l * 4 + h]) * softplus_f(araw + pin(p, I_GDTB)[l * 4 + h]);
        gcs[tid] = wave_incl_scan(gl, lane);
    }
    if (tid < 384) {
        const int o = tid % 24, tg = tid / 24;
        const int ch = (o >> 3) * 256 + h * 64 + (o & 7) * 8;
        const float* cw = pin(p, I_GCW) + (size_t)l * 4 * 768 + ch;
        float w0[8], w1[8], w2[8], w3[8];
#pragma unroll
        for (int j = 0; j < 8; ++j) { w0[j] = cw[j]; w1[j] = cw[768 + j]; w2[j] = cw[2 * 768 + j]; w3[j] = cw[3 * 768 + j]; }
        const bf16_t* src = PROJ + (size_t)tok0 * PN + 2560 + ch;
        int t0 = tg * 4; asm volatile("" : "+v"(t0));
        const int sp = c * 64 + t0;
        const bf16_t* rp = src + (ptrdiff_t)(t0 - 3) * PN;
        u32x4 raw[7];
#pragma unroll
        for (int r = 0; r < 7; ++r) { const bool ok = (r >= 3) || (sp + r - 3 >= 0); raw[r] = *(const u32x4*)(ok ? rp + (size_t)r * PN : src); if (!ok) raw[r] = (u32x4){0u, 0u, 0u, 0u}; }
        float x0[8], x1[8], x2[8], cur[8];
        unpack8(raw[0], x0); unpack8(raw[1], x1); unpack8(raw[2], x2);
#pragma unroll
        for (int tt = 0; tt < 4; ++tt) {
            const int t = t0 + tt;
            unpack8(raw[tt + 3], cur);
#pragma unroll
            for (int j = 0; j < 8; ++j) { const float a = (w0[j] * x0[j] + w1[j] * x1[j]) + (w2[j] * x2[j] + w3[j] * cur[j]); QKVf[t * 193 + o * 8 + j] = silu_f(a); x0[j] = x1[j]; x1[j] = x2[j]; x2[j] = cur[j]; }
        }
    }
    __syncthreads();
    LAS bf16_t* KT = (LAS bf16_t*)(lds + 120320);
    {
        const int t = tid >> 3, which = (tid >> 2) & 1, q4 = tid & 3;
        const LAS float* row = QKVf + t * 193 + which * 64 + q4 * 16;
        float e[16]; float ss = 0.f;
#pragma unroll
        for (int d = 0; d < 16; ++d) { e[d] = row[d]; ss += e[d] * e[d]; }
        ss += dpp_f<0xB1>(ss); ss += dpp_f<0x4E>(ss);
        const float rinv = rsqrtf(ss + 1e-6f);
        const float gct = gcs[t];
        if (which == 0) {
            const float sc = rinv * 0.125f, eg = __expf(gct);
            u32x4 g0, g1;
#pragma unroll
            for (int d = 0; d < 16; d += 2) { const float v0 = e[d] * sc, v1 = e[d + 1] * sc; *(LAS unsigned*)(Qs + t * 72 + q4 * 16 + d) = pk2(v0, v1); const unsigned w = pk2(v0 * eg, v1 * eg); if (d < 8) g0[d >> 1] = w; else g1[(d - 8) >> 1] = w; }
            bf16_t* QG = (bf16_t*)(gob + GO_QG) + (size_t)gu * 4096 + t * 64 + q4 * 16;
            *(u32x4*)QG = g0; *(u32x4*)(QG + 8) = g1;
        } else {
            const float bt = betas[t] * __expf(gct), ek = __expf(gcs[63] - gct);
#pragma unroll
            for (int d = 0; d < 16; d += 2) { const float v0 = e[d] * rinv, v1 = e[d + 1] * rinv; *(LAS unsigned*)(Ks + t * 72 + q4 * 16 + d) = pk2(v0, v1);
                KT[(q4 * 16 + d) * 72 + t] = (bf16_t)f2bf(v0 * ek); KT[(q4 * 16 + d + 1) * 72 + t] = (bf16_t)f2bf(v1 * ek); }
#pragma unroll
            for (int d = 0; d < 16; d += 4) *(LAS f32x4*)(RHS + t * 132 + 64 + q4 * 16 + d) = (f32x4){e[d] * rinv * bt, e[d + 1] * rinv * bt, e[d + 2] * rinv * bt, e[d + 3] * rinv * bt};
        }
    }
    for (int idx = tid; idx < 4096; idx += 512) { const int t = idx >> 6, d = idx & 63; RHS[t * 132 + d] = QKVf[t * 193 + 128 + d] * betas[t]; }
    __syncthreads();
    { const int r = tid >> 3, c8 = (tid & 7) * 8; *(u32x4*)((bf16_t*)(gob + GO_KGT) + (size_t)gu * 4096 + r * 64 + c8) = *(const LAS u32x4*)(KT + r * 72 + c8); }
    mm16<64, 64, 64>(Ks, 72, Ks, 72, wid, lane, [&](int i, int j, float v) { Tm[i * 68 + j] = (i > j) ? v * betas[i] * __expf(gcs[i] - gcs[j]) : 0.f; });
    {
        bf16_t* ATT = (bf16_t*)(gob + GO_ATT) + (size_t)gu * 4096;
        mm16v<64, 64, 64>(Ks, 72, Qs, 72, wid, lane, [&](int j0, int i, f32x4 v) { const float gi = gcs[i]; float o[4];
#pragma unroll
            for (int q = 0; q < 4; ++q) o[q] = (i >= j0 + q) ? v[q] * __expf(gi - gcs[j0 + q]) : 0.f;
            u32x2 w; w.x = pk2(o[0], o[1]); w.y = pk2(o[2], o[3]); *(u32x2*)(ATT + i * 64 + j0) = w; });
    }
    if (tid == 0) ((float*)(ws + WS_EA + 768 * 1024))[gu] = __expf(gcs[63]);
    __syncthreads();
    if (tid < 128) {
        float x[64];
#pragma unroll
        for (int bi = 0; bi < 4; ++bi) {
            float a[16];
#pragma unroll
            for (int r = 0; r < 16; ++r) a[r] = RHS[(16 * bi + r) * 132 + tid];
#pragma unroll
            for (int j4 = 0; j4 < 4 * bi; ++j4) {
                f32x4 t[16];
#pragma unroll
                for (int r = 0; r < 16; ++r) t[r] = *(const LAS f32x4*)(Tm + (16 * bi + r) * 68 + 4 * j4);
#pragma unroll
                for (int r = 0; r < 16; ++r)
#pragma unroll
                    for (int q = 0; q < 4; ++q) a[r] -= t[r][q] * x[4 * j4 + q];
            }
            f32x4 cur[4], nxt[4];
#pragma unroll
            for (int q4 = 0; q4 < 4; ++q4) { cur[q4] = (f32x4){0.f, 0.f, 0.f, 0.f}; nxt[q4] = (f32x4){0.f, 0.f, 0.f, 0.f}; }
#pragma unroll
            for (int r = 0; r < 16; ++r) {
                if (r + 1 < 16) {
#pragma unroll
                    for (int q4 = 0; q4 < (r + 1 + 3) / 4; ++q4) nxt[q4] = *(const LAS f32x4*)(Tm + (16 * bi + r + 1) * 68 + 16 * bi + 4 * q4);
                }
                __builtin_amdgcn_sched_barrier(0);
                float acc = a[r];
#pragma unroll
                for (int j = 0; j < r; ++j) acc -= cur[j >> 2][j & 3] * x[16 * bi + j];
                x[16 * bi + r] = acc;
#pragma unroll
                for (int q4 = 0; q4 < 4; ++q4) cur[q4] = nxt[q4];
            }
        }
        if (tid < 64) { float* U = (float*)(ws + WS_GU) + (size_t)gu * 4096 + tid;
#pragma unroll
            for (int i = 0; i < 64; ++i) U[i * 64] = x[i];
        } else { bf16_t* W = (bf16_t*)(gob + GO_W) + (size_t)gu * 4096 + (tid - 64);
#pragma unroll
            for (int i = 0; i < 64; ++i) W[i * 64] = (bf16_t)f2bf(x[i]); }
    }
    __syncthreads();
}

__device__ __forceinline__ void gdn_chain_unit(const Params& p, int cu, LAS unsigned char* lds, int tid, int lane, int wid) {
    asm volatile("" : "+v"(lds));
    unsigned char* ws = wsp(p); const int b = cu >> 2, h = cu & 3;
    unsigned char* gob = (unsigned char*)outp(p);
    const int fr = lane & 15, fq = lane >> 4;
    constexpr int BUF = 54272;
    LAS bf16_t* St0 = (LAS bf16_t*)(lds + 2 * BUF); LAS bf16_t* VnT = (LAS bf16_t*)(lds + 2 * BUF + 18432);
    const bf16_t* gW = (const bf16_t*)(gob + GO_W) + (size_t)cu * 64 * 4096; const bf16_t* gQG = (const bf16_t*)(gob + GO_QG) + (size_t)cu * 64 * 4096;
    const bf16_t* gAT = (const bf16_t*)(gob + GO_ATT) + (size_t)cu * 64 * 4096; const bf16_t* gKT = (const bf16_t*)(gob + GO_KGT) + (size_t)cu * 64 * 4096;
    const float* gU = (const float*)(ws + WS_GU) + (size_t)cu * 64 * 4096; const float* GL = (const float*)(ws + WS_EA + 768 * 1024) + cu * 64;
    float* OG = (float*)(ws + WS_OG);
    f32x4 sreg[2] = {(f32x4){0.f, 0.f, 0.f, 0.f}, (f32x4){0.f, 0.f, 0.f, 0.f}};
    for (int i = tid; i < 64 * 72 / 2; i += 512) ((LAS unsigned*)St0)[i] = 0u;
    const int lrow = tid >> 3, lc8 = (tid & 7) * 8;
    u32x4 rw, rq, ra, rk; f32x4 ru[2];
    auto gload = [&](int c) { const size_t o = (size_t)c * 4096 + lrow * 64 + lc8; rw = *(const u32x4*)(gW + o); rq = *(const u32x4*)(gQG + o); ra = *(const u32x4*)(gAT + o); rk = *(const u32x4*)(gKT + o);
#pragma unroll
        for (int i = 0; i < 2; ++i) ru[i] = *(const f32x4*)(gU + (size_t)c * 4096 + (tid + 512 * i) * 4); };
    auto lstore = [&](int buf) { LAS unsigned char* B = lds + buf * BUF; const int o = (lrow * 72 + lc8) * 2;
        *(LAS u32x4*)(B + o) = rw; *(LAS u32x4*)(B + 9216 + o) = rq; *(LAS u32x4*)(B + 18432 + o) = ra; *(LAS u32x4*)(B + 27648 + o) = rk;
#pragma unroll
        for (int i = 0; i < 2; ++i) { const int idx = tid + 512 * i; *(LAS f32x4*)(B + 36864 + ((idx >> 4) * 68 + (idx & 15) * 4) * 4) = ru[i]; } };
    gload(0); lstore(0);
    __syncthreads();
    for (int c = 0; c < 64; ++c) {
        LAS unsigned char* B = lds + (c & 1) * BUF;
        const LAS bf16_t* Wt = (const LAS bf16_t*)B; const LAS bf16_t* QGt = (const LAS bf16_t*)(B + 9216); const LAS bf16_t* ATt = (const LAS bf16_t*)(B + 18432); const LAS bf16_t* KTt = (const LAS bf16_t*)(B + 27648);
        const LAS float* Ut = (const LAS float*)(B + 36864);
        LAS bf16_t* St = St0 + (c & 1) * 4608; LAS bf16_t* Stn = St0 + ((c + 1) & 1) * 4608;
        if (c + 1 < 64) gload(c + 1);
        mm16<64, 64, 64>(Wt, 72, St, 72, wid, lane, [&](int t, int dv, float v) { VnT[dv * 72 + t] = (bf16_t)f2bf(Ut[t * 68 + dv] - v); });
        __syncthreads();
        const float gl = GL[c];
        const int tokc = b * SEQ + c * 64;
#pragma unroll
        for (int bi = 0; bi < 2; ++bi) {
            const int blk = wid + 8 * bi, mb = blk >> 2, nb = blk & 3;
            f32x4 acc = {0.f, 0.f, 0.f, 0.f}, acs = {0.f, 0.f, 0.f, 0.f};
            const LAS bf16_t* sp = St + (nb * 16 + fr) * 72 + fq * 8; const LAS bf16_t* vp = VnT + (nb * 16 + fr) * 72 + fq * 8;
            const int ao = (mb * 16 + fr) * 72 + fq * 8;
#pragma unroll
            for (int k0 = 0; k0 < 64; k0 += 32) {
                acc = __builtin_amdgcn_mfma_f32_16x16x32_bf16(*(const LAS bf16x8*)(QGt + ao + k0), *(const LAS bf16x8*)(sp + k0), acc, 0, 0, 0);
                acc = __builtin_amdgcn_mfma_f32_16x16x32_bf16(*(const LAS bf16x8*)(ATt + ao + k0), *(const LAS bf16x8*)(vp + k0), acc, 0, 0, 0);
                acs = __builtin_amdgcn_mfma_f32_16x16x32_bf16(*(const LAS bf16x8*)(KTt + ao + k0), *(const LAS bf16x8*)(vp + k0), acs, 0, 0, 0);
            }
#pragma unroll
            for (int i = 0; i < 4; ++i) OG[(size_t)(tokc + mb * 16 + fq * 4 + i) * 256 + h * 64 + nb * 16 + fr] = acc[i];
            sreg[bi] = sreg[bi] * gl + acs;
        }
#pragma unroll
        for (int bi = 0; bi < 2; ++bi) { const int blk = wid + 8 * bi, mb = blk >> 2, nb = blk & 3;
            u32x2 w; w.x = pk2(sreg[bi][0], sreg[bi][1]); w.y = pk2(sreg[bi][2], sreg[bi][3]);
            *(LAS u32x2*)(Stn + (nb * 16 + fr) * 72 + mb * 16 + fq * 4) = w; }
        if (c + 1 < 64) lstore((c + 1) & 1);
        __syncthreads();
    }
}

__device__ __forceinline__ void phase_e_unit(const Params& p, int l, int tile, LAS unsigned char* lds, int tid, int lane, int wid) {
    asm volatile("" : "+v"(lds));
    unsigned char* ws = wsp(p);
    const int tok0 = tile * 64, b = tile >> 6, c = (tile & 63) >> 1;
    const bf16_t* PROJ = (const bf16_t*)(ws + WS_PROJ); bf16_t* CAT = (bf16_t*)(ws + WS_CAT);
    const float lambda_init = 0.8f - 0.6f * __expf(-0.3f * (float)l);
    float lam;
    { const float d1 = wave_sum(pin(p, I_LQ1)[l * 64 + lane] * pin(p, I_LK1)[l * 64 + lane], lane), d2 = wave_sum(pin(p, I_LQ2)[l * 64 + lane] * pin(p, I_LK2)[l * 64 + lane], lane); lam = __expf(d1) - __expf(d2) + lambda_init; }
    {
        const bf16_t* AO = (const bf16_t*)(ws + WS_AO); const float* sg = pin(p, I_SUBG) + l * 128;
        const int hh = lane >> 4, cmap = (lane >> 3) & 1, eh = (lane >> 2) & 1, dp = lane & 3;
        float gsub[16];
#pragma unroll
        for (int j = 0; j < 16; ++j) gsub[j] = sg[eh * 64 + dp * 16 + j];
        const float post = 1.f - lambda_init;
#pragma unroll 2
        for (int i = 0; i < 8; ++i) { const size_t tok = tok0 + wid + 8 * i;
            const u32x4 r0 = *(const u32x4*)(AO + tok * 1024 + lane * 16), r1 = *(const u32x4*)(AO + tok * 1024 + lane * 16 + 8);
            float mine[16], oth[16]; unpack8(r0, *(float(*)[8])&mine[0]); unpack8(r1, *(float(*)[8])&mine[8]);
#pragma unroll
            for (int j = 0; j < 16; ++j) oth[j] = dpp_f<0x128>(mine[j]);
            float v[16]; float sq = 0.f;
#pragma unroll
            for (int j = 0; j < 16; ++j) { v[j] = mine[j] - lam * oth[j]; sq += v[j] * v[j]; }
            if (cmap) sq = 0.f;
            sq += dpp_f<0xB1>(sq); sq += dpp_f<0x4E>(sq); sq += dpp_f<0x141>(sq); sq += dpp_f<0x140>(sq);
            const float rr = rsqrtf(sq * (1.f / 128.f) + NORM_EPS) * post;
            if (!cmap) { bf16_t* o = CAT + tok * 1024 + hh * 128 + eh * 64 + dp * 16;
                u32x4 w0, w1;
#pragma unroll
                for (int j = 0; j < 4; ++j) { w0[j] = pk2(v[2 * j] * rr * gsub[2 * j], v[2 * j + 1] * rr * gsub[2 * j + 1]); w1[j] = pk2(v[8 + 2 * j] * rr * gsub[8 + 2 * j], v[9 + 2 * j] * rr * gsub[9 + 2 * j]); }
                *(u32x4*)o = w0; *(u32x4*)(o + 8) = w1; }
        }
    }
    {
        const float* OG = (const float*)(ws + WS_OG); const f32x4 gn = *(const f32x4*)(pin(p, I_GNG) + l * 64 + (lane & 15) * 4);
#pragma unroll 4
        for (int i = 0; i < 8; ++i) { const size_t tok = tok0 + wid + 8 * i;
            const f32x4 v = *(const f32x4*)(OG + tok * 256 + lane * 4); const u32x2 zz = *(const u32x2*)(PROJ + tok * PN + 3328 + lane * 4);
            float sq = dot4v(v);
            sq += dpp_f<0xB1>(sq); sq += dpp_f<0x4E>(sq); sq += dpp_f<0x141>(sq); sq += dpp_f<0x140>(sq);
            const float rr = rsqrtf(sq * (1.f / 64.f) + NORM_EPS);
            const float z0 = __builtin_bit_cast(float, zz.x << 16), z1 = __builtin_bit_cast(float, zz.x & 0xffff0000u), z2 = __builtin_bit_cast(float, zz.y << 16), z3 = __builtin_bit_cast(float, zz.y & 0xffff0000u);
            u32x2 w; w.x = pk2(v[0] * rr * gn[0] * silu_f(z0), v[1] * rr * gn[1] * silu_f(z1)); w.y = pk2(v[2] * rr * gn[2] * silu_f(z2), v[3] * rr * gn[3] * silu_f(z3));
            *(u32x2*)(CAT + tok * 1024 + 768 + lane * 4) = w; }
    }
    LAS bf16_t* CMg = (LAS bf16_t*)lds; LAS bf16_t* HPs = (LAS bf16_t*)(lds + 17408); LAS float* Yb = (LAS float*)(lds + 17408 + 34816);
    const float* Y = (const float*)(ws + WS_YS); const float* EA = (const float*)(ws + WS_EA);
    for (int g = 0; g < 2; ++g) {
        {
            u32x4 r0[2], r1[4];
#pragma unroll
            for (int i = 0; i < 2; ++i) { const int idx = tid + 512 * i; r0[i] = *(const u32x4*)((const bf16_t*)(ws + WS_CM) + (size_t)(tok0 + (idx >> 4)) * 256 + g * 128 + (idx & 15) * 8); }
#pragma unroll
            for (int i = 0; i < 4; ++i) { const int idx = tid + 512 * i; const int hh = idx >> 10, r = (idx >> 4) & 63;
                r1[i] = *(const u32x4*)((const bf16_t*)(ws + WS_HP) + (size_t)((b * 32 + c) * 4 + 2 * g + hh) * 8192 + r * 128 + (idx & 15) * 8); }
#pragma unroll
            for (int i = 0; i < 2; ++i) { const int idx = tid + 512 * i; *(LAS u32x4*)(CMg + (idx >> 4) * 136 + (idx & 15) * 8) = r0[i]; }
#pragma unroll
            for (int i = 0; i < 4; ++i) { const int idx = tid + 512 * i; const int hh = idx >> 10, r = (idx >> 4) & 63; *(LAS u32x4*)(HPs + (hh * 64 + r) * 136 + (idx & 15) * 8) = r1[i]; }
        }
        __syncthreads();
        for (int hh = 0; hh < 2; ++hh)
            mm16<64, 64, 128>(CMg, 136, HPs + hh * 64 * 136, 136, wid, lane, [&](int r, int pp, float v) { Yb[r * 132 + hh * 64 + pp] = v; });
        __syncthreads();
        {
            f32x4 yv[4]; u32x2 zv[4]; float ea[4];
#pragma unroll
            for (int i = 0; i < 4; ++i) { const int idx = tid + 512 * i; const int r = idx >> 5, c4 = (idx & 31) * 4; const size_t tok = tok0 + r;
                yv[i] = *(const f32x4*)(Y + tok * 256 + g * 128 + c4); zv[i] = *(const u32x2*)(PROJ + tok * PN + 1536 + g * 128 + c4); ea[i] = EA[tok * 4 + 2 * g + (c4 >> 6)]; }
#pragma unroll
            for (int i = 0; i < 4; ++i) { const int idx = tid + 512 * i; const int r = idx >> 5, c4 = (idx & 31) * 4;
                const f32x4 yo = *(const LAS f32x4*)(Yb + r * 132 + c4); f32x4 o;
                const float z0 = __builtin_bit_cast(float, zv[i].x << 16), z1 = __builtin_bit_cast(float, zv[i].x & 0xffff0000u), z2 = __builtin_bit_cast(float, zv[i].y << 16), z3 = __builtin_bit_cast(float, zv[i].y & 0xffff0000u);
                o[0] = (yv[i][0] + yo[0] * ea[i]) * silu_f(z0); o[1] = (yv[i][1] + yo[1] * ea[i]) * silu_f(z1); o[2] = (yv[i][2] + yo[2] * ea[i]) * silu_f(z2); o[3] = (yv[i][3] + yo[3] * ea[i]) * silu_f(z3);
                *(LAS f32x4*)(Yb + r * 132 + c4) = o; }
        }
        __syncthreads();
        { const float* gn = pin(p, I_SNG) + l * 256 + g * 128; const float g0 = gn[lane], g1 = gn[64 + lane];
#pragma unroll
            for (int i = 0; i < 8; ++i) { const int r = wid + 8 * i; const float v0 = Yb[r * 132 + lane], v1 = Yb[r * 132 + 64 + lane];
                const float rr = rsqrtf(wave_sum(v0 * v0 + v1 * v1, lane) * (1.f / 128.f) + NORM_EPS);
                bf16_t* o = CAT + (size_t)(tok0 + r) * 1024 + 512 + g * 128 + lane; o[0] = (bf16_t)f2bf(v0 * rr * g0); o[64] = (bf16_t)f2bf(v1 * rr * g1); } }
        __syncthreads();
    }
}
}

namespace mk {
__device__ __forceinline__ int q_next(unsigned* ctr, LAS unsigned char* lds, int tid) {
    LAS int* slot = (LAS int*)(lds + LDS_SLOT);
    __syncthreads();
    if (tid == 0) *slot = (int)atomicAdd(ctr, 1u);
    __syncthreads();
    return __builtin_amdgcn_readfirstlane(*slot);
}
}

#ifndef PROBE_REP_D1
#define PROBE_REP_D1 1
#endif
#ifndef PROBE_REP_D2
#define PROBE_REP_D2 1
#endif
#ifndef PROBE_XSYNC
#define PROBE_XSYNC 0
#endif
#ifndef PROBE_REP_A
#define PROBE_REP_A 1
#endif
#ifndef PROBE_REP_EPIINPROJ
#define PROBE_REP_EPIINPROJ 1
#endif
#ifndef PROBE_REP_EPIQPROJ
#define PROBE_REP_EPIQPROJ 1
#endif
#ifndef PROBE_REP_EPISOFTMAX
#define PROBE_REP_EPISOFTMAX 1
#endif
#ifndef PROBE_REP_EPIBF16
#define PROBE_REP_EPIBF16 1
#endif
#ifndef PROBE_REP_EPISWIGLU
#define PROBE_REP_EPISWIGLU 1
#endif
#ifndef PROBE_REP_GP
#define PROBE_REP_GP 1
#endif
#ifndef PROBE_REP_ATT
#define PROBE_REP_ATT 1
#endif
#ifndef PROBE_REP_SP
#define PROBE_REP_SP 1
#endif
#ifndef PROBE_REP_CH
#define PROBE_REP_CH 1
#endif
#ifndef PROBE_REP_E
#define PROBE_REP_E 1
#endif
#ifndef MK_LAYERS
#define MK_LAYERS DEPTH
#endif

#define IDS int tid; asm volatile("v_mbcnt_lo_u32_b32 %0, -1, 0\n\tv_mbcnt_hi_u32_b32 %0, -1, %0" : "=v"(tid)); tid += wid0 * 64; asm volatile("" : "+v"(tid)); const int lane = tid & 63, wid = __builtin_amdgcn_readfirstlane(tid >> 6); (void)lane; (void)wid
#define WSV unsigned char* ws = wsp(p); unsigned* ctl = (unsigned*)(ws + WS_CTL); bf16_t* H = (bf16_t*)(ws + WS_H); bf16_t* PROJ = (bf16_t*)(ws + WS_PROJ); bf16_t* AO = (bf16_t*)(ws + WS_AO); bf16_t* CAT = (bf16_t*)(ws + WS_CAT); \
    bf16_t* QX = AO; bf16_t* PB = PROJ; bf16_t* OX = CAT; bf16_t* HID = PROJ; (void)ctl; (void)H; (void)PROJ; (void)AO; (void)CAT; (void)QX; (void)PB; (void)OX; (void)HID
__global__ void __launch_bounds__(512, 2) mega_fwd(mk::Params p) {
    using namespace mk;
    extern __shared__ __attribute__((aligned(16))) unsigned char lds_raw[];
    cg::grid_group grid = cg::this_grid();
    LAS unsigned char* lds = (LAS unsigned char*)lds_raw;
    const int bid = blockIdx.x;
    const int wid0 = __builtin_amdgcn_readfirstlane((int)threadIdx.x >> 6);
    {
        IDS; volatile LAS unsigned* st = (volatile LAS unsigned*)(lds + LDS_SLOT + 16);
        if (tid < 2) st[tid] = 0u;
        __syncthreads();
        { unsigned char* wv = p.ws; asm volatile("" : "+v"(wv));
          (void)xcd_barrier_post((unsigned*)(wv + WS_CTL) + 4096, st, tid); }
    }
#define GSYNC() do { IDS; XcdBarrier b_; b_.bar = (unsigned*)(wsp(p) + WS_CTL) + 4096; b_.x = xb_xcc_id(); b_.st = (volatile LAS unsigned*)(lds + LDS_SLOT + 16); xcd_barrier(b_, tid); } while (0)
    { IDS; phase_a(p, 0, lds, tid, lane, wid); }
    if (gridDim.x == 0x7fffffffu) grid.sync();
    GSYNC();
    {
        WSV; pg8::SchedOne S; S.have = bid < 128; const int ll = bid >> 5, r = bid & 31;
        S.u0.pm = r >> 3; S.u0.pn = r & 7; S.u0.kind = 0; S.u0.aux = ll;
        S.u0.a = (const char*)(ws + WS_MEMN) + ((size_t)ll * NMEM + S.u0.pm * 256) * DM * 2;
        S.u0.b = (const char*)(ws + WS_WCKV) + ((size_t)ll * 2048 + S.u0.pn * 256) * DM * 2;
        pg8::EpiKV E{(bf16_t*)(ws + WS_KN), (bf16_t*)(ws + WS_VT), pin(p, I_XKG)};
        { IDS; pg8::gemm_phase<pg8::EpiKV, pg8::SchedOne, false, true>(lds, pg8::Gemm{DM, DM, DM}, S, E, tid); }
        __syncthreads();
    }
#pragma unroll 1
    for (int l = 0; l < MK_LAYERS; ++l) {
        {
            WSV; pg8::SchedDense S; S.init(H, ws + woff(0, l & 1), DM, DM, MTOK / 256, PN / 256 + 1);
            pg8::EpiInProj E{PROJ, pin(p, I_QG) + l * 64, pin(p, I_KG) + l * 64, (const float*)(ws + WS_SSP), (float*)(ws + WS_SM)};
            for (int rep = 0; rep < PROBE_REP_EPIINPROJ; ++rep) { IDS; pg8::gemm_phase<pg8::EpiInProj, pg8::SchedDense, true, true>(lds, pg8::Gemm{DM, DM, DM}, S, E, tid); }
        }
        GSYNC();
        {
            IDS;
#pragma unroll 1
            for (int u = bid; u < 1024; u += gridDim.x) gdn_prep_unit(p, l, u, lds, tid, lane, wid);
#pragma unroll 1
            for (int u = bid; u < 512; u += gridDim.x) ssd_prep_unit(p, l, u, lds, tid, lane, wid);
            if (l > 0) for (int u = bid; u < (CI_DN + 7) / 8; u += gridDim.x) conv_unit(p, l, u, true, lds, lane, wid);
        }
        GSYNC();
        for (int rep = 0; rep < PROBE_REP_D2; ++rep) {
            IDS; WSV; unsigned* ctr = ctl + ((l * 2 + 1) * 4 + rep) * 64;
            const int nq2 = 32 + 1024 + (l + 1 < MK_LAYERS ? (CI_MAIN + 7) / 8 : 0);
            for (;;) { const int idx = q_next(ctr, lds, tid); if (idx >= nq2) break;
                if (idx >= 32 + 1024) { conv_unit(p, l + 1, idx - (32 + 1024), false, lds, lane, wid); continue; }
#ifndef SKIP_GCHAIN
                if (idx < 16) { for (int r2 = 0; r2 < PROBE_REP_CH; ++r2) gdn_chain_unit(p, idx, lds, tid, lane, wid); }
#endif
                if (idx >= 16 && idx < 32) ssd_scan_unit(p, idx - 16, tid);
#ifndef SKIP_ATTN
                if (idx >= 32) { const int a = idx - 32, qb = 15 - (a >> 6), bh = a & 63;
                    for (int r2 = 0; r2 < PROBE_REP_ATT; ++r2) attn_body::attn_unit<8>(bh >> 4, bh & 15, qb, (const attn_body::bf16*)PROJ, (const attn_body::bf16*)PROJ, (const attn_body::bf16*)PROJ, (attn_body::bf16*)AO, (char*)lds_raw, tid); }
#endif
            }
        }
        GSYNC();
#ifndef SKIP_E
        { IDS; for (int tile = bid; tile < MTOK / 64; tile += gridDim.x) for (int r2 = 0; r2 < PROBE_REP_E; ++r2) phase_e_unit(p, l, tile, lds, tid, lane, wid); }
#endif
        GSYNC();
        {
            WSV; pg8::SchedDense S; S.init(CAT, ws + woff(1, l & 1), DM, DM, MTOK / 256, 4);
            pg8::EpiResid E{H, (float*)(ws + WS_SSP + 1 * MiB), nullptr};
#ifdef PROBE_NULL_RESID
            { pg8::EpiNull EN{(float*)(ws + WS_SM)}; IDS; pg8::gemm_phase<pg8::EpiNull, pg8::SchedDense, true, true>(lds, pg8::Gemm{DM, DM, DM}, S, EN, tid); }
#endif
            { IDS; pg8::gemm_phase<pg8::EpiResid, pg8::SchedDense, true, true>(lds, pg8::Gemm{DM, DM, DM}, S, E, tid); }
        }
        GSYNC();
        {
            WSV; pg8::SchedDense S; S.init(H, ws + woff(2, l & 1), DM, DM, MTOK / 256, 4);
            pg8::EpiQProj E{QX, pin(p, I_XQG) + l * 256, (const float*)(ws + WS_SSP + 1 * MiB)};
            for (int rep = 0; rep < PROBE_REP_EPIQPROJ; ++rep) { IDS; pg8::gemm_phase<pg8::EpiQProj, pg8::SchedDense, false, true>(lds, pg8::Gemm{DM, DM, DM}, S, E, tid); }
        }
        asm volatile("s_waitcnt vmcnt(0)" ::: "memory"); __syncthreads();
        {
            WSV; pg8::SchedX<0> S; S.init(QX, ws + WS_KN + (size_t)l * NMEM * DM * 2);
            pg8::EpiSoftmax E{PB};
            for (int rep = 0; rep < PROBE_REP_EPISOFTMAX; ++rep) { IDS; pg8::gemm_phase<pg8::EpiSoftmax, pg8::SchedX<0>, false, true>(lds, pg8::Gemm{DM, DM, 256}, S, E, tid); }
        }
        asm volatile("s_waitcnt vmcnt(0)" ::: "memory"); __syncthreads();
        {
            WSV; pg8::SchedX<1> S; S.init(PB, ws + WS_VT + (size_t)l * 16 * 65536 * 2);
            pg8::EpiBf16 E{OX};
            for (int rep = 0; rep < PROBE_REP_EPIBF16; ++rep) { IDS; pg8::gemm_phase<pg8::EpiBf16, pg8::SchedX<1>, false, true>(lds, pg8::Gemm{DM, 256, 256}, S, E, tid); }
        }
        GSYNC();
        {
            WSV; pg8::SchedDense S; S.init(OX, ws + woff(3, l & 1), DM, DM, MTOK / 256, 4);
            pg8::EpiResid E{H, (float*)(ws + WS_SSP + 2 * MiB), nullptr};
#ifdef PROBE_NULL_RESID
            { pg8::EpiNull EN{(float*)(ws + WS_SM)}; IDS; pg8::gemm_phase<pg8::EpiNull, pg8::SchedDense, true, true>(lds, pg8::Gemm{DM, DM, DM}, S, EN, tid); }
#endif
            { IDS; pg8::gemm_phase<pg8::EpiResid, pg8::SchedDense, true, true>(lds, pg8::Gemm{DM, DM, DM}, S, E, tid); }
        }
        GSYNC();
        {
            WSV; pg8::SchedDense S; S.init(H, ws + woff(4, l & 1), DM, DM, MTOK / 256, 2 * D_FF / 256);
            pg8::EpiSwiGLU E{HID, (const float*)(ws + WS_SSP + 2 * MiB)};
            for (int rep = 0; rep < PROBE_REP_EPISWIGLU; ++rep) { IDS; pg8::gemm_phase<pg8::EpiSwiGLU, pg8::SchedDense, true, true>(lds, pg8::Gemm{DM, DM, DM}, S, E, tid); }
        }
        GSYNC();
        {
            WSV; pg8::SchedDense S; S.init(HID, ws + WS_WDN, D_FF, D_FF, MTOK / 256, 4);
            pg8::EpiResid E{H, (float*)(ws + WS_SSP), l + 1 < MK_LAYERS ? nullptr : outp(p)};
#ifdef PROBE_NULL_RESID
            { pg8::EpiNull EN{(float*)(ws + WS_SM)}; IDS; pg8::gemm_phase<pg8::EpiNull, pg8::SchedDense, true, true>(lds, pg8::Gemm{D_FF, D_FF, D_FF}, S, EN, tid); }
#endif
            { IDS; pg8::gemm_phase<pg8::EpiResid, pg8::SchedDense, true, true>(lds, pg8::Gemm{D_FF, D_FF, D_FF}, S, E, tid); }
        }
        GSYNC();
        for (int xs = 0; xs < PROBE_XSYNC; ++xs) GSYNC();

    }
}

extern "C" void kernel_launch(void* const* d_in, const int* in_sizes, int n_in, void* d_out, int out_size, void* d_ws, size_t ws_size, hipStream_t stream) {
    static int grid = 0;
    if (grid == 0) {
        if (n_in != 32 || out_size != MTOK * DM || ws_size < mk::WS_END) { fprintf(stderr, "kernel_launch: unexpected shapes: n_in %d out %d ws %zu (need %zu)\n", n_in, out_size, ws_size, (size_t)mk::WS_END); grid = -1; return; }
        int dev = 0, cus = 0, per_cu = 0;
        hipGetDevice(&dev); hipDeviceGetAttribute(&cus, hipDeviceAttributeMultiprocessorCount, dev);
        if (hipFuncSetAttribute((const void*)mega_fwd, hipFuncAttributeMaxDynamicSharedMemorySize, mk::LDS_BYTES) != hipSuccess) { fprintf(stderr, "kernel_launch: hipFuncSetAttribute failed\n"); grid = -1; return; }
        hipOccupancyMaxActiveBlocksPerMultiprocessor(&per_cu, (const void*)mega_fwd, 512, mk::LDS_BYTES);
        (void)hipGetLastError();
        if (per_cu < 1) fprintf(stderr, "kernel_launch: occupancy query says %d blocks/CU\n", per_cu);
        grid = cus;
        if (grid != 256) fprintf(stderr, "kernel_launch: %d CUs; this kernel is built for 256\n", grid);
    }
    if (grid < 0) return;
    (void)hipMemsetAsync((char*)d_ws + mk::WS_CTL, 0, mk::CTL_BYTES, stream);
    mk::Params p{};
    for (int i = 0; i < 32; ++i) p.in[i] = (const float*)d_in[i];
    p.out = (float*)d_out; p.ws = (unsigned char*)d_ws;
    void* args[] = {&p};
    hipError_t e = hipLaunchCooperativeKernel((const void*)mega_fwd, dim3(grid), dim3(512), args, mk::LDS_BYTES, stream);
    if (e != hipSuccess) fprintf(stderr, "cooperative launch failed: %s (grid %d)\n", hipGetErrorString(e), grid);
}
```
